# Optimizing an MI355X kernel written in HIP

```python
import math
import jax, jax.numpy as jnp
from jax import lax
import numpy as np

D_MODEL = 1024
BATCH = 16
SEQ = 2048
DEPTH = 4

N_MIXERS = 2
N_FOX = (DEPTH + 1) // 2
N_MLA = DEPTH // 2
FOX_HEADS = 16
FOX_HEAD_DIM = D_MODEL // FOX_HEADS
MLA_HEADS = 16
MLA_NOPE_DIM = D_MODEL // MLA_HEADS
MLA_ROPE_DIM = MLA_NOPE_DIM // 2
MLA_V_DIM = D_MODEL // MLA_HEADS
MLA_Q_RANK = D_MODEL // 4
MLA_KV_RANK = D_MODEL // 8
D_FF = 4 * D_MODEL
Q_BLOCK = 128
ROPE_THETA = 10000.0
NORM_EPS = 1e-6
N_MOD = 6

kernel_name = "hybrid_fox_mla_adaln_trunk"


def rms_norm(x, g):
    x32 = x.astype(jnp.float32)
    y = x32 * lax.rsqrt(jnp.mean(x32 * x32, axis=-1, keepdims=True) + NORM_EPS)
    return y.astype(x.dtype) * g


def causal_block_attention(logits_fn, v):
    S = v.shape[1]
    outs = []
    for qb in range(S // Q_BLOCK):
        q0, q1 = qb * Q_BLOCK, (qb + 1) * Q_BLOCK
        logits = logits_fn(q0, q1)
        allowed = jnp.arange(q1)[None, :] <= jnp.arange(q0, q1)[:, None]
        logits = jnp.where(allowed, logits, -jnp.inf)
        p = jax.nn.softmax(logits, axis=-1).astype(v.dtype)
        outs.append(jnp.einsum('bhqk,bkhd->bqhd', p, v[:, :q1]))
    return jnp.concatenate(outs, axis=1)


def rope_cos_sin(positions, dim):
    inv_freq = ROPE_THETA ** (-jnp.arange(0, dim, 2, dtype=jnp.float32) / dim)
    ang = positions.astype(jnp.float32)[..., None] * inv_freq
    return jnp.cos(ang), jnp.sin(ang)


def apply_rope(x, cos, sin):
    half = x.shape[-1] // 2
    x1, x2 = x[..., :half], x[..., half:]
    cos = cos.astype(x.dtype)
    sin = sin.astype(x.dtype)
    return jnp.concatenate([x1 * cos - x2 * sin, x2 * cos + x1 * sin], axis=-1)


def fox_mixer(h, w_in, b_f, w_out):
    B, S, _ = h.shape
    proj = h @ w_in
    q = proj[..., :D_MODEL].reshape(B, S, FOX_HEADS, FOX_HEAD_DIM)
    k = proj[..., D_MODEL:2 * D_MODEL].reshape(B, S, FOX_HEADS, FOX_HEAD_DIM)
    v = proj[..., 2 * D_MODEL:3 * D_MODEL].reshape(B, S, FOX_HEADS, FOX_HEAD_DIM)
    log_f = jax.nn.log_sigmoid((proj[..., 3 * D_MODEL:] + b_f).astype(jnp.float32))
    F = jnp.cumsum(log_f, axis=1).transpose(0, 2, 1)
    scale = FOX_HEAD_DIM ** -0.5

    def logits_fn(q0, q1):
        s = jnp.einsum('bqhd,bkhd->bhqk', q[:, q0:q1], k[:, :q1],
                       preferred_element_type=jnp.float32)
        return s * scale + (F[:, :, q0:q1, None] - F[:, :, None, :q1])

    o = causal_block_attention(logits_fn, v)
    return o.reshape(B, S, D_MODEL) @ w_out


def mla_mixer(h, cos, sin, w_dq, q_norm_g, w_uq, w_dkv, kv_norm_g, w_ukv, w_out):
    B, S, _ = h.shape
    cq = rms_norm(h @ w_dq, q_norm_g)
    q = (cq @ w_uq).reshape(B, S, MLA_HEADS, MLA_NOPE_DIM + MLA_ROPE_DIM)
    q_nope = q[..., :MLA_NOPE_DIM]
    q_rope = apply_rope(q[..., MLA_NOPE_DIM:], cos[:, :, None, :], sin[:, :, None, :])
    dkv = h @ w_dkv
    ckv = rms_norm(dkv[..., :MLA_KV_RANK], kv_norm_g)
    k_rope = apply_rope(dkv[..., MLA_KV_RANK:], cos, sin)
    kv = (ckv @ w_ukv).reshape(B, S, MLA_HEADS, MLA_NOPE_DIM + MLA_V_DIM)
    k_nope = kv[..., :MLA_NOPE_DIM]
    v = kv[..., MLA_NOPE_DIM:]
    scale = (MLA_NOPE_DIM + MLA_ROPE_DIM) ** -0.5

    def logits_fn(q0, q1):
        s = jnp.einsum('bqhd,bkhd->bhqk', q_nope[:, q0:q1], k_nope[:, :q1],
                       preferred_element_type=jnp.float32)
        s = s + jnp.einsum('bqhd,bkd->bhqk', q_rope[:, q0:q1], k_rope[:, :q1],
                           preferred_element_type=jnp.float32)
        return s * scale

    o = causal_block_attention(logits_fn, v)
    return o.reshape(B, S, MLA_HEADS * MLA_V_DIM) @ w_out


def sq_relu_mlp(h, w1, w2):
    a = jax.nn.relu(h @ w1)
    return (a * a) @ w2


def setup_inputs(seed: int = 0) -> dict:
    key = jax.random.key(seed)
    ks = iter(jax.random.split(key, 32))
    D = D_MODEL

    def nrm(shape, fan_in, mult=1.0):
        return jax.random.normal(next(ks), shape, jnp.float32) * (mult * fan_in ** -0.5)

    def gain(shape):
        return 1.0 + 0.02 * jax.random.normal(next(ks), shape, jnp.float32)

    x = jax.random.normal(next(ks), (BATCH, SEQ, D), jnp.float32)
    c = jax.random.normal(next(ks), (BATCH, D), jnp.float32)
    offs = jax.random.randint(next(ks), (BATCH, 1), 0, 4096, dtype=jnp.int32)
    positions = (jnp.arange(SEQ, dtype=jnp.int32)[None, :] + offs).astype(jnp.int32)
    return {
        "x": x,
        "c": c,
        "positions": positions,
        "ada_w": nrm((DEPTH, D, N_MOD * D), D),
        "ada_b": 0.02 * jax.random.normal(next(ks), (DEPTH, N_MOD * D), jnp.float32),
        "norm_mix_g": gain((DEPTH, D)),
        "norm_mlp_g": gain((DEPTH, D)),
        "fox_w_in": nrm((N_FOX, D, 3 * D + FOX_HEADS), D),
        "fox_b_f": jax.random.uniform(next(ks), (N_FOX, FOX_HEADS), jnp.float32, 2.0, 6.0),
        "fox_w_out": nrm((N_FOX, D, D), D),
        "mla_w_dq": nrm((N_MLA, D, MLA_Q_RANK), D),
        "mla_q_norm_g": gain((N_MLA, MLA_Q_RANK)),
        "mla_w_uq": nrm((N_MLA, MLA_Q_RANK, MLA_HEADS * (MLA_NOPE_DIM + MLA_ROPE_DIM)), MLA_Q_RANK),
        "mla_w_dkv": nrm((N_MLA, D, MLA_KV_RANK + MLA_ROPE_DIM), D),
        "mla_kv_norm_g": gain((N_MLA, MLA_KV_RANK)),
        "mla_w_ukv": nrm((N_MLA, MLA_KV_RANK, MLA_HEADS * (MLA_NOPE_DIM + MLA_V_DIM)), MLA_KV_RANK),
        "mla_w_out": nrm((N_MLA, MLA_HEADS * MLA_V_DIM, D), MLA_HEADS * MLA_V_DIM),
        "mlp_w1": nrm((DEPTH, D, D_FF), D),
        "mlp_w2": nrm((DEPTH, D_FF, D), D_FF),
        "final_norm_g": gain((D,)),
    }


def reference(x, c, positions, ada_w, ada_b, norm_mix_g, norm_mlp_g,
              fox_w_in, fox_b_f, fox_w_out,
              mla_w_dq, mla_q_norm_g, mla_w_uq, mla_w_dkv, mla_kv_norm_g, mla_w_ukv, mla_w_out,
              mlp_w1, mlp_w2, final_norm_g):
    cos, sin = rope_cos_sin(positions, MLA_ROPE_DIM)
    c_act = jax.nn.silu(c)
    for i in range(DEPTH):
        mod = (c_act @ ada_w[i] + ada_b[i])[:, None, :]
        sh_m, sc_m, g_m, sh_f, sc_f, g_f = jnp.split(mod, N_MOD, axis=-1)
        h = rms_norm(x, norm_mix_g[i]) * (1 + sc_m) + sh_m
        j = i // N_MIXERS
        if i % N_MIXERS == 0:
            y = fox_mixer(h, fox_w_in[j], fox_b_f[j], fox_w_out[j])
        else:
            y = mla_mixer(h, cos, sin, mla_w_dq[j], mla_q_norm_g[j], mla_w_uq[j],
                          mla_w_dkv[j], mla_kv_norm_g[j], mla_w_ukv[j], mla_w_out[j])
        x = x + g_m * y
        h = rms_norm(x, norm_mlp_g[i]) * (1 + sc_f) + sh_f
        x = x + g_f * sq_relu_mlp(h, mlp_w1[i], mlp_w2[i])
    return rms_norm(x, final_norm_g)
```

```cpp
#include <hip/hip_runtime.h>
#include <hip/hip_cooperative_groups.h>
#include <cstdio>
#include <cstdint>
namespace cg = cooperative_groups;
#define LAS __attribute__((address_space(3)))
typedef unsigned short bf16;
typedef short bf16x8 __attribute__((ext_vector_type(8)));
typedef short s16x4 __attribute__((ext_vector_type(4)));
typedef float f32x16 __attribute__((ext_vector_type(16)));
typedef float f32x4 __attribute__((ext_vector_type(4)));
typedef float f32x2 __attribute__((ext_vector_type(2)));
typedef unsigned u32x4 __attribute__((ext_vector_type(4)));
typedef unsigned u32x2 __attribute__((ext_vector_type(2)));

constexpr int NB = 16, SEQ = 2048, DM = 1024, NH = 16, FF = 4096, DEPTH = 4;
constexpr int M = NB * SEQ;
constexpr int NTHR = 512, NWAVE = 8;
constexpr float EPS = 1e-6f, LOG2E = 1.4426950408889634f;
constexpr size_t MiB = 1u << 20;
constexpr size_t WS_BIG = 0;
constexpr size_t WS_Q = 0, WS_K = 96 * MiB, WS_V = 192 * MiB;
constexpr size_t WS_H = 256 * MiB;
constexpr size_t WS_CQ = 320 * MiB, WS_CKV = 336 * MiB;
constexpr size_t WS_W = 344 * MiB;
constexpr size_t W_FOX = 0, W_FOX_STRIDE = 8 * MiB;
constexpr size_t W_MLA = 16 * MiB, W_MLA_STRIDE = 5 * MiB;
constexpr size_t W_MLP = 26 * MiB, W_MLP_STRIDE = 16 * MiB;
constexpr size_t WS_MOD = 436 * MiB;
constexpr size_t WS_CS = 438 * MiB;
constexpr size_t WS_LF = 442 * MiB;
constexpr size_t WS_SSQQ = 444 * MiB, WS_SSQKV = 445 * MiB;
constexpr size_t WS_END = 446 * MiB;
static_assert(WS_W + W_MLP + 4 * W_MLP_STRIDE <= WS_MOD, "weights fit");
constexpr int LDS_BYTES = 135168;

namespace pg8 {
#define PG8_LAS __attribute__((address_space(3)))
typedef unsigned short bf16_t;
typedef short bf16x8 __attribute__((ext_vector_type(8)));
typedef float f32x4 __attribute__((ext_vector_type(4)));
typedef unsigned u32x4 __attribute__((ext_vector_type(4)));
constexpr int BM = 256, BK = 64, HALF = 128, HTB = HALF * BK * 2  , STAGE_BYTES = 8 * HTB, NXCD = 8, WGM = 8;

__host__ __device__ __forceinline__ int lds_byte(int r, int c) { const int st = (r >> 4) * 2 + (c >> 5), rr = r & 15, cc = c & 31, ob = rr * 64 + cc * 2; return st * 1024 + (ob ^ (((ob >> 9) & 1) << 5)); }
__host__ __device__ __forceinline__ void stage_rc(int b, int& R, int& C) { const int st = b / 1024, sb = b % 1024, swz = sb ^ (((sb >> 9) & 1) << 5); R = (st >> 1) * 16 + swz / 64; C = (st & 1) * 32 + (swz % 64) / 2; }
__host__ __device__ __forceinline__ int perm32(int rho) { const int n = rho >> 4, i = rho & 15; return 8 * (i >> 2) + 4 * n + (i & 3); }

struct Unit { int pm, pn; };
struct Gemm { const bf16_t* A; const bf16_t* Bt; int M, N, K; };

struct StaticOrder {
    int nM, nN, nwg, G, c;
    __host__ __device__ void init(int M, int N, int G_, int c_) { nM = M / BM; nN = N / BM; nwg = nM * nN; G = G_; c = c_; }
    __host__ __device__ bool next(int i, Unit& u) const {
        const long L = (long)i * G + c; if (L >= nwg) return false;
        int wgid = (int)L; { const int q = nwg / NXCD, r = nwg % NXCD, xcd = wgid % NXCD, off = wgid / NXCD; wgid = (xcd < r ? xcd * (q + 1) : r * (q + 1) + (xcd - r) * q) + off; }
        const int nig = WGM * nN, gid = wgid / nig, fm = gid * WGM, gsz = (nM - fm) < WGM ? (nM - fm) : WGM;
        u.pm = fm + ((wgid % nig) % gsz); u.pn = (wgid % nig) / gsz; return true;
    }
    __device__ __forceinline__ void a_ready(const Unit&) const {}
    __device__ __forceinline__ void done(const Unit&) const {}
};

__device__ __forceinline__ unsigned cvt_pk_bf16(float lo, float hi) { unsigned r; asm volatile("v_cvt_pk_bf16_f32 %0, %1, %2" : "=v"(r) : "v"(lo), "v"(hi)); return r; }
typedef float f32x2 __attribute__((ext_vector_type(2)));
typedef unsigned u32x2 __attribute__((ext_vector_type(2)));
#define GAS __attribute__((address_space(1)))
typedef GAS bf16_t gbf16; typedef GAS float gf32; typedef GAS unsigned char gu8;
constexpr float RMS_EPS = 1e-6f;
__device__ __forceinline__ u32x4 pack8(const f32x4& v0, const f32x4& v1) { u32x4 w; w.x = cvt_pk_bf16(v0[0], v0[1]); w.y = cvt_pk_bf16(v0[2], v0[3]); w.z = cvt_pk_bf16(v1[0], v1[1]); w.w = cvt_pk_bf16(v1[2], v1[3]); return w; }
__device__ __forceinline__ u32x2 pack4(const f32x4& v) { u32x2 w; w.x = cvt_pk_bf16(v[0], v[1]); w.y = cvt_pk_bf16(v[2], v[3]); return w; }

struct EpiQkvFox {
    static constexpr bool PERM = true, AFTER_DRAIN = false;
    unsigned char* ws; float qscale;
    __device__ __forceinline__ void operator()(const f32x4 (&acc)[2][2][4][2], const Unit& u, int wr, int wc, int fr, int fq) const {
        gbf16* Q = (gbf16*)((gu8*)ws + WS_Q); gbf16* Kp = (gbf16*)((gu8*)ws + WS_K); gbf16* V = (gbf16*)((gu8*)ws + WS_V);
        const int row0 = u.pm * BM + wr * 64 + fr;
        const int t = u.pn >> 2;
        const int cin0 = (u.pn & 3) * BM + wc * 32 + 8 * fq;
        const float sc = (t == 0) ? qscale : 1.f;
#pragma unroll
        for (int ai = 0; ai < 2; ++ai)
#pragma unroll
            for (int m = 0; m < 4; ++m) { const unsigned row = (unsigned)(row0 + ai * HALF + m * 16);
#pragma unroll
                for (int bj = 0; bj < 2; ++bj) { const int cin = cin0 + bj * HALF;
                    gbf16* dst = (t == 2) ? (V + row * 1024 + cin) : ((t == 0 ? Q : Kp) + row * 1280 + (cin >> 6) * 80 + (cin & 63));
                    *(GAS u32x4*)dst = pack8(acc[ai][bj][m][0] * sc, acc[ai][bj][m][1] * sc); } }
    }
};
struct EpiRelu2 {
    static constexpr bool PERM = true, AFTER_DRAIN = false;
    unsigned char* ws;
    __device__ __forceinline__ void operator()(const f32x4 (&acc)[2][2][4][2], const Unit& u, int wr, int wc, int fr, int fq) const {
        gbf16* H = (gbf16*)((gu8*)ws + WS_BIG);
        const int row0 = u.pm * BM + wr * 64 + fr; const int col0 = u.pn * BM + wc * 32 + 8 * fq;
#pragma unroll
        for (int ai = 0; ai < 2; ++ai)
#pragma unroll
            for (int m = 0; m < 4; ++m) { gbf16* rowp = H + (unsigned)(row0 + ai * HALF + m * 16) * 4096u + (unsigned)col0;
#pragma unroll
                for (int bj = 0; bj < 2; ++bj) { f32x4 v0 = acc[ai][bj][m][0], v1 = acc[ai][bj][m][1];
#pragma unroll
                    for (int j = 0; j < 4; ++j) { const float a = fmaxf(v0[j], 0.f), b = fmaxf(v1[j], 0.f); v0[j] = a * a; v1[j] = b * b; }
                    *(GAS u32x4*)(rowp + bj * HALF) = pack8(v0, v1); } }
    }
};
struct EpiResid {
    static constexpr bool PERM = false, AFTER_DRAIN = false;
    const float* base_; float* out_; const float* gate_;
    __device__ __forceinline__ void operator()(const f32x4 (&acc)[2][2][4][2], const Unit& u, int wr, int wc, int fr, int fq) const {
        const gf32* base = (const gf32*)base_; gf32* out = (gf32*)out_; const gf32* gate = (const gf32*)gate_;
        const int row0 = u.pm * BM + wr * 64 + fr; const int col0 = u.pn * BM + wc * 32 + 4 * fq;
        const gf32* gp = gate + (size_t)(u.pm >> 3) * 6144 + col0;
        f32x4 gv[2][2];
#pragma unroll
        for (int bj = 0; bj < 2; ++bj)
#pragma unroll
            for (int n = 0; n < 2; ++n) gv[bj][n] = *(const GAS f32x4*)(gp + bj * HALF + n * 16);
#pragma unroll
        for (int ai = 0; ai < 2; ++ai)
#pragma unroll
            for (int m = 0; m < 4; ++m) { const unsigned off = (unsigned)(row0 + ai * HALF + m * 16) * 1024u + (unsigned)col0;
#pragma unroll
                for (int bj = 0; bj < 2; ++bj)
#pragma unroll
                    for (int n = 0; n < 2; ++n) { const f32x4 bs = *(const GAS f32x4*)(base + off + bj * HALF + n * 16);
                        *(GAS f32x4*)(out + off + bj * HALF + n * 16) = bs + gv[bj][n] * acc[ai][bj][m][n]; } }
    }
};
struct EpiMlaKv {
    static constexpr bool PERM = true, AFTER_DRAIN = false;
    unsigned char* ws;
    __device__ __forceinline__ void operator()(const f32x4 (&acc)[2][2][4][2], const Unit& u, int wr, int wc, int fr, int fq) const {
        const gf32* ssq = (const gf32*)((gu8*)ws + WS_SSQKV); gbf16* Kp = (gbf16*)((gu8*)ws + WS_K); gbf16* V = (gbf16*)((gu8*)ws + WS_V);
        const int row0 = u.pm * BM + wr * 64 + fr;
        const int t = u.pn >> 2; const int cin0 = (u.pn & 3) * BM + wc * 32 + 8 * fq;
#pragma unroll
        for (int ai = 0; ai < 2; ++ai)
#pragma unroll
            for (int m = 0; m < 4; ++m) { const unsigned row = (unsigned)(row0 + ai * HALF + m * 16);
                const f32x4 s4 = *(const GAS f32x4*)(ssq + row * 4);
                const float rs = __builtin_amdgcn_rsqf(((s4[0] + s4[1]) + (s4[2] + s4[3])) * (1.0f / 128.0f) + RMS_EPS);
#pragma unroll
                for (int bj = 0; bj < 2; ++bj) { const int cin = cin0 + bj * HALF;
                    gbf16* dst = t ? (V + row * 1024 + cin) : (Kp + row * 1536 + (cin >> 6) * 96 + (cin & 63));
                    *(GAS u32x4*)dst = pack8(acc[ai][bj][m][0] * rs, acc[ai][bj][m][1] * rs); }
                asm volatile("" ::: "memory"); }
    }
};
struct EpiMlaQ {
    static constexpr bool PERM = false, AFTER_DRAIN = false;
    unsigned char* ws; float qscale;
    __device__ __forceinline__ void operator()(const f32x4 (&acc)[2][2][4][2], const Unit& u, int wr, int wc, int fr, int fq) const {
        const gf32* ssq = (const gf32*)((gu8*)ws + WS_SSQQ); const gf32* cst = (const gf32*)((gu8*)ws + WS_CS); gbf16* Q = (gbf16*)((gu8*)ws + WS_Q);
        const int row0 = u.pm * BM + wr * 64 + fr;
#pragma unroll
        for (int ai = 0; ai < 2; ++ai)
#pragma unroll
            for (int m = 0; m < 4; ++m) { const unsigned row = (unsigned)(row0 + ai * HALF + m * 16);
                const f32x4 s4 = *(const GAS f32x4*)(ssq + row * 4);
                const float rs = qscale * __builtin_amdgcn_rsqf(((s4[0] + s4[1]) + (s4[2] + s4[3])) * (1.0f / 256.0f) + RMS_EPS);
                if (u.pn < 4) {
#pragma unroll
                    for (int bj = 0; bj < 2; ++bj)
#pragma unroll
                        for (int n = 0; n < 2; ++n) { const int cin = u.pn * BM + bj * HALF + wc * 32 + n * 16 + 4 * fq;
                            *(GAS u32x2*)(Q + row * 1536 + (cin >> 6) * 96 + (cin & 63)) = pack4(acc[ai][bj][m][n] * rs); }
                } else {
                    const f32x4 cs = *(const GAS f32x4*)(cst + row * 32 + 4 * fq), sn = *(const GAS f32x4*)(cst + row * 32 + 16 + 4 * fq);
#pragma unroll
                    for (int bj = 0; bj < 2; ++bj) { const int head = ((u.pn - 4) * BM + bj * HALF + wc * 32) >> 5;
                        const f32x4 x1 = acc[ai][bj][m][0] * rs, x2 = acc[ai][bj][m][1] * rs;
                        gbf16* dst = Q + row * 1536 + head * 96 + 64 + 4 * fq;
                        *(GAS u32x2*)dst = pack4(x1 * cs - x2 * sn); *(GAS u32x2*)(dst + 16) = pack4(x2 * cs + x1 * sn); }
                }
                asm volatile("" ::: "memory");
            }
    }
};
struct EpiMlaDown {
    static constexpr bool PERM = false, AFTER_DRAIN = false;
    unsigned char* ws;
    __device__ __forceinline__ void operator()(const f32x4 (&acc)[2][2][4][2], const Unit& u, int wr, int wc, int fr, int fq) const {
        gbf16* cq = (gbf16*)((gu8*)ws + WS_CQ); gbf16* ckv = (gbf16*)((gu8*)ws + WS_CKV); gf32* ssqq = (gf32*)((gu8*)ws + WS_SSQQ); gf32* ssqkv = (gf32*)((gu8*)ws + WS_SSQKV); const gf32* cst = (const gf32*)((gu8*)ws + WS_CS); gbf16* Kp = (gbf16*)((gu8*)ws + WS_K);
        const int row0 = u.pm * BM + wr * 64 + fr;
#pragma unroll
        for (int ai = 0; ai < 2; ++ai)
#pragma unroll
            for (int m = 0; m < 4; ++m) { const unsigned row = (unsigned)(row0 + ai * HALF + m * 16);
                if (u.pn == 0) {
                    float ss = 0.f;
#pragma unroll
                    for (int bj = 0; bj < 2; ++bj)
#pragma unroll
                        for (int n = 0; n < 2; ++n) { const f32x4 v = acc[ai][bj][m][n]; ss += (v[0] * v[0] + v[1] * v[1]) + (v[2] * v[2] + v[3] * v[3]);
                            *(GAS u32x2*)(cq + row * 256 + bj * HALF + wc * 32 + n * 16 + 4 * fq) = pack4(v); }
                    ss += __shfl_xor(ss, 16); ss += __shfl_xor(ss, 32);
                    if (fq == 0) ssqq[row * 4 + wc] = ss;
                } else {
                    float ss = 0.f;
#pragma unroll
                    for (int n = 0; n < 2; ++n) { const f32x4 v = acc[ai][0][m][n]; ss += (v[0] * v[0] + v[1] * v[1]) + (v[2] * v[2] + v[3] * v[3]);
                        *(GAS u32x2*)(ckv + row * 128 + wc * 32 + n * 16 + 4 * fq) = pack4(v); }
                    ss += __shfl_xor(ss, 16); ss += __shfl_xor(ss, 32);
                    if (fq == 0) ssqkv[row * 4 + wc] = ss;
                    if (wc == 0) {
                        const f32x4 cs = *(const GAS f32x4*)(cst + row * 32 + 4 * fq), sn = *(const GAS f32x4*)(cst + row * 32 + 16 + 4 * fq);
                        const f32x4 x1 = acc[ai][1][m][0], x2 = acc[ai][1][m][1];
                        const u32x2 o1 = pack4(x1 * cs - x2 * sn), o2 = pack4(x2 * cs + x1 * sn);
                        gbf16* dst = Kp + row * 1536 + 64 + 4 * fq;
#pragma unroll
                        for (int hd = 0; hd < 16; ++hd) { *(GAS u32x2*)(dst + hd * 96) = o1; *(GAS u32x2*)(dst + hd * 96 + 16) = o2; }
                    }
                }
            }
    }
};

template <class Epi, class Sched, bool ALIGN_EPI = false, bool SP2 = false>
__device__ __forceinline__ void gemm_phase(PG8_LAS unsigned char* lds, const Gemm g, const Sched& S, const Epi& E) {
    int tid_ = threadIdx.x; asm volatile("" : "+v"(tid_));
    const int tid = tid_, wid = __builtin_amdgcn_readfirstlane(tid >> 6), lane = tid & 63, wr = wid >> 2, wc = wid & 3, fr = lane & 15, fq = lane >> 4;
    const int K = g.K, nt = K / BK;
    unsigned voffA[2], voffB[2];
#pragma unroll
    for (int i = 0; i < 2; ++i) { int R, C; stage_rc(tid * 16 + i * 8192, R, C); const int Rb = Epi::PERM ? ((R & ~31) + perm32(R & 31)) : R;
        voffA[i] = (unsigned)(R * K + C) * 2u; voffB[i] = (unsigned)(Rb * K + C) * 2u; }
    const size_t kstep = (size_t)(BK * 2);
    const size_t hstep = (size_t)HALF * K * 2;
    const size_t tstep = 2 * hstep;
    const unsigned ldsw = (unsigned)wid * 1024u;
    const int aoff = lds_byte(wr * 64 + fr, fq * 8), boff = lds_byte(wc * 32 + fr, fq * 8);
#define PG8_SA(b, h) (((b) * 2 + (h)) * HTB)
#define PG8_SB(b, h) ((4 + (b) * 2 + (h)) * HTB)
#define PG8_STAGE(bufoff, gbase, voff) do { _Pragma("unroll") for (int _i = 0; _i < 2; ++_i) \
        __builtin_amdgcn_global_load_lds((const unsigned*)((const char*)(gbase) + (voff)[_i]), (PG8_LAS unsigned*)(lds + (bufoff) + ldsw + _i * 8192), 16, 0, 0); } while (0)
#define PG8_LDA(dst, b, h) do { _Pragma("unroll") for (int m = 0; m < 4; ++m) _Pragma("unroll") for (int k = 0; k < 2; ++k) dst[m][k] = *(const PG8_LAS bf16x8*)(lds + PG8_SA(b, h) + aoff + m * 2048 + k * 1024); } while (0)
#define PG8_LDB(dst, b, h) do { _Pragma("unroll") for (int n = 0; n < 2; ++n) _Pragma("unroll") for (int k = 0; k < 2; ++k) dst[n][k] = *(const PG8_LAS bf16x8*)(lds + PG8_SB(b, h) + boff + n * 2048 + k * 1024); } while (0)
#define PG8_MMA(ai, bj, At, Bt) do { __builtin_amdgcn_s_setprio(1); _Pragma("unroll") for (int m = 0; m < 4; ++m) _Pragma("unroll") for (int n = 0; n < 2; ++n) _Pragma("unroll") for (int k = 0; k < 2; ++k) \
        acc[ai][bj][m][n] = __builtin_amdgcn_mfma_f32_16x16x32_bf16(Bt[n][k], At[m][k], acc[ai][bj][m][n], 0, 0, 0); __builtin_amdgcn_s_setprio(0); } while (0)
#define PG8_WAIT_V(n) asm volatile("s_waitcnt vmcnt(" #n ")" ::: "memory")
#define PG8_WAIT_L(n) asm volatile("s_waitcnt lgkmcnt(" #n ")" ::: "memory")
#define PG8_BAR __builtin_amdgcn_s_barrier()
#define PG8_SCHED __builtin_amdgcn_sched_barrier(0)
    Unit cur, nxt; int ui = 0;
    if (!S.next(0, cur)) return;
    f32x4 acc[2][2][4][2];
#pragma unroll
    for (int a = 0; a < 2; ++a)
#pragma unroll
        for (int b = 0; b < 2; ++b)
#pragma unroll
            for (int m = 0; m < 4; ++m)
#pragma unroll
                for (int n = 0; n < 2; ++n) acc[a][b][m][n] = (f32x4){0.f, 0.f, 0.f, 0.f};
    bf16x8 At[4][2], B0[2][2], B1[2][2];
    const char* cA = (const char*)g.A + (size_t)cur.pm * tstep; const char* cB = (const char*)g.Bt + (size_t)cur.pn * tstep;
    S.a_ready(cur);
    if constexpr (SP2) {
        PG8_STAGE(PG8_SB(0, 0), cB, voffB); PG8_STAGE(PG8_SB(0, 1), cB + hstep, voffB); PG8_STAGE(PG8_SA(0, 0), cA, voffA); PG8_STAGE(PG8_SA(0, 1), cA + hstep, voffA);
        if (wr == 1) PG8_BAR;
        PG8_WAIT_V(2); PG8_BAR;
        PG8_STAGE(PG8_SB(1, 0), cB + kstep, voffB); PG8_STAGE(PG8_SA(1, 0), cA + kstep, voffA); PG8_STAGE(PG8_SB(1, 1), cB + hstep + kstep, voffB);
        PG8_WAIT_V(6); PG8_BAR;
    } else {
        PG8_STAGE(PG8_SB(0, 0), cB, voffB); PG8_STAGE(PG8_SA(0, 0), cA, voffA); PG8_STAGE(PG8_SB(0, 1), cB + hstep, voffB); PG8_STAGE(PG8_SA(0, 1), cA + hstep, voffA);
        if (wr == 1) PG8_BAR;
        PG8_WAIT_V(4); PG8_BAR;
        PG8_STAGE(PG8_SB(1, 0), cB + kstep, voffB); PG8_STAGE(PG8_SA(1, 0), cA + kstep, voffA); PG8_STAGE(PG8_SB(1, 1), cB + hstep + kstep, voffB);
        PG8_WAIT_V(6); PG8_BAR;
    }
    for (;;) {
        const bool has_next = S.next(ui + 1, nxt);
        const char* nA = has_next ? (const char*)g.A + (size_t)nxt.pm * tstep : cA; const char* nB = has_next ? (const char*)g.Bt + (size_t)nxt.pn * tstep : cB;
        for (int t = 0; t < nt; t += 2) {
            const bool last = (t == nt - 2);
            const char* a1 = cA + (size_t)(t + 1) * kstep;
            const char* a2 = last ? nA : cA + (size_t)(t + 2) * kstep; const char* b2 = last ? nB : cB + (size_t)(t + 2) * kstep;
            const char* a3 = a2 + kstep; const char* b3 = b2 + kstep;
            if (last && has_next) S.a_ready(nxt);
            if constexpr (SP2) {
            PG8_LDB(B0, 0, 0); PG8_LDB(B1, 0, 1); PG8_SCHED; PG8_LDA(At, 0, 0); PG8_STAGE(PG8_SA(1, 1), a1 + hstep, voffA);
            PG8_WAIT_V(8); PG8_WAIT_L(0); PG8_BAR; PG8_MMA(0, 0, At, B0); PG8_MMA(0, 1, At, B1); PG8_BAR; PG8_SCHED;
            PG8_LDA(At, 0, 1); PG8_STAGE(PG8_SB(0, 0), b2, voffB); PG8_STAGE(PG8_SB(0, 1), b2 + hstep, voffB); PG8_STAGE(PG8_SA(0, 0), a2, voffA);
            PG8_WAIT_V(8); PG8_WAIT_L(0); PG8_BAR; PG8_MMA(1, 0, At, B0); PG8_MMA(1, 1, At, B1); PG8_BAR; PG8_SCHED;
            PG8_LDB(B0, 1, 0); PG8_LDB(B1, 1, 1); PG8_SCHED; PG8_LDA(At, 1, 0); PG8_STAGE(PG8_SA(0, 1), a2 + hstep, voffA);
            PG8_WAIT_V(8); PG8_WAIT_L(0); PG8_BAR; PG8_MMA(0, 0, At, B0); PG8_MMA(0, 1, At, B1); PG8_BAR; PG8_SCHED;
            PG8_LDA(At, 1, 1); PG8_STAGE(PG8_SB(1, 0), b3, voffB); PG8_STAGE(PG8_SB(1, 1), b3 + hstep, voffB); PG8_STAGE(PG8_SA(1, 0), a3, voffA);
            PG8_WAIT_V(8); PG8_WAIT_L(0); PG8_BAR; PG8_MMA(1, 0, At, B0); PG8_MMA(1, 1, At, B1); PG8_BAR; PG8_SCHED;
            } else {
            PG8_LDB(B0, 0, 0); PG8_SCHED; PG8_LDA(At, 0, 0); PG8_STAGE(PG8_SA(1, 1), a1 + hstep, voffA);
            PG8_WAIT_L(8); PG8_BAR; PG8_WAIT_L(0); PG8_MMA(0, 0, At, B0); PG8_BAR; PG8_SCHED;
            PG8_LDB(B1, 0, 1); PG8_STAGE(PG8_SB(0, 0), b2, voffB);
            PG8_BAR; PG8_WAIT_L(0); PG8_MMA(0, 1, At, B1); PG8_BAR;
            PG8_LDA(At, 0, 1); PG8_STAGE(PG8_SA(0, 0), a2, voffA);
            PG8_BAR; PG8_WAIT_L(0); PG8_MMA(1, 0, At, B0); PG8_BAR; PG8_SCHED;
            PG8_STAGE(PG8_SB(0, 1), b2 + hstep, voffB);
            PG8_WAIT_V(6); PG8_BAR; PG8_MMA(1, 1, At, B1); PG8_BAR;
            PG8_LDB(B0, 1, 0); PG8_SCHED; PG8_LDA(At, 1, 0); PG8_STAGE(PG8_SA(0, 1), a2 + hstep, voffA);
            PG8_WAIT_L(8); PG8_BAR; PG8_WAIT_L(0); PG8_MMA(0, 0, At, B0); PG8_BAR; PG8_SCHED;
            PG8_LDB(B1, 1, 1); PG8_STAGE(PG8_SB(1, 0), b3, voffB);
            PG8_BAR; PG8_WAIT_L(0); PG8_MMA(0, 1, At, B1); PG8_BAR;
            PG8_LDA(At, 1, 1); PG8_STAGE(PG8_SA(1, 0), a3, voffA);
            PG8_BAR; PG8_WAIT_L(0); PG8_MMA(1, 0, At, B0); PG8_BAR; PG8_SCHED;
            PG8_STAGE(PG8_SB(1, 1), b3 + hstep, voffB);
            PG8_WAIT_V(6); PG8_BAR; PG8_MMA(1, 1, At, B1); PG8_BAR;
            }
        }
        if constexpr (ALIGN_EPI) { if (wr == 0) PG8_BAR; }
        if constexpr (!Epi::AFTER_DRAIN) { E(acc, cur, wr, wc, fr, fq); S.done(cur); }
        if (!has_next) break;
#pragma unroll
        for (int a = 0; a < 2; ++a)
#pragma unroll
            for (int b = 0; b < 2; ++b)
#pragma unroll
                for (int m = 0; m < 4; ++m)
#pragma unroll
                    for (int n = 0; n < 2; ++n) acc[a][b][m][n] = (f32x4){0.f, 0.f, 0.f, 0.f};
        cur = nxt; cA = nA; cB = nB; ++ui;
        if constexpr (ALIGN_EPI) { if (wr == 1) PG8_BAR; }
    }
    PG8_WAIT_V(0);
    if constexpr (!ALIGN_EPI) { if (wr == 0) PG8_BAR; }
    PG8_BAR;
    if constexpr (Epi::AFTER_DRAIN) { E.fused(acc, cur, wr, wc, fr, fq, lds, wid, lane); S.done(cur); }
#undef PG8_SA
#undef PG8_SB
#undef PG8_STAGE
#undef PG8_LDA
#undef PG8_LDB
#undef PG8_MMA
#undef PG8_WAIT_V
#undef PG8_WAIT_L
#undef PG8_BAR
#undef PG8_SCHED
}
}

__device__ __forceinline__ int obid() { int b = blockIdx.x; asm volatile("" : "+s"(b)); return b; }
__device__ __forceinline__ int ogrid() { int g = gridDim.x; asm volatile("" : "+s"(g)); return g; }
__device__ __forceinline__ float wave_sum(float v) {
#pragma unroll
    for (int o = 1; o < 64; o <<= 1) v += __shfl_xor(v, o);
    return v;
}
__device__ __forceinline__ unsigned f2bf(float f) { unsigned u = __builtin_bit_cast(unsigned, f); return (u + 0x7fffu + ((u >> 16) & 1u)) >> 16; }
__device__ __forceinline__ unsigned pk2(float lo, float hi) { return f2bf(lo) | (f2bf(hi) << 16); }
__device__ __forceinline__ float bf2f(unsigned b) { return __builtin_bit_cast(float, b << 16); }

__device__ __forceinline__ void transpose_item(const float* W, int ld, int K, int N, bf16* WT, int map, int drow0, const float* gk, LAS float* scr, int item, int lane) {
    const int nblk = N / 32, kb = item / nblk, nb = item % nblk, k0 = 64 * kb, n0 = 32 * nb;
    int drow;
    if (map == 1) { const int hd = n0 / 96, d = n0 % 96; drow = (d < 64) ? hd * 64 + d : 1024 + hd * 32 + (d - 64); }
    else if (map == 2) { const int hd = n0 / 128, d = n0 % 128; drow = (d < 64) ? hd * 64 + d : 1024 + hd * 64 + (d - 64); }
    else drow = drow0 + n0;
#pragma unroll 8
    for (int i = 0; i < 32; ++i) { const int kk = 2 * i + (lane >> 5); float v = W[(size_t)(k0 + kk) * ld + n0 + (lane & 31)]; if (gk) v *= gk[k0 + kk]; scr[kk * 33 + (lane & 31)] = v; }
    asm volatile("s_waitcnt lgkmcnt(0)" ::: "memory");
    const int c = lane & 7;
#pragma unroll
    for (int j = 0; j < 4; ++j) { const int n = (lane >> 3) + 8 * j; const LAS float* s = scr + (8 * c) * 33 + n;
        u32x4 o; o.x = pk2(s[0 * 33], s[1 * 33]); o.y = pk2(s[2 * 33], s[3 * 33]); o.z = pk2(s[4 * 33], s[5 * 33]); o.w = pk2(s[6 * 33], s[7 * 33]);
        *(u32x4*)(WT + (size_t)(drow + n) * K + k0 + 8 * c) = o; }
    asm volatile("s_waitcnt lgkmcnt(0)" ::: "memory");
}

struct Params { const float* in[20]; float* out; unsigned char* ws; };
enum { I_X = 0, I_C, I_POS, I_ADAW, I_ADAB, I_GMIX, I_GMLP, I_FWIN, I_FBF, I_FWOUT, I_MDQ, I_MQG, I_MUQ, I_MDKV, I_MKVG, I_MUKV, I_MOUT, I_W1, I_W2, I_GFIN };

__device__ __forceinline__ void prologue(const Params& p, LAS unsigned char* lds) {
    const int BID = obid(), GSZ = ogrid(); int tid_ = threadIdx.x; asm volatile("" : "+v"(tid_));
    const int tid = tid_, lane = tid & 63, wave = __builtin_amdgcn_readfirstlane(tid >> 6);
    unsigned char* ws = p.ws;
    {
        LAS float* cact = (LAS float*)lds;
        LAS float* part = (LAS float*)(lds + 65536);
        const float* c = p.in[I_C];
        for (int idx = tid; idx < NB * DM; idx += NTHR) { const int b = idx >> 10, k = idx & 1023; const float v = c[idx]; cact[k * 16 + b] = v / (1.0f + __expf(-v)); }
        __syncthreads();
        float* mod = (float*)(ws + WS_MOD);
        for (int item = BID; item < 4 * 48; item += GSZ) {
            const int l = item / 48, n0 = (item % 48) * 128, col = tid & 127, ks = tid >> 7;
            float acc[16];
#pragma unroll
            for (int b = 0; b < 16; ++b) acc[b] = 0.f;
            const float* wp = p.in[I_ADAW] + ((size_t)l * DM + ks * 256) * 6144 + n0 + col;
            const LAS f32x4* cp = (const LAS f32x4*)(cact + ks * 256 * 16);
#pragma unroll 8
            for (int k = 0; k < 256; ++k) { const float w = wp[(size_t)k * 6144];
                const f32x4 c0 = cp[k * 4 + 0], c1 = cp[k * 4 + 1], c2 = cp[k * 4 + 2], c3 = cp[k * 4 + 3];
                acc[0] += w * c0[0]; acc[1] += w * c0[1]; acc[2] += w * c0[2]; acc[3] += w * c0[3];
                acc[4] += w * c1[0]; acc[5] += w * c1[1]; acc[6] += w * c1[2]; acc[7] += w * c1[3];
                acc[8] += w * c2[0]; acc[9] += w * c2[1]; acc[10] += w * c2[2]; acc[11] += w * c2[3];
                acc[12] += w * c3[0]; acc[13] += w * c3[1]; acc[14] += w * c3[2]; acc[15] += w * c3[3]; }
#pragma unroll
            for (int b = 0; b < 16; ++b) part[(ks * 16 + b) * 128 + col] = acc[b];
            __syncthreads();
            for (int o = tid; o < 2048; o += NTHR) { const int b = o >> 7, cc = o & 127;
                const float s = (part[(0 * 16 + b) * 128 + cc] + part[(1 * 16 + b) * 128 + cc]) + (part[(2 * 16 + b) * 128 + cc] + part[(3 * 16 + b) * 128 + cc]);
                mod[((size_t)l * 16 + b) * 6144 + n0 + cc] = s + p.in[I_ADAB][(size_t)l * 6144 + n0 + cc]; }
            __syncthreads();
        }
    }
    __syncthreads();
    {
        const int* pos = (const int*)p.in[I_POS]; float* cst = (float*)(ws + WS_CS);
        for (size_t idx = (size_t)BID * NTHR + tid; idx < (size_t)M * 16; idx += (size_t)GSZ * NTHR) {
            const int tok = (int)(idx >> 4), i = (int)(idx & 15);
            const float invf = exp2f(-(float)i * (13.287712379549449f / 16.0f));
            const float ang = (float)pos[tok] * invf;
            double rev = (double)ang * 0.15915494309189535; rev -= __builtin_rint(rev);
            const float rf = (float)rev;
            cst[(size_t)tok * 32 + i] = __builtin_amdgcn_cosf(rf); cst[(size_t)tok * 32 + 16 + i] = __builtin_amdgcn_sinf(rf);
        }
    }
    for (int j = 0; j < 2; ++j) { u32x4* z = (u32x4*)(ws + WS_W + W_MLA + j * W_MLA_STRIDE + (size_t)416 * 1024 * 2);
        for (int idx = BID * NTHR + tid; idx < 96 * 1024 * 2 / 16; idx += GSZ * NTHR) z[idx] = (u32x4){0u, 0u, 0u, 0u}; }
    {
        LAS float* scr = (LAS float*)(lds + wave * 16384);
        const int gw = BID * NWAVE + wave, NGW = GSZ * NWAVE;
        constexpr int N_MLP = 4 * 4096, N_FOX = 2 * 2048, N_MLA = 2 * 1040;
        for (int it = gw; it < N_MLP + N_FOX + N_MLA; it += NGW) {
            int r = it;
            if (r < N_MLP) { const int l = r >> 12, rr = r & 4095; bf16* wb = (bf16*)(ws + WS_W + W_MLP + (size_t)l * W_MLP_STRIDE);
                if (rr < 2048) transpose_item(p.in[I_W1] + (size_t)l * DM * FF, FF, DM, FF, wb, 0, 0, nullptr, scr, rr, lane);
                else transpose_item(p.in[I_W2] + (size_t)l * DM * FF, DM, FF, DM, wb + (size_t)FF * DM, 0, 0, nullptr, scr, rr - 2048, lane);
                continue; }
            r -= N_MLP;
            if (r < N_FOX) { const int j = r >> 11, rr = r & 2047; bf16* wb = (bf16*)(ws + WS_W + W_FOX + (size_t)j * W_FOX_STRIDE);
                if (rr < 1536) transpose_item(p.in[I_FWIN] + (size_t)j * DM * 3088, 3088, DM, 3072, wb, 0, 0, nullptr, scr, rr, lane);
                else transpose_item(p.in[I_FWOUT] + (size_t)j * DM * DM, DM, DM, DM, wb + (size_t)3072 * DM, 0, 0, nullptr, scr, rr - 1536, lane);
                continue; }
            r -= N_FOX;
            { const int j = r / 1040, rr = r % 1040; bf16* wb = (bf16*)(ws + WS_W + W_MLA + (size_t)j * W_MLA_STRIDE);
                if (rr < 128) transpose_item(p.in[I_MDQ] + (size_t)j * DM * 256, 256, DM, 256, wb, 0, 0, nullptr, scr, rr, lane);
                else if (rr < 208) transpose_item(p.in[I_MDKV] + (size_t)j * DM * 160, 160, DM, 160, wb, 0, 256, nullptr, scr, rr - 128, lane);
                else if (rr < 400) transpose_item(p.in[I_MUQ] + (size_t)j * 256 * 1536, 1536, 256, 1536, wb + (size_t)512 * 1024, 1, 0, p.in[I_MQG] + j * 256, scr, rr - 208, lane);
                else if (rr < 528) transpose_item(p.in[I_MUKV] + (size_t)j * 128 * 2048, 2048, 128, 2048, wb + (size_t)512 * 1024 + (size_t)1536 * 256, 2, 0, p.in[I_MKVG] + j * 128, scr, rr - 400, lane);
                else transpose_item(p.in[I_MOUT] + (size_t)j * DM * DM, DM, DM, DM, (bf16*)((unsigned char*)wb + 3 * MiB), 0, 0, nullptr, scr, rr - 528, lane);
            }
        }
    }
}

__device__ __forceinline__ void norm_phase(const float* x, const float* g, const float* sh0, const float* sc0, bf16* hout, bool gates, const float* wfsrc, const float* bfv, float* lf, LAS unsigned char* lds) {
    const int BID = obid(), GSZ = ogrid(); int tid_ = threadIdx.x; asm volatile("" : "+v"(tid_));
    const int tid = tid_, lane = tid & 63, wave = __builtin_amdgcn_readfirstlane(tid >> 6);
    LAS float* wfs = (LAS float*)lds;
    if (gates) {
        for (int idx = tid; idx < 16 * 1024; idx += NTHR) { const int k = idx >> 4, j = idx & 15; wfs[j * 1024 + k] = wfsrc[(size_t)k * 3088 + 3072 + j]; }
        __syncthreads();
    }
    const int gw = BID * NWAVE + wave, NGW = GSZ * NWAVE;
    for (int row = gw; row < M; row += NGW) {
        const int b = row >> 11;
        const f32x4* xr = (const f32x4*)(x + (size_t)row * DM) + lane;
        f32x4 v[4]; float ss = 0.f;
#pragma unroll
        for (int j = 0; j < 4; ++j) { v[j] = xr[64 * j]; ss += (v[j][0] * v[j][0] + v[j][1] * v[j][1]) + (v[j][2] * v[j][2] + v[j][3] * v[j][3]); }
        const float rstd = __builtin_amdgcn_rsqf(wave_sum(ss) * (1.0f / DM) + EPS);
        const f32x4* gp = (const f32x4*)g + lane; const f32x4* shp = (const f32x4*)(sh0 + (size_t)b * 6144) + lane; const f32x4* scp = (const f32x4*)(sc0 + (size_t)b * 6144) + lane;
        u32x2* o8 = (u32x2*)(hout + (size_t)row * DM) + lane;
#pragma unroll
        for (int j = 0; j < 4; ++j) { const f32x4 gg = gp[64 * j], sc = scp[64 * j], sh = shp[64 * j];
            v[j] = (v[j] * rstd) * gg * (sc + 1.0f) + sh;
            u32x2 w; w.x = pk2(v[j][0], v[j][1]); w.y = pk2(v[j][2], v[j][3]); o8[64 * j] = w; }
        if (gates) {
            float myz = 0.f;
#pragma unroll
            for (int jg = 0; jg < 16; ++jg) {
                float z = 0.f;
#pragma unroll
                for (int jj = 0; jj < 4; ++jj) { const f32x4 w = *(const LAS f32x4*)(wfs + jg * 1024 + 256 * jj + 4 * lane); z += (v[jj][0] * w[0] + v[jj][1] * w[1]) + (v[jj][2] * w[2] + v[jj][3] * w[3]); }
                z = wave_sum(z);
                if (lane == jg) myz = z;
            }
            if (lane < 16) { const float z = myz + bfv[lane]; lf[(size_t)row * 16 + lane] = fminf(z, 0.f) - __logf(1.0f + __expf(-fabsf(z))); }
        }
    }
}

__device__ __forceinline__ void final_norm(float* x, const float* g) {
    const int BID = obid(), GSZ = ogrid(); int tid_ = threadIdx.x; asm volatile("" : "+v"(tid_));
    const int tid = tid_, lane = tid & 63, wave = __builtin_amdgcn_readfirstlane(tid >> 6);
    const int gw = BID * NWAVE + wave, NGW = GSZ * NWAVE;
    for (int row = gw; row < M; row += NGW) {
        f32x4* xr = (f32x4*)(x + (size_t)row * DM) + lane;
        f32x4 v[4]; float ss = 0.f;
#pragma unroll
        for (int j = 0; j < 4; ++j) { v[j] = xr[64 * j]; ss += (v[j][0] * v[j][0] + v[j][1] * v[j][1]) + (v[j][2] * v[j][2] + v[j][3] * v[j][3]); }
        const float rstd = __builtin_amdgcn_rsqf(wave_sum(ss) * (1.0f / DM) + EPS);
        const f32x4* gp = (const f32x4*)g + lane;
#pragma unroll
        for (int j = 0; j < 4; ++j) xr[64 * j] = (v[j] * rstd) * gp[64 * j];
    }
}

__device__ __forceinline__ void fox_cumsum(const float* lf, bf16* Qb, bf16* Kb, LAS unsigned char* lds) {
    const int BID = obid(), GSZ = ogrid(); int tid_ = threadIdx.x; asm volatile("" : "+v"(tid_));
    const int tid = tid_, lane = tid & 63, wave = __builtin_amdgcn_readfirstlane(tid >> 6);
    LAS float* wtot = (LAS float*)lds;
    for (int bh = BID; bh < NB * NH; bh += GSZ) {
        const int b = bh >> 4, h = bh & 15; const int s0 = 4 * tid;
        float a[4];
#pragma unroll
        for (int i = 0; i < 4; ++i) a[i] = lf[((size_t)(b * SEQ + s0 + i)) * 16 + h];
        a[1] += a[0]; a[2] += a[1]; a[3] += a[2];
        float xs = a[3];
#pragma unroll
        for (int off = 1; off < 64; off <<= 1) { const float t = __shfl_up(xs, off); if (lane >= off) xs += t; }
        if (lane == 63) wtot[wave] = xs;
        __syncthreads();
        float base = 0.f;
#pragma unroll
        for (int w = 0; w < NWAVE; ++w) { const float t = wtot[w]; if (w < wave) base += t; }
        const float excl = xs - a[3] + base;
#pragma unroll
        for (int i = 0; i < 4; ++i) {
            const float F = (a[i] + excl) * LOG2E;
            const unsigned fh = f2bf(F); const float r1 = F - bf2f(fh); const unsigned fm = f2bf(r1); const float r2 = r1 - bf2f(fm); const unsigned fl = f2bf(r2);
            const size_t tok = (size_t)(b * SEQ + s0 + i);
            u32x4* qd = (u32x4*)(Qb + tok * 1280 + h * 80 + 64); u32x4* kd = (u32x4*)(Kb + tok * 1280 + h * 80 + 64);
            unsigned zz = 0u; asm volatile("" : "+v"(zz));
            qd[0] = (u32x4){0x3F803F80u, 0x3F80u | (fh << 16), fm | (fl << 16), zz}; qd[1] = (u32x4){zz, zz, zz, zz};
            kd[0] = (u32x4){(fh ^ 0x8000u) | ((fm ^ 0x8000u) << 16), (fl ^ 0x8000u) | (0x3F80u << 16), 0x3F803F80u, zz}; kd[1] = (u32x4){zz, zz, zz, zz};
        }
        __syncthreads();
    }
}

__device__ __forceinline__ int crow(int r, int hi) { return (r & 3) + 8 * (r >> 2) + 4 * hi; }
__device__ __forceinline__ unsigned cvtpk(float lo, float hi) { typedef __bf16 bf16x2_t __attribute__((ext_vector_type(2))); f32x2 v = {lo, hi}; bf16x2_t b = __builtin_convertvector(v, bf16x2_t); return __builtin_bit_cast(unsigned, b); }
typedef short v4i16_t __attribute__((ext_vector_type(4)));
__device__ __forceinline__ s16x4 vtr(const LAS unsigned char* p) { return __builtin_bit_cast(s16x4, __builtin_amdgcn_ds_read_tr16_b64_v4i16((LAS v4i16_t*)p)); }
#define MFMA32(a, b, c) __builtin_amdgcn_mfma_f32_32x32x16_bf16((a), (b), (c), 0, 0, 0)

template <int NKS>
__device__ __forceinline__ void attn_phase(LAS unsigned char* lds, const bf16* Q, const bf16* K, const bf16* V, bf16* O) {
    constexpr int QKD = 16 * NKS, QP = 16 * QKD, RS = QKD * 2 + 16, KCH = QKD / 8, NKC = 64 * KCH;
    constexpr int KB_BYTES = 64 * RS, L_K = 0, L_V = 2 * KB_BYTES, L_WS = L_V + 2 * 8192, L_ST = L_WS + NWAVE * 128;
    static_assert(L_ST + NWAVE * 4096 <= LDS_BYTES, "attention LDS");
    const int BID = obid(), GSZ = ogrid(); int tid_ = threadIdx.x; asm volatile("" : "+v"(tid_));
    const int tid = tid_, lane = tid & 63, r32 = lane & 31, hi = lane >> 5; const int wid = __builtin_amdgcn_readfirstlane(tid >> 6);
    LAS float* wsf = (LAS float*)(lds + L_WS) + wid * 32;
    LAS bf16* stg = (LAS bf16*)(lds + L_ST) + wid * 2048;
    const int kr0 = tid / KCH, kc0 = tid % KCH, kr1 = (tid + 512) / KCH, kc1 = (tid + 512) % KCH; const bool has1 = (tid + 512) < NKC;
    const int vr = tid >> 3, vc = tid & 7;
    const int kl0 = kr0 * RS + kc0 * 16, kl1 = kr1 * RS + kc1 * 16;
    const int vl = vr * 128 + ((((vc >> 2) ^ ((vr >> 1) & 1))) * 64) + (vc & 3) * 16;
    const int kfb = r32 * RS + hi * 16;
    const int i16 = lane & 15, qq = i16 >> 2, pp = i16 & 3, blk = (lane >> 4) & 1, swz = (qq >> 1) & 1;
    const int vfb0 = (4 * hi + qq) * 128 + 32 * blk + 8 * pp + swz * 64, vfb1 = (4 * hi + qq) * 128 + 32 * blk + 8 * pp + (swz ^ 1) * 64;
    for (int bh = BID; bh < NB * NH; bh += GSZ) {
        const int b = bh >> 4, h = bh & 15; const size_t rowbase = (size_t)b * SEQ;
        const bf16* Kh = K + rowbase * QP + h * QKD; const bf16* Vh = V + rowbase * DM + h * 64;
        for (int qi = 0; qi < SEQ / 256; ++qi) {
            const int qb = (SEQ / 256 - 1) - qi; const int q0 = qb * 256; const int NT = 4 * qb + 4; const int NTw = 4 * qb + (wid >> 1) + 1;
            const int qabs = q0 + wid * 32 + r32;
            const bf16* Qw = Q + (rowbase + qabs) * QP + h * QKD + hi * 8;
            bf16x8 qr[NKS];
#pragma unroll
            for (int ks = 0; ks < NKS; ++ks) qr[ks] = *(const bf16x8*)(Qw + ks * 16);
            u32x4 ka, kb2, va;
            ka = *(const u32x4*)(Kh + (size_t)kr0 * QP + kc0 * 8); if (has1) kb2 = *(const u32x4*)(Kh + (size_t)kr1 * QP + kc1 * 8);
            va = *(const u32x4*)(Vh + (size_t)vr * DM + vc * 8);
            *(LAS u32x4*)(lds + L_K + kl0) = ka; if (has1) *(LAS u32x4*)(lds + L_K + kl1) = kb2; *(LAS u32x4*)(lds + L_V + vl) = va;
            __syncthreads();
            float mrow = -1e30f, lrow = 0.f; f32x16 o0, o1;
#pragma unroll
            for (int i = 0; i < 16; ++i) { o0[i] = 0.f; o1[i] = 0.f; }
            for (int t = 0; t < NT; ++t) {
                const int buf = t & 1;
                const bool more = (t + 1 < NT);
                if (more) { const size_t ro = (size_t)(t + 1) * 64;
                    ka = *(const u32x4*)(Kh + (ro + kr0) * QP + kc0 * 8); if (has1) kb2 = *(const u32x4*)(Kh + (ro + kr1) * QP + kc1 * 8);
                    va = *(const u32x4*)(Vh + (ro + vr) * DM + vc * 8); }
                if (t < NTw) {
                    const LAS unsigned char* Kl = lds + L_K + buf * KB_BYTES + kfb; const LAS unsigned char* Vl = lds + L_V + buf * 8192;
                    f32x16 p0, p1;
#pragma unroll
                    for (int i = 0; i < 16; ++i) { p0[i] = 0.f; p1[i] = 0.f; }
#pragma unroll
                    for (int ks = 0; ks < NKS; ++ks) { const bf16x8 a0 = *(const LAS bf16x8*)(Kl + ks * 32), a1 = *(const LAS bf16x8*)(Kl + 32 * RS + ks * 32);
                        p0 = MFMA32(a0, qr[ks], p0); p1 = MFMA32(a1, qr[ks], p1); }
                    if (64 * t + 63 > q0 + wid * 32) {
                        const int kb0 = 64 * t + 4 * hi;
#pragma unroll
                        for (int i = 0; i < 16; ++i) { const int kv = kb0 + (i & 3) + 8 * (i >> 2); if (kv > qabs) p0[i] = -INFINITY; if (kv + 32 > qabs) p1[i] = -INFINITY; }
                    }
                    float rm = fmaxf(p0[0], p1[0]);
#pragma unroll
                    for (int i = 1; i < 16; ++i) rm = fmaxf(rm, fmaxf(p0[i], p1[i]));
                    rm = fmaxf(rm, __shfl_xor(rm, 32));
                    const float mn = fmaxf(mrow, rm); const float alpha = __builtin_amdgcn_exp2f(mrow - mn); mrow = mn;
                    float ls = 0.f;
#pragma unroll
                    for (int i = 0; i < 16; ++i) { p0[i] = __builtin_amdgcn_exp2f(p0[i] - mn); p1[i] = __builtin_amdgcn_exp2f(p1[i] - mn); ls += p0[i] + p1[i]; }
                    lrow = lrow * alpha + ls;
                    if (!__all(alpha == 1.0f)) {
                        if (hi == 0) wsf[r32] = alpha;
                        asm volatile("" ::: "memory");
#pragma unroll
                        for (int g4 = 0; g4 < 4; ++g4) { const f32x4 a = *(const LAS f32x4*)(wsf + 8 * g4 + 4 * hi);
#pragma unroll
                            for (int j = 0; j < 4; ++j) { o0[4 * g4 + j] *= a[j]; o1[4 * g4 + j] *= a[j]; } }
                    }
                    bf16x8 PA[4];
                    { u32x4 w;
                      w = (u32x4){cvtpk(p0[0], p0[1]), cvtpk(p0[2], p0[3]), cvtpk(p0[4], p0[5]), cvtpk(p0[6], p0[7])}; PA[0] = __builtin_bit_cast(bf16x8, w);
                      w = (u32x4){cvtpk(p0[8], p0[9]), cvtpk(p0[10], p0[11]), cvtpk(p0[12], p0[13]), cvtpk(p0[14], p0[15])}; PA[1] = __builtin_bit_cast(bf16x8, w);
                      w = (u32x4){cvtpk(p1[0], p1[1]), cvtpk(p1[2], p1[3]), cvtpk(p1[4], p1[5]), cvtpk(p1[6], p1[7])}; PA[2] = __builtin_bit_cast(bf16x8, w);
                      w = (u32x4){cvtpk(p1[8], p1[9]), cvtpk(p1[10], p1[11]), cvtpk(p1[12], p1[13]), cvtpk(p1[14], p1[15])}; PA[3] = __builtin_bit_cast(bf16x8, w); }
#pragma unroll
                    for (int kk = 0; kk < 4; ++kk) {
                        const s16x4 l0 = vtr(Vl + vfb0 + kk * 2048), h0 = vtr(Vl + vfb0 + kk * 2048 + 1024);
                        const s16x4 l1 = vtr(Vl + vfb1 + kk * 2048), h1 = vtr(Vl + vfb1 + kk * 2048 + 1024);
                        const bf16x8 b0 = (bf16x8){l0[0], l0[1], l0[2], l0[3], h0[0], h0[1], h0[2], h0[3]};
                        const bf16x8 b1 = (bf16x8){l1[0], l1[1], l1[2], l1[3], h1[0], h1[1], h1[2], h1[3]};
                        o0 = MFMA32(PA[kk], b0, o0); o1 = MFMA32(PA[kk], b1, o1);
                    }
                }
                if (more) { const int nb = buf ^ 1;
                    *(LAS u32x4*)(lds + L_K + nb * KB_BYTES + kl0) = ka; if (has1) *(LAS u32x4*)(lds + L_K + nb * KB_BYTES + kl1) = kb2; *(LAS u32x4*)(lds + L_V + nb * 8192 + vl) = va; }
                __syncthreads();
            }
            lrow += __shfl_xor(lrow, 32);
            if (hi == 0) wsf[r32] = 1.0f / lrow;
            asm volatile("" ::: "memory");
#pragma unroll
            for (int g4 = 0; g4 < 4; ++g4) { const f32x4 a = *(const LAS f32x4*)(wsf + 8 * g4 + 4 * hi);
#pragma unroll
                for (int j = 0; j < 4; ++j) { const int i = 4 * g4 + j; const int orow = crow(i, hi);
                    stg[orow * 64 + r32] = (bf16)f2bf(o0[i] * a[j]); stg[orow * 64 + 32 + r32] = (bf16)f2bf(o1[i] * a[j]); } }
            asm volatile("s_waitcnt lgkmcnt(0)" ::: "memory");
            bf16* Ow = O + (rowbase + q0 + wid * 32) * DM + h * 64;
#pragma unroll
            for (int i = 0; i < 4; ++i) { const int row = i * 8 + (lane >> 3), ch = lane & 7; const u32x4 v = *(const LAS u32x4*)(stg + row * 64 + ch * 8); *(u32x4*)(Ow + (size_t)row * DM + ch * 8) = v; }
            __syncthreads();
        }
    }
}

constexpr int PTR_OFF = 131072;
__device__ __forceinline__ const float* inptr(LAS unsigned char* lds, int i) {
    unsigned off = PTR_OFF + 8 * i; asm volatile("" : "+v"(off));
    const u32x2 v = *(const LAS u32x2*)(lds + off);
    const unsigned lo = __builtin_amdgcn_readfirstlane(v.x), hi = __builtin_amdgcn_readfirstlane(v.y);
    return (const float*)(((unsigned long long)hi << 32) | lo);
}
__global__ void __launch_bounds__(NTHR, 2) trunk_fwd(Params p) {
    extern __shared__ __attribute__((aligned(16))) unsigned char lds_raw[];
    LAS unsigned char* lds = (LAS unsigned char*)lds_raw;
    cg::grid_group grid = cg::this_grid();
#ifndef NO_PRO
    prologue(p, lds);
#endif
    if (threadIdx.x < 22) { const unsigned long long v = (threadIdx.x < 20) ? (unsigned long long)p.in[threadIdx.x < 20 ? threadIdx.x : 0] : (threadIdx.x == 20 ? (unsigned long long)p.out : (unsigned long long)p.ws);
        ((LAS unsigned long long*)(lds + PTR_OFF))[threadIdx.x] = v; }
    __syncthreads();
    grid.sync();
#define WSP ((unsigned char*)inptr(lds, 21))
#define XRES ((float*)inptr(lds, 20))
#pragma nounroll
    for (int l = 0; l < DEPTH; ++l) {
        const int j = l >> 1; const bool fox = (l & 1) == 0;
#ifndef NO_NORM
        { unsigned char* ws = WSP; const float* modl = (const float*)(ws + WS_MOD) + (size_t)l * 16 * 6144;
          norm_phase((l == 0) ? inptr(lds, I_X) : XRES, inptr(lds, I_GMIX) + l * DM, modl + 0, modl + 1024, (bf16*)(ws + WS_H), fox, inptr(lds, I_FWIN) + (size_t)j * DM * 3088, inptr(lds, I_FBF) + j * 16, (float*)(ws + WS_LF), lds); }
#endif
        grid.sync();
        if (fox) {
#ifndef NO_CUM
            { unsigned char* ws = WSP; fox_cumsum((const float*)(ws + WS_LF), (bf16*)(ws + WS_Q), (bf16*)(ws + WS_K), lds); }
#endif
#ifndef NO_G1F
            { unsigned char* ws = WSP; const bf16* WinT = (const bf16*)(ws + WS_W + W_FOX + (size_t)j * W_FOX_STRIDE);
              pg8::Gemm g{(const bf16*)(ws + WS_H), WinT, M, 3072, DM}; pg8::StaticOrder S; S.init(M, 3072, ogrid(), obid());
              pg8::EpiQkvFox E{ws, 0.125f * LOG2E};
              pg8::gemm_phase<pg8::EpiQkvFox, pg8::StaticOrder, true, true>(lds, g, S, E); }
#endif
            grid.sync();
#ifndef NO_ATT5
            { unsigned char* ws = WSP; attn_phase<5>(lds, (const bf16*)(ws + WS_Q), (const bf16*)(ws + WS_K), (const bf16*)(ws + WS_V), (bf16*)(ws + WS_H)); }
#endif
            grid.sync();
        } else {
#ifndef NO_GD
            { unsigned char* ws = WSP; const bf16* WdT = (const bf16*)(ws + WS_W + W_MLA + (size_t)j * W_MLA_STRIDE);
              pg8::Gemm g{(const bf16*)(ws + WS_H), WdT, M, 512, DM}; pg8::StaticOrder S; S.init(M, 512, ogrid(), obid());
              pg8::EpiMlaDown E{ws};
              pg8::gemm_phase<pg8::EpiMlaDown, pg8::StaticOrder, true, true>(lds, g, S, E); }
#endif
            grid.sync();
#ifndef NO_GQ
            { unsigned char* ws = WSP; const bf16* WuqT = (const bf16*)(ws + WS_W + W_MLA + (size_t)j * W_MLA_STRIDE) + (size_t)512 * 1024;
              int Kq = 256; asm volatile("" : "+s"(Kq));
              pg8::Gemm g{(const bf16*)(ws + WS_CQ), WuqT, M, 1536, Kq}; pg8::StaticOrder S; S.init(M, 1536, ogrid(), obid());
              pg8::EpiMlaQ E{ws, 0.10206207261596575f * LOG2E};
              pg8::gemm_phase<pg8::EpiMlaQ, pg8::StaticOrder, true, true>(lds, g, S, E); }
#endif
#ifndef NO_GKV
            { unsigned char* ws = WSP; const bf16* WukvT = (const bf16*)(ws + WS_W + W_MLA + (size_t)j * W_MLA_STRIDE) + (size_t)512 * 1024 + (size_t)1536 * 256;
              int Kkv = 128; asm volatile("" : "+s"(Kkv));
              pg8::Gemm g{(const bf16*)(ws + WS_CKV), WukvT, M, 2048, Kkv}; pg8::StaticOrder S; S.init(M, 2048, ogrid(), obid());
              pg8::EpiMlaKv E{ws};
              pg8::gemm_phase<pg8::EpiMlaKv, pg8::StaticOrder, true, true>(lds, g, S, E); }
#endif
            grid.sync();
#ifndef NO_ATT6
            { unsigned char* ws = WSP; attn_phase<6>(lds, (const bf16*)(ws + WS_Q), (const bf16*)(ws + WS_K), (const bf16*)(ws + WS_V), (bf16*)(ws + WS_H)); }
#endif
            grid.sync();
        }
#ifndef NO_GO
        { unsigned char* ws = WSP; const float* modl = (const float*)(ws + WS_MOD) + (size_t)l * 16 * 6144;
          const bf16* WoutT = fox ? (const bf16*)(ws + WS_W + W_FOX + (size_t)j * W_FOX_STRIDE) + (size_t)3072 * DM : (const bf16*)(ws + WS_W + W_MLA + (size_t)j * W_MLA_STRIDE + 3 * MiB);
          float* xres = XRES;
          pg8::Gemm g{(const bf16*)(ws + WS_H), WoutT, M, DM, DM}; pg8::StaticOrder S; S.init(M, DM, ogrid(), obid());
          pg8::EpiResid E{(l == 0) ? inptr(lds, I_X) : xres, xres, modl + 2048};
          pg8::gemm_phase<pg8::EpiResid, pg8::StaticOrder, true, true>(lds, g, S, E); }
#endif
        grid.sync();
#ifndef NO_NORM2
        { unsigned char* ws = WSP; const float* modl = (const float*)(ws + WS_MOD) + (size_t)l * 16 * 6144;
          norm_phase(XRES, inptr(lds, I_GMLP) + l * DM, modl + 3072, modl + 4096, (bf16*)(ws + WS_H), false, nullptr, nullptr, nullptr, lds); }
#endif
        grid.sync();
#ifndef NO_GU
        { unsigned char* ws = WSP; const bf16* W1T = (const bf16*)(ws + WS_W + W_MLP + (size_t)l * W_MLP_STRIDE);
          pg8::Gemm g{(const bf16*)(ws + WS_H), W1T, M, FF, DM}; pg8::StaticOrder S; S.init(M, FF, ogrid(), obid());
          pg8::EpiRelu2 E{ws};
          pg8::gemm_phase<pg8::EpiRelu2, pg8::StaticOrder, true, true>(lds, g, S, E); }
#endif
        grid.sync();
#ifndef NO_GDN
        { unsigned char* ws = WSP; const float* modl = (const float*)(ws + WS_MOD) + (size_t)l * 16 * 6144;
          const bf16* W2T = (const bf16*)(ws + WS_W + W_MLP + (size_t)l * W_MLP_STRIDE) + (size_t)FF * DM;
          float* xres = XRES;
          pg8::Gemm g{(const bf16*)(ws + WS_BIG), W2T, M, DM, FF}; pg8::StaticOrder S; S.init(M, DM, ogrid(), obid());
          pg8::EpiResid E{xres, xres, modl + 5120};
          pg8::gemm_phase<pg8::EpiResid, pg8::StaticOrder, true, true>(lds, g, S, E); }
#endif
        grid.sync();
    }
    final_norm(XRES, inptr(lds, I_GFIN));
}

extern "C" void kernel_launch(void* const* d_in, const int* in_sizes, int n_in, void* d_out, int out_size, void* d_ws, size_t ws_size, hipStream_t stream) {
    static int grid = 0;
    if (grid == 0) {
        if (n_in != 20 || in_sizes[0] != M * DM || out_size != M * DM || ws_size < WS_END) { fprintf(stderr, "kernel_launch: unexpected shapes (n_in %d, in0 %d, out %d, ws %zu)\n", n_in, n_in > 0 ? in_sizes[0] : -1, out_size, ws_size); grid = -1; return; }
        int dev = 0, cus = 0, per_cu = 0;
        if (hipGetDevice(&dev) != hipSuccess || hipDeviceGetAttribute(&cus, hipDeviceAttributeMultiprocessorCount, dev) != hipSuccess) { fprintf(stderr, "kernel_launch: device query failed\n"); grid = -1; return; }
        if (hipFuncSetAttribute((const void*)trunk_fwd, hipFuncAttributeMaxDynamicSharedMemorySize, LDS_BYTES) != hipSuccess) { fprintf(stderr, "kernel_launch: hipFuncSetAttribute failed\n"); grid = -1; return; }
        if (hipOccupancyMaxActiveBlocksPerMultiprocessor(&per_cu, (const void*)trunk_fwd, NTHR, LDS_BYTES) != hipSuccess || per_cu < 1) { fprintf(stderr, "kernel_launch: occupancy query gave %d\n", per_cu); per_cu = 1; }
        (void)hipGetLastError();
        grid = cus * per_cu;
    }
    if (grid < 0) return;
    Params prm{};
    for (int i = 0; i < 20; ++i) prm.in[i] = (const float*)d_in[i];
    prm.out = (float*)d_out; prm.ws = (unsigned char*)d_ws;
    void* args[] = {&prm};
    hipError_t e = hipLaunchCooperativeKernel((const void*)trunk_fwd, dim3(grid), dim3(NTHR), args, LDS_BYTES, stream);
    if (e != hipSuccess) fprintf(stderr, "kernel_launch: cooperative launch failed: %s (grid %d)\n", hipGetErrorString(e), grid);
}
```

```cpp
#include <hip/hip_runtime.h>
#include <hip/hip_cooperative_groups.h>
#include <cstdio>
#include <cstdint>
namespace cg = cooperative_groups;
#define LAS __attribute__((address_space(3)))
typedef unsigned short bf16;
typedef short bf16x8 __attribute__((ext_vector_type(8)));
typedef short s16x4 __attribute__((ext_vector_type(4)));
typedef float f32x16 __attribute__((ext_vector_type(16)));
typedef float f32x4 __attribute__((ext_vector_type(4)));
typedef float f32x2 __attribute__((ext_vector_type(2)));
typedef unsigned u32x4 __attribute__((ext_vector_type(4)));
typedef unsigned u32x2 __attribute__((ext_vector_type(2)));

constexpr int NB = 16, SEQ = 2048, DM = 1024, NH = 16, FF = 4096, DEPTH = 4;
constexpr int M = NB * SEQ;
constexpr int NTHR = 512, NWAVE = 8;
constexpr float EPS = 1e-6f, LOG2E = 1.4426950408889634f;
constexpr size_t MiB = 1u << 20;
constexpr size_t WS_BIG = 0;
constexpr size_t WS_Q = 0, WS_K = 96 * MiB, WS_V = 192 * MiB;
constexpr size_t WS_H = 256 * MiB;
constexpr size_t WS_CQ = 320 * MiB, WS_CKV = 336 * MiB;
constexpr size_t WS_W = 344 * MiB;
constexpr size_t W_FOX = 0, W_FOX_STRIDE = 8 * MiB;
constexpr size_t W_MLA = 16 * MiB, W_MLA_STRIDE = 5 * MiB;
constexpr size_t W_MLP = 26 * MiB, W_MLP_STRIDE = 16 * MiB;
constexpr size_t WS_MOD = 436 * MiB;
constexpr size_t WS_CS = 438 * MiB;
constexpr size_t WS_LF = 442 * MiB;
constexpr size_t WS_SSQQ = 444 * MiB, WS_SSQKV = 445 * MiB;
constexpr size_t WS_CTL = 446 * MiB;
constexpr size_t WS_END = 447 * MiB;
static_assert(WS_W + W_MLP + 4 * W_MLP_STRIDE <= WS_MOD, "weights fit");
constexpr int LDS_BYTES = 135168;

namespace pg8 {
#define PG8_LAS __attribute__((address_space(3)))
typedef unsigned short bf16_t;
typedef short bf16x8 __attribute__((ext_vector_type(8)));
typedef float f32x4 __attribute__((ext_vector_type(4)));
typedef unsigned u32x4 __attribute__((ext_vector_type(4)));
constexpr int BM = 256, BK = 64, HALF = 128, HTB = HALF * BK * 2  , STAGE_BYTES = 8 * HTB, NXCD = 8, WGM = 8;

__host__ __device__ __forceinline__ int lds_byte(int r, int c) { const int st = (r >> 4) * 2 + (c >> 5), rr = r & 15, cc = c & 31, ob = rr * 64 + cc * 2; return st * 1024 + (ob ^ (((ob >> 9) & 1) << 5)); }
__host__ __device__ __forceinline__ void stage_rc(int b, int& R, int& C) { const int st = b / 1024, sb = b % 1024, swz = sb ^ (((sb >> 9) & 1) << 5); R = (st >> 1) * 16 + swz / 64; C = (st & 1) * 32 + (swz % 64) / 2; }
__host__ __device__ __forceinline__ int perm32(int rho) { const int n = rho >> 4, i = rho & 15; return 8 * (i >> 2) + 4 * n + (i & 3); }

struct Unit { int pm, pn; };
struct Gemm { const bf16_t* A; const bf16_t* Bt; int M, N, K; };

struct StaticOrder {
    int nM, nN, nwg, G, c;
    __host__ __device__ void init(int M, int N, int G_, int c_) { nM = M / BM; nN = N / BM; nwg = nM * nN; G = G_; c = c_; }
    __host__ __device__ bool next(int i, Unit& u) const {
        const long L = (long)i * G + c; if (L >= nwg) return false;
        int wgid = (int)L; { const int q = nwg / NXCD, r = nwg % NXCD, xcd = wgid % NXCD, off = wgid / NXCD; wgid = (xcd < r ? xcd * (q + 1) : r * (q + 1) + (xcd - r) * q) + off; }
        const int nig = WGM * nN, gid = wgid / nig, fm = gid * WGM, gsz = (nM - fm) < WGM ? (nM - fm) : WGM;
        u.pm = fm + ((wgid % nig) % gsz); u.pn = (wgid % nig) / gsz; return true;
    }
    __device__ __forceinline__ void a_ready(const Unit&) const {}
    __device__ __forceinline__ void done(const Unit&) const {}
};

__device__ __forceinline__ unsigned cvt_pk_bf16(float lo, float hi) { unsigned r; asm volatile("v_cvt_pk_bf16_f32 %0, %1, %2" : "=v"(r) : "v"(lo), "v"(hi)); return r; }
typedef float f32x2 __attribute__((ext_vector_type(2)));
typedef unsigned u32x2 __attribute__((ext_vector_type(2)));
#define GAS __attribute__((address_space(1)))
typedef GAS bf16_t gbf16; typedef GAS float gf32; typedef GAS unsigned char gu8;
constexpr float RMS_EPS = 1e-6f;
__device__ __forceinline__ u32x4 pack8(const f32x4& v0, const f32x4& v1) { u32x4 w; w.x = cvt_pk_bf16(v0[0], v0[1]); w.y = cvt_pk_bf16(v0[2], v0[3]); w.z = cvt_pk_bf16(v1[0], v1[1]); w.w = cvt_pk_bf16(v1[2], v1[3]); return w; }
__device__ __forceinline__ u32x2 pack4(const f32x4& v) { u32x2 w; w.x = cvt_pk_bf16(v[0], v[1]); w.y = cvt_pk_bf16(v[2], v[3]); return w; }

struct EpiQkvFox {
    static constexpr bool PERM = true, AFTER_DRAIN = false;
    unsigned char* ws; float qscale;
    __device__ __forceinline__ void operator()(const f32x4 (&acc)[2][2][4][2], const Unit& u, int wr, int wc, int fr, int fq) const {
        gbf16* Q = (gbf16*)((gu8*)ws + WS_Q); gbf16* Kp = (gbf16*)((gu8*)ws + WS_K); gbf16* V = (gbf16*)((gu8*)ws + WS_V);
        const int row0 = u.pm * BM + wr * 64 + fr;
        const int t = u.pn >> 2;
        const int cin0 = (u.pn & 3) * BM + wc * 32 + 8 * fq;
        const float sc = (t == 0) ? qscale : 1.f;
#pragma unroll
        for (int ai = 0; ai < 2; ++ai)
#pragma unroll
            for (int m = 0; m < 4; ++m) { const unsigned row = (unsigned)(row0 + ai * HALF + m * 16);
#pragma unroll
                for (int bj = 0; bj < 2; ++bj) { const int cin = cin0 + bj * HALF;
                    gbf16* dst = (t == 2) ? (V + row * 1024 + cin) : ((t == 0 ? Q : Kp) + row * 1280 + (cin >> 6) * 80 + (cin & 63));
                    *(GAS u32x4*)dst = pack8(acc[ai][bj][m][0] * sc, acc[ai][bj][m][1] * sc); } }
    }
};
struct EpiRelu2 {
    static constexpr bool PERM = true, AFTER_DRAIN = false;
    unsigned char* ws;
    __device__ __forceinline__ void operator()(const f32x4 (&acc)[2][2][4][2], const Unit& u, int wr, int wc, int fr, int fq) const {
        gbf16* H = (gbf16*)((gu8*)ws + WS_BIG);
        const int row0 = u.pm * BM + wr * 64 + fr; const int col0 = u.pn * BM + wc * 32 + 8 * fq;
#pragma unroll
        for (int ai = 0; ai < 2; ++ai)
#pragma unroll
            for (int m = 0; m < 4; ++m) { gbf16* rowp = H + (unsigned)(row0 + ai * HALF + m * 16) * 4096u + (unsigned)col0;
#pragma unroll
                for (int bj = 0; bj < 2; ++bj) { f32x4 v0 = acc[ai][bj][m][0], v1 = acc[ai][bj][m][1];
#pragma unroll
                    for (int j = 0; j < 4; ++j) { const float a = fmaxf(v0[j], 0.f), b = fmaxf(v1[j], 0.f); v0[j] = a * a; v1[j] = b * b; }
                    *(GAS u32x4*)(rowp + bj * HALF) = pack8(v0, v1); } }
    }
};
struct EpiResid {
    static constexpr bool PERM = false, AFTER_DRAIN = false;
    const float* base_; float* out_; const float* gate_;
    __device__ __forceinline__ void operator()(const f32x4 (&acc)[2][2][4][2], const Unit& u, int wr, int wc, int fr, int fq) const {
        const gf32* base = (const gf32*)base_; gf32* out = (gf32*)out_; const gf32* gate = (const gf32*)gate_;
        const int row0 = u.pm * BM + wr * 64 + fr; const int col0 = u.pn * BM + wc * 32 + 4 * fq;
        const gf32* gp = gate + (size_t)(u.pm >> 3) * 6144 + col0;
        f32x4 gv[2][2];
#pragma unroll
        for (int bj = 0; bj < 2; ++bj)
#pragma unroll
            for (int n = 0; n < 2; ++n) gv[bj][n] = *(const GAS f32x4*)(gp + bj * HALF + n * 16);
#pragma unroll
        for (int ai = 0; ai < 2; ++ai)
#pragma unroll
            for (int m = 0; m < 4; ++m) { const unsigned off = (unsigned)(row0 + ai * HALF + m * 16) * 1024u + (unsigned)col0;
#pragma unroll
                for (int bj = 0; bj < 2; ++bj)
#pragma unroll
                    for (int n = 0; n < 2; ++n) { const f32x4 bs = *(const GAS f32x4*)(base + off + bj * HALF + n * 16);
                        *(GAS f32x4*)(out + off + bj * HALF + n * 16) = bs + gv[bj][n] * acc[ai][bj][m][n]; } }
    }
};
struct EpiMlaKv {
    static constexpr bool PERM = true, AFTER_DRAIN = false;
    unsigned char* ws;
    __device__ __forceinline__ void operator()(const f32x4 (&acc)[2][2][4][2], const Unit& u, int wr, int wc, int fr, int fq) const {
        const gf32* ssq = (const gf32*)((gu8*)ws + WS_SSQKV); gbf16* Kp = (gbf16*)((gu8*)ws + WS_K); gbf16* V = (gbf16*)((gu8*)ws + WS_V);
        const int row0 = u.pm * BM + wr * 64 + fr;
        const int t = u.pn >> 2; const int cin0 = (u.pn & 3) * BM + wc * 32 + 8 * fq;
#pragma unroll
        for (int ai = 0; ai < 2; ++ai)
#pragma unroll
            for (int m = 0; m < 4; ++m) { const unsigned row = (unsigned)(row0 + ai * HALF + m * 16);
                const f32x4 s4 = *(const GAS f32x4*)(ssq + row * 4);
                const float rs = __builtin_amdgcn_rsqf(((s4[0] + s4[1]) + (s4[2] + s4[3])) * (1.0f / 128.0f) + RMS_EPS);
#pragma unroll
                for (int bj = 0; bj < 2; ++bj) { const int cin = cin0 + bj * HALF;
                    gbf16* dst = t ? (V + row * 1024 + cin) : (Kp + row * 1536 + (cin >> 6) * 96 + (cin & 63));
                    *(GAS u32x4*)dst = pack8(acc[ai][bj][m][0] * rs, acc[ai][bj][m][1] * rs); }
                asm volatile("" ::: "memory"); }
    }
};
struct EpiMlaQ {
    static constexpr bool PERM = false, AFTER_DRAIN = false;
    unsigned char* ws; float qscale;
    __device__ __forceinline__ void operator()(const f32x4 (&acc)[2][2][4][2], const Unit& u, int wr, int wc, int fr, int fq) const {
        const gf32* ssq = (const gf32*)((gu8*)ws + WS_SSQQ); const gf32* cst = (const gf32*)((gu8*)ws + WS_CS); gbf16* Q = (gbf16*)((gu8*)ws + WS_Q);
        const int row0 = u.pm * BM + wr * 64 + fr;
#pragma unroll
        for (int ai = 0; ai < 2; ++ai)
#pragma unroll
            for (int m = 0; m < 4; ++m) { const unsigned row = (unsigned)(row0 + ai * HALF + m * 16);
                const f32x4 s4 = *(const GAS f32x4*)(ssq + row * 4);
                const float rs = qscale * __builtin_amdgcn_rsqf(((s4[0] + s4[1]) + (s4[2] + s4[3])) * (1.0f / 256.0f) + RMS_EPS);
                if (u.pn < 4) {
#pragma unroll
                    for (int bj = 0; bj < 2; ++bj)
#pragma unroll
                        for (int n = 0; n < 2; ++n) { const int cin = u.pn * BM + bj * HALF + wc * 32 + n * 16 + 4 * fq;
                            *(GAS u32x2*)(Q + row * 1536 + (cin >> 6) * 96 + (cin & 63)) = pack4(acc[ai][bj][m][n] * rs); }
                } else {
                    const f32x4 cs = *(const GAS f32x4*)(cst + row * 32 + 4 * fq), sn = *(const GAS f32x4*)(cst + row * 32 + 16 + 4 * fq);
#pragma unroll
                    for (int bj = 0; bj < 2; ++bj) { const int head = ((u.pn - 4) * BM + bj * HALF + wc * 32) >> 5;
                        const f32x4 x1 = acc[ai][bj][m][0] * rs, x2 = acc[ai][bj][m][1] * rs;
                        gbf16* dst = Q + row * 1536 + head * 96 + 64 + 4 * fq;
                        *(GAS u32x2*)dst = pack4(x1 * cs - x2 * sn); *(GAS u32x2*)(dst + 16) = pack4(x2 * cs + x1 * sn); }
                }
                asm volatile("" ::: "memory");
            }
    }
};
struct EpiMlaDown {
    static constexpr bool PERM = false, AFTER_DRAIN = false;
    unsigned char* ws;
    __device__ __forceinline__ void operator()(const f32x4 (&acc)[2][2][4][2], const Unit& u, int wr, int wc, int fr, int fq) const {
        gbf16* cq = (gbf16*)((gu8*)ws + WS_CQ); gbf16* ckv = (gbf16*)((gu8*)ws + WS_CKV); gf32* ssqq = (gf32*)((gu8*)ws + WS_SSQQ); gf32* ssqkv = (gf32*)((gu8*)ws + WS_SSQKV); const gf32* cst = (const gf32*)((gu8*)ws + WS_CS); gbf16* Kp = (gbf16*)((gu8*)ws + WS_K);
        const int row0 = u.pm * BM + wr * 64 + fr;
#pragma unroll
        for (int ai = 0; ai < 2; ++ai)
#pragma unroll
            for (int m = 0; m < 4; ++m) { const unsigned row = (unsigned)(row0 + ai * HALF + m * 16);
                if (u.pn == 0) {
                    float ss = 0.f;
#pragma unroll
                    for (int bj = 0; bj < 2; ++bj)
#pragma unroll
                        for (int n = 0; n < 2; ++n) { const f32x4 v = acc[ai][bj][m][n]; ss += (v[0] * v[0] + v[1] * v[1]) + (v[2] * v[2] + v[3] * v[3]);
                            *(GAS u32x2*)(cq + row * 256 + bj * HALF + wc * 32 + n * 16 + 4 * fq) = pack4(v); }
                    ss += __shfl_xor(ss, 16); ss += __shfl_xor(ss, 32);
                    if (fq == 0) ssqq[row * 4 + wc] = ss;
                } else {
                    float ss = 0.f;
#pragma unroll
                    for (int n = 0; n < 2; ++n) { const f32x4 v = acc[ai][0][m][n]; ss += (v[0] * v[0] + v[1] * v[1]) + (v[2] * v[2] + v[3] * v[3]);
                        *(GAS u32x2*)(ckv + row * 128 + wc * 32 + n * 16 + 4 * fq) = pack4(v); }
                    ss += __shfl_xor(ss, 16); ss += __shfl_xor(ss, 32);
                    if (fq == 0) ssqkv[row * 4 + wc] = ss;
                    if (wc == 0) {
                        const f32x4 cs = *(const GAS f32x4*)(cst + row * 32 + 4 * fq), sn = *(const GAS f32x4*)(cst + row * 32 + 16 + 4 * fq);
                        const f32x4 x1 = acc[ai][1][m][0], x2 = acc[ai][1][m][1];
                        const u32x2 o1 = pack4(x1 * cs - x2 * sn), o2 = pack4(x2 * cs + x1 * sn);
                        gbf16* dst = Kp + row * 1536 + 64 + 4 * fq;
#pragma unroll
                        for (int hd = 0; hd < 16; ++hd) { *(GAS u32x2*)(dst + hd * 96) = o1; *(GAS u32x2*)(dst + hd * 96 + 16) = o2; }
                    }
                }
            }
    }
};

template <class Epi, class Sched, bool ALIGN_EPI = false, bool SP2 = false>
__device__ __forceinline__ void gemm_phase(PG8_LAS unsigned char* lds, const Gemm g, const Sched& S, const Epi& E) {
    int tid_ = threadIdx.x; asm volatile("" : "+v"(tid_));
    const int tid = tid_, wid = __builtin_amdgcn_readfirstlane(tid >> 6), lane = tid & 63, wr = wid >> 2, wc = wid & 3, fr = lane & 15, fq = lane >> 4;
    const int K = g.K, nt = K / BK;
    unsigned voffA[2], voffB[2];
#pragma unroll
    for (int i = 0; i < 2; ++i) { int R, C; stage_rc(tid * 16 + i * 8192, R, C); const int Rb = Epi::PERM ? ((R & ~31) + perm32(R & 31)) : R;
        voffA[i] = (unsigned)(R * K + C) * 2u; voffB[i] = (unsigned)(Rb * K + C) * 2u; }
    const size_t kstep = (size_t)(BK * 2);
    const size_t hstep = (size_t)HALF * K * 2;
    const size_t tstep = 2 * hstep;
    const unsigned ldsw = (unsigned)wid * 1024u;
    const int aoff = lds_byte(wr * 64 + fr, fq * 8), boff = lds_byte(wc * 32 + fr, fq * 8);
#define PG8_SA(b, h) (((b) * 2 + (h)) * HTB)
#define PG8_SB(b, h) ((4 + (b) * 2 + (h)) * HTB)
#define PG8_STAGE(bufoff, gbase, voff) do { _Pragma("unroll") for (int _i = 0; _i < 2; ++_i) \
        __builtin_amdgcn_global_load_lds((const unsigned*)((const char*)(gbase) + (voff)[_i]), (PG8_LAS unsigned*)(lds + (bufoff) + ldsw + _i * 8192), 16, 0, 0); } while (0)
#define PG8_LDA(dst, b, h) do { _Pragma("unroll") for (int m = 0; m < 4; ++m) _Pragma("unroll") for (int k = 0; k < 2; ++k) dst[m][k] = *(const PG8_LAS bf16x8*)(lds + PG8_SA(b, h) + aoff + m * 2048 + k * 1024); } while (0)
#define PG8_LDB(dst, b, h) do { _Pragma("unroll") for (int n = 0; n < 2; ++n) _Pragma("unroll") for (int k = 0; k < 2; ++k) dst[n][k] = *(const PG8_LAS bf16x8*)(lds + PG8_SB(b, h) + boff + n * 2048 + k * 1024); } while (0)
#define PG8_MMA(ai, bj, At, Bt) do { __builtin_amdgcn_s_setprio(1); _Pragma("unroll") for (int m = 0; m < 4; ++m) _Pragma("unroll") for (int n = 0; n < 2; ++n) _Pragma("unroll") for (int k = 0; k < 2; ++k) \
        acc[ai][bj][m][n] = __builtin_amdgcn_mfma_f32_16x16x32_bf16(Bt[n][k], At[m][k], acc[ai][bj][m][n], 0, 0, 0); __builtin_amdgcn_s_setprio(0); } while (0)
#define PG8_WAIT_V(n) asm volatile("s_waitcnt vmcnt(" #n ")" ::: "memory")
#define PG8_WAIT_L(n) asm volatile("s_waitcnt lgkmcnt(" #n ")" ::: "memory")
#define PG8_BAR __builtin_amdgcn_s_barrier()
#define PG8_SCHED __builtin_amdgcn_sched_barrier(0)
    Unit cur, nxt; int ui = 0;
    if (!S.next(0, cur)) return;
    f32x4 acc[2][2][4][2];
#pragma unroll
    for (int a = 0; a < 2; ++a)
#pragma unroll
        for (int b = 0; b < 2; ++b)
#pragma unroll
            for (int m = 0; m < 4; ++m)
#pragma unroll
                for (int n = 0; n < 2; ++n) acc[a][b][m][n] = (f32x4){0.f, 0.f, 0.f, 0.f};
    bf16x8 At[4][2], B0[2][2], B1[2][2];
    const char* cA = (const char*)g.A + (size_t)cur.pm * tstep; const char* cB = (const char*)g.Bt + (size_t)cur.pn * tstep;
    S.a_ready(cur);
    if constexpr (SP2) {
        PG8_STAGE(PG8_SB(0, 0), cB, voffB); PG8_STAGE(PG8_SB(0, 1), cB + hstep, voffB); PG8_STAGE(PG8_SA(0, 0), cA, voffA); PG8_STAGE(PG8_SA(0, 1), cA + hstep, voffA);
        if (wr == 1) PG8_BAR;
        PG8_WAIT_V(2); PG8_BAR;
        PG8_STAGE(PG8_SB(1, 0), cB + kstep, voffB); PG8_STAGE(PG8_SA(1, 0), cA + kstep, voffA); PG8_STAGE(PG8_SB(1, 1), cB + hstep + kstep, voffB);
        PG8_WAIT_V(6); PG8_BAR;
    } else {
        PG8_STAGE(PG8_SB(0, 0), cB, voffB); PG8_STAGE(PG8_SA(0, 0), cA, voffA); PG8_STAGE(PG8_SB(0, 1), cB + hstep, voffB); PG8_STAGE(PG8_SA(0, 1), cA + hstep, voffA);
        if (wr == 1) PG8_BAR;
        PG8_WAIT_V(4); PG8_BAR;
        PG8_STAGE(PG8_SB(1, 0), cB + kstep, voffB); PG8_STAGE(PG8_SA(1, 0), cA + kstep, voffA); PG8_STAGE(PG8_SB(1, 1), cB + hstep + kstep, voffB);
        PG8_WAIT_V(6); PG8_BAR;
    }
    for (;;) {
        const bool has_next = S.next(ui + 1, nxt);
        const char* nA = has_next ? (const char*)g.A + (size_t)nxt.pm * tstep : cA; const char* nB = has_next ? (const char*)g.Bt + (size_t)nxt.pn * tstep : cB;
        for (int t = 0; t < nt; t += 2) {
            const bool last = (t == nt - 2);
            const char* a1 = cA + (size_t)(t + 1) * kstep;
            const char* a2 = last ? nA : cA + (size_t)(t + 2) * kstep; const char* b2 = last ? nB : cB + (size_t)(t + 2) * kstep;
            const char* a3 = a2 + kstep; const char* b3 = b2 + kstep;
            if (last && has_next) S.a_ready(nxt);
            if constexpr (SP2) {
            PG8_LDB(B0, 0, 0); PG8_LDB(B1, 0, 1); PG8_SCHED; PG8_LDA(At, 0, 0); PG8_STAGE(PG8_SA(1, 1), a1 + hstep, voffA);
            PG8_WAIT_V(8); PG8_WAIT_L(0); PG8_BAR; PG8_MMA(0, 0, At, B0); PG8_MMA(0, 1, At, B1); PG8_BAR; PG8_SCHED;
            PG8_LDA(At, 0, 1); PG8_STAGE(PG8_SB(0, 0), b2, voffB); PG8_STAGE(PG8_SB(0, 1), b2 + hstep, voffB); PG8_STAGE(PG8_SA(0, 0), a2, voffA);
            PG8_WAIT_V(8); PG8_WAIT_L(0); PG8_BAR; PG8_MMA(1, 0, At, B0); PG8_MMA(1, 1, At, B1); PG8_BAR; PG8_SCHED;
            PG8_LDB(B0, 1, 0); PG8_LDB(B1, 1, 1); PG8_SCHED; PG8_LDA(At, 1, 0); PG8_STAGE(PG8_SA(0, 1), a2 + hstep, voffA);
            PG8_WAIT_V(8); PG8_WAIT_L(0); PG8_BAR; PG8_MMA(0, 0, At, B0); PG8_MMA(0, 1, At, B1); PG8_BAR; PG8_SCHED;
            PG8_LDA(At, 1, 1); PG8_STAGE(PG8_SB(1, 0), b3, voffB); PG8_STAGE(PG8_SB(1, 1), b3 + hstep, voffB); PG8_STAGE(PG8_SA(1, 0), a3, voffA);
            PG8_WAIT_V(8); PG8_WAIT_L(0); PG8_BAR; PG8_MMA(1, 0, At, B0); PG8_MMA(1, 1, At, B1); PG8_BAR; PG8_SCHED;
            } else {
            PG8_LDB(B0, 0, 0); PG8_SCHED; PG8_LDA(At, 0, 0); PG8_STAGE(PG8_SA(1, 1), a1 + hstep, voffA);
            PG8_WAIT_L(8); PG8_BAR; PG8_WAIT_L(0); PG8_MMA(0, 0, At, B0); PG8_BAR; PG8_SCHED;
            PG8_LDB(B1, 0, 1); PG8_STAGE(PG8_SB(0, 0), b2, voffB);
            PG8_BAR; PG8_WAIT_L(0); PG8_MMA(0, 1, At, B1); PG8_BAR;
            PG8_LDA(At, 0, 1); PG8_STAGE(PG8_SA(0, 0), a2, voffA);
            PG8_BAR; PG8_WAIT_L(0); PG8_MMA(1, 0, At, B0); PG8_BAR; PG8_SCHED;
            PG8_STAGE(PG8_SB(0, 1), b2 + hstep, voffB);
            PG8_WAIT_V(6); PG8_BAR; PG8_MMA(1, 1, At, B1); PG8_BAR;
            PG8_LDB(B0, 1, 0); PG8_SCHED; PG8_LDA(At, 1, 0); PG8_STAGE(PG8_SA(0, 1), a2 + hstep, voffA);
            PG8_WAIT_L(8); PG8_BAR; PG8_WAIT_L(0); PG8_MMA(0, 0, At, B0); PG8_BAR; PG8_SCHED;
            PG8_LDB(B1, 1, 1); PG8_STAGE(PG8_SB(1, 0), b3, voffB);
            PG8_BAR; PG8_WAIT_L(0); PG8_MMA(0, 1, At, B1); PG8_BAR;
            PG8_LDA(At, 1, 1); PG8_STAGE(PG8_SA(1, 0), a3, voffA);
            PG8_BAR; PG8_WAIT_L(0); PG8_MMA(1, 0, At, B0); PG8_BAR; PG8_SCHED;
            PG8_STAGE(PG8_SB(1, 1), b3 + hstep, voffB);
            PG8_WAIT_V(6); PG8_BAR; PG8_MMA(1, 1, At, B1); PG8_BAR;
            }
        }
        if constexpr (ALIGN_EPI) { if (wr == 0) PG8_BAR; }
        if constexpr (!Epi::AFTER_DRAIN) { E(acc, cur, wr, wc, fr, fq); S.done(cur); }
        if (!has_next) break;
#pragma unroll
        for (int a = 0; a < 2; ++a)
#pragma unroll
            for (int b = 0; b < 2; ++b)
#pragma unroll
                for (int m = 0; m < 4; ++m)
#pragma unroll
                    for (int n = 0; n < 2; ++n) acc[a][b][m][n] = (f32x4){0.f, 0.f, 0.f, 0.f};
        cur = nxt; cA = nA; cB = nB; ++ui;
        if constexpr (ALIGN_EPI) { if (wr == 1) PG8_BAR; }
    }
    PG8_WAIT_V(0);
    if constexpr (!ALIGN_EPI) { if (wr == 0) PG8_BAR; }
    PG8_BAR;
    if constexpr (Epi::AFTER_DRAIN) { E.fused(acc, cur, wr, wc, fr, fq, lds, wid, lane); S.done(cur); }
#undef PG8_SA
#undef PG8_SB
#undef PG8_STAGE
#undef PG8_LDA
#undef PG8_LDB
#undef PG8_MMA
#undef PG8_WAIT_V
#undef PG8_WAIT_L
#undef PG8_BAR
#undef PG8_SCHED
}
}

__device__ __forceinline__ int obid() { int b = blockIdx.x; asm volatile("" : "+s"(b)); return b; }
__device__ __forceinline__ int ogrid() { int g = gridDim.x; asm volatile("" : "+s"(g)); return g; }
__device__ __forceinline__ float wave_sum(float v) {
#pragma unroll
    for (int o = 1; o < 64; o <<= 1) v += __shfl_xor(v, o);
    return v;
}
__device__ __forceinline__ unsigned f2bf(float f) { unsigned u = __builtin_bit_cast(unsigned, f); return (u + 0x7fffu + ((u >> 16) & 1u)) >> 16; }
__device__ __forceinline__ unsigned pk2(float lo, float hi) { return f2bf(lo) | (f2bf(hi) << 16); }
__device__ __forceinline__ float bf2f(unsigned b) { return __builtin_bit_cast(float, b << 16); }

__device__ __forceinline__ void transpose_item(const float* W, int ld, int K, int N, bf16* WT, int map, int drow0, const float* gk, LAS float* scr, int item, int lane) {
    const int nblk = N / 32, kb = item / nblk, nb = item % nblk, k0 = 64 * kb, n0 = 32 * nb;
    int drow;
    if (map == 1) { const int hd = n0 / 96, d = n0 % 96; drow = (d < 64) ? hd * 64 + d : 1024 + hd * 32 + (d - 64); }
    else if (map == 2) { const int hd = n0 / 128, d = n0 % 128; drow = (d < 64) ? hd * 64 + d : 1024 + hd * 64 + (d - 64); }
    else drow = drow0 + n0;
#pragma unroll 8
    for (int i = 0; i < 32; ++i) { const int kk = 2 * i + (lane >> 5); float v = W[(size_t)(k0 + kk) * ld + n0 + (lane & 31)]; if (gk) v *= gk[k0 + kk]; scr[kk * 33 + (lane & 31)] = v; }
    asm volatile("s_waitcnt lgkmcnt(0)" ::: "memory");
    const int c = lane & 7;
#pragma unroll
    for (int j = 0; j < 4; ++j) { const int n = (lane >> 3) + 8 * j; const LAS float* s = scr + (8 * c) * 33 + n;
        u32x4 o; o.x = pk2(s[0 * 33], s[1 * 33]); o.y = pk2(s[2 * 33], s[3 * 33]); o.z = pk2(s[4 * 33], s[5 * 33]); o.w = pk2(s[6 * 33], s[7 * 33]);
        *(u32x4*)(WT + (size_t)(drow + n) * K + k0 + 8 * c) = o; }
    asm volatile("s_waitcnt lgkmcnt(0)" ::: "memory");
}

struct Params { const float* in[20]; float* out; unsigned char* ws; };
enum { I_X = 0, I_C, I_POS, I_ADAW, I_ADAB, I_GMIX, I_GMLP, I_FWIN, I_FBF, I_FWOUT, I_MDQ, I_MQG, I_MUQ, I_MDKV, I_MKVG, I_MUKV, I_MOUT, I_W1, I_W2, I_GFIN };

__device__ __forceinline__ void prologue(const Params& p, LAS unsigned char* lds) {
    const int BID = obid(), GSZ = ogrid(); int tid_ = threadIdx.x; asm volatile("" : "+v"(tid_));
    const int tid = tid_, lane = tid & 63, wave = __builtin_amdgcn_readfirstlane(tid >> 6);
    unsigned char* ws = p.ws;
    {
        LAS float* cact = (LAS float*)lds;
        LAS float* part = (LAS float*)(lds + 65536);
        const float* c = p.in[I_C];
        for (int idx = tid; idx < NB * DM; idx += NTHR) { const int b = idx >> 10, k = idx & 1023; const float v = c[idx]; cact[k * 16 + b] = v / (1.0f + __expf(-v)); }
        __syncthreads();
        float* mod = (float*)(ws + WS_MOD);
        for (int item = BID; item < 4 * 48; item += GSZ) {
            const int l = item / 48, n0 = (item % 48) * 128, col = tid & 127, ks = tid >> 7;
            float acc[16];
#pragma unroll
            for (int b = 0; b < 16; ++b) acc[b] = 0.f;
            const float* wp = p.in[I_ADAW] + ((size_t)l * DM + ks * 256) * 6144 + n0 + col;
            const LAS f32x4* cp = (const LAS f32x4*)(cact + ks * 256 * 16);
#pragma unroll 8
            for (int k = 0; k < 256; ++k) { const float w = wp[(size_t)k * 6144];
                const f32x4 c0 = cp[k * 4 + 0], c1 = cp[k * 4 + 1], c2 = cp[k * 4 + 2], c3 = cp[k * 4 + 3];
                acc[0] += w * c0[0]; acc[1] += w * c0[1]; acc[2] += w * c0[2]; acc[3] += w * c0[3];
                acc[4] += w * c1[0]; acc[5] += w * c1[1]; acc[6] += w * c1[2]; acc[7] += w * c1[3];
                acc[8] += w * c2[0]; acc[9] += w * c2[1]; acc[10] += w * c2[2]; acc[11] += w * c2[3];
                acc[12] += w * c3[0]; acc[13] += w * c3[1]; acc[14] += w * c3[2]; acc[15] += w * c3[3]; }
#pragma unroll
            for (int b = 0; b < 16; ++b) part[(ks * 16 + b) * 128 + col] = acc[b];
            __syncthreads();
            for (int o = tid; o < 2048; o += NTHR) { const int b = o >> 7, cc = o & 127;
                const float s = (part[(0 * 16 + b) * 128 + cc] + part[(1 * 16 + b) * 128 + cc]) + (part[(2 * 16 + b) * 128 + cc] + part[(3 * 16 + b) * 128 + cc]);
                mod[((size_t)l * 16 + b) * 6144 + n0 + cc] = s + p.in[I_ADAB][(size_t)l * 6144 + n0 + cc]; }
            __syncthreads();
        }
    }
    __syncthreads();
    {
        const int* pos = (const int*)p.in[I_POS]; float* cst = (float*)(ws + WS_CS);
        for (size_t idx = (size_t)BID * NTHR + tid; idx < (size_t)M * 16; idx += (size_t)GSZ * NTHR) {
            const int tok = (int)(idx >> 4), i = (int)(idx & 15);
            const float invf = exp2f(-(float)i * (13.287712379549449f / 16.0f));
            const float ang = (float)pos[tok] * invf;
            double rev = (double)ang * 0.15915494309189535; rev -= __builtin_rint(rev);
            const float rf = (float)rev;
            cst[(size_t)tok * 32 + i] = __builtin_amdgcn_cosf(rf); cst[(size_t)tok * 32 + 16 + i] = __builtin_amdgcn_sinf(rf);
        }
    }
    for (int j = 0; j < 2; ++j) { u32x4* z = (u32x4*)(ws + WS_W + W_MLA + j * W_MLA_STRIDE + (size_t)416 * 1024 * 2);
        for (int idx = BID * NTHR + tid; idx < 96 * 1024 * 2 / 16; idx += GSZ * NTHR) z[idx] = (u32x4){0u, 0u, 0u, 0u}; }
    {
        LAS float* scr = (LAS float*)(lds + wave * 16384);
        const int gw = BID * NWAVE + wave, NGW = GSZ * NWAVE;
        constexpr int N_MLP = 4 * 4096, N_FOX = 2 * 2048, N_MLA = 2 * 1040;
        for (int it = gw; it < N_MLP + N_FOX + N_MLA; it += NGW) {
            int r = it;
            if (r < N_MLP) { const int l = r >> 12, rr = r & 4095; bf16* wb = (bf16*)(ws + WS_W + W_MLP + (size_t)l * W_MLP_STRIDE);
                if (rr < 2048) transpose_item(p.in[I_W1] + (size_t)l * DM * FF, FF, DM, FF, wb, 0, 0, nullptr, scr, rr, lane);
                else transpose_item(p.in[I_W2] + (size_t)l * DM * FF, DM, FF, DM, wb + (size_t)FF * DM, 0, 0, nullptr, scr, rr - 2048, lane);
                continue; }
            r -= N_MLP;
            if (r < N_FOX) { const int j = r >> 11, rr = r & 2047; bf16* wb = (bf16*)(ws + WS_W + W_FOX + (size_t)j * W_FOX_STRIDE);
                if (rr < 1536) transpose_item(p.in[I_FWIN] + (size_t)j * DM * 3088, 3088, DM, 3072, wb, 0, 0, nullptr, scr, rr, lane);
                else transpose_item(p.in[I_FWOUT] + (size_t)j * DM * DM, DM, DM, DM, wb + (size_t)3072 * DM, 0, 0, nullptr, scr, rr - 1536, lane);
                continue; }
            r -= N_FOX;
            { const int j = r / 1040, rr = r % 1040; bf16* wb = (bf16*)(ws + WS_W + W_MLA + (size_t)j * W_MLA_STRIDE);
                if (rr < 128) transpose_item(p.in[I_MDQ] + (size_t)j * DM * 256, 256, DM, 256, wb, 0, 0, nullptr, scr, rr, lane);
                else if (rr < 208) transpose_item(p.in[I_MDKV] + (size_t)j * DM * 160, 160, DM, 160, wb, 0, 256, nullptr, scr, rr - 128, lane);
                else if (rr < 400) transpose_item(p.in[I_MUQ] + (size_t)j * 256 * 1536, 1536, 256, 1536, wb + (size_t)512 * 1024, 1, 0, p.in[I_MQG] + j * 256, scr, rr - 208, lane);
                else if (rr < 528) transpose_item(p.in[I_MUKV] + (size_t)j * 128 * 2048, 2048, 128, 2048, wb + (size_t)512 * 1024 + (size_t)1536 * 256, 2, 0, p.in[I_MKVG] + j * 128, scr, rr - 400, lane);
                else transpose_item(p.in[I_MOUT] + (size_t)j * DM * DM, DM, DM, DM, (bf16*)((unsigned char*)wb + 3 * MiB), 0, 0, nullptr, scr, rr - 528, lane);
            }
        }
    }
}

__device__ __forceinline__ void norm_phase(const float* x, const float* g, const float* sh0, const float* sc0, bf16* hout, bool gates, const float* wfsrc, const float* bfv, float* lf, LAS unsigned char* lds) {
    const int BID = obid(), GSZ = ogrid(); int tid_ = threadIdx.x; asm volatile("" : "+v"(tid_));
    const int tid = tid_, lane = tid & 63, wave = __builtin_amdgcn_readfirstlane(tid >> 6);
    LAS float* wfs = (LAS float*)lds;
    if (gates) {
        for (int idx = tid; idx < 16 * 1024; idx += NTHR) { const int k = idx >> 4, j = idx & 15; wfs[j * 1024 + k] = wfsrc[(size_t)k * 3088 + 3072 + j]; }
        __syncthreads();
    }
    const int gw = BID * NWAVE + wave, NGW = GSZ * NWAVE;
    for (int row = gw; row < M; row += NGW) {
        const int b = row >> 11;
        const f32x4* xr = (const f32x4*)(x + (size_t)row * DM) + lane;
        f32x4 v[4]; float ss = 0.f;
#pragma unroll
        for (int j = 0; j < 4; ++j) { v[j] = xr[64 * j]; ss += (v[j][0] * v[j][0] + v[j][1] * v[j][1]) + (v[j][2] * v[j][2] + v[j][3] * v[j][3]); }
        const float rstd = __builtin_amdgcn_rsqf(wave_sum(ss) * (1.0f / DM) + EPS);
        const f32x4* gp = (const f32x4*)g + lane; const f32x4* shp = (const f32x4*)(sh0 + (size_t)b * 6144) + lane; const f32x4* scp = (const f32x4*)(sc0 + (size_t)b * 6144) + lane;
        u32x2* o8 = (u32x2*)(hout + (size_t)row * DM) + lane;
#pragma unroll
        for (int j = 0; j < 4; ++j) { const f32x4 gg = gp[64 * j], sc = scp[64 * j], sh = shp[64 * j];
            v[j] = (v[j] * rstd) * gg * (sc + 1.0f) + sh;
            u32x2 w; w.x = pk2(v[j][0], v[j][1]); w.y = pk2(v[j][2], v[j][3]); o8[64 * j] = w; }
        if (gates) {
            float myz = 0.f;
#pragma unroll
            for (int jg = 0; jg < 16; ++jg) {
                float z = 0.f;
#pragma unroll
                for (int jj = 0; jj < 4; ++jj) { const f32x4 w = *(const LAS f32x4*)(wfs + jg * 1024 + 256 * jj + 4 * lane); z += (v[jj][0] * w[0] + v[jj][1] * w[1]) + (v[jj][2] * w[2] + v[jj][3] * w[3]); }
                z = wave_sum(z);
                if (lane == jg) myz = z;
            }
            if (lane < 16) { const float z = myz + bfv[lane]; lf[(size_t)row * 16 + lane] = fminf(z, 0.f) - __logf(1.0f + __expf(-fabsf(z))); }
        }
    }
}

__device__ __forceinline__ void final_norm(float* x, const float* g) {
    const int BID = obid(), GSZ = ogrid(); int tid_ = threadIdx.x; asm volatile("" : "+v"(tid_));
    const int tid = tid_, lane = tid & 63, wave = __builtin_amdgcn_readfirstlane(tid >> 6);
    const int gw = BID * NWAVE + wave, NGW = GSZ * NWAVE;
    for (int row = gw; row < M; row += NGW) {
        f32x4* xr = (f32x4*)(x + (size_t)row * DM) + lane;
        f32x4 v[4]; float ss = 0.f;
#pragma unroll
        for (int j = 0; j < 4; ++j) { v[j] = xr[64 * j]; ss += (v[j][0] * v[j][0] + v[j][1] * v[j][1]) + (v[j][2] * v[j][2] + v[j][3] * v[j][3]); }
        const float rstd = __builtin_amdgcn_rsqf(wave_sum(ss) * (1.0f / DM) + EPS);
        const f32x4* gp = (const f32x4*)g + lane;
#pragma unroll
        for (int j = 0; j < 4; ++j) xr[64 * j] = (v[j] * rstd) * gp[64 * j];
    }
}

__device__ __forceinline__ void fox_cumsum(const float* lf, bf16* Qb, bf16* Kb, LAS unsigned char* lds) {
    const int BID = obid(), GSZ = ogrid(); int tid_ = threadIdx.x; asm volatile("" : "+v"(tid_));
    const int tid = tid_, lane = tid & 63, wave = __builtin_amdgcn_readfirstlane(tid >> 6);
    LAS float* wtot = (LAS float*)lds;
    for (int bh = BID; bh < NB * NH; bh += GSZ) {
        const int b = bh >> 4, h = bh & 15; const int s0 = 4 * tid;
        float a[4];
#pragma unroll
        for (int i = 0; i < 4; ++i) a[i] = lf[((size_t)(b * SEQ + s0 + i)) * 16 + h];
        a[1] += a[0]; a[2] += a[1]; a[3] += a[2];
        float xs = a[3];
#pragma unroll
        for (int off = 1; off < 64; off <<= 1) { const float t = __shfl_up(xs, off); if (lane >= off) xs += t; }
        if (lane == 63) wtot[wave] = xs;
        __syncthreads();
        float base = 0.f;
#pragma unroll
        for (int w = 0; w < NWAVE; ++w) { const float t = wtot[w]; if (w < wave) base += t; }
        const float excl = xs - a[3] + base;
#pragma unroll
        for (int i = 0; i < 4; ++i) {
            const float F = (a[i] + excl) * LOG2E;
            const unsigned fh = f2bf(F); const float r1 = F - bf2f(fh); const unsigned fm = f2bf(r1); const float r2 = r1 - bf2f(fm); const unsigned fl = f2bf(r2);
            const size_t tok = (size_t)(b * SEQ + s0 + i);
            u32x4* qd = (u32x4*)(Qb + tok * 1280 + h * 80 + 64); u32x4* kd = (u32x4*)(Kb + tok * 1280 + h * 80 + 64);
            unsigned zz = 0u; asm volatile("" : "+v"(zz));
            qd[0] = (u32x4){0x3F803F80u, 0x3F80u | (fh << 16), fm | (fl << 16), zz}; qd[1] = (u32x4){zz, zz, zz, zz};
            kd[0] = (u32x4){(fh ^ 0x8000u) | ((fm ^ 0x8000u) << 16), (fl ^ 0x8000u) | (0x3F80u << 16), 0x3F803F80u, zz}; kd[1] = (u32x4){zz, zz, zz, zz};
        }
        __syncthreads();
    }
}

__device__ __forceinline__ int crow(int r, int hi) { return (r & 3) + 8 * (r >> 2) + 4 * hi; }
__device__ __forceinline__ unsigned cvtpk(float lo, float hi) { typedef __bf16 bf16x2_t __attribute__((ext_vector_type(2))); f32x2 v = {lo, hi}; bf16x2_t b = __builtin_convertvector(v, bf16x2_t); return __builtin_bit_cast(unsigned, b); }
typedef short v4i16_t __attribute__((ext_vector_type(4)));
__device__ __forceinline__ s16x4 vtr(const LAS unsigned char* p) { return __builtin_bit_cast(s16x4, __builtin_amdgcn_ds_read_tr16_b64_v4i16((LAS v4i16_t*)p)); }
#define MFMA32(a, b, c) __builtin_amdgcn_mfma_f32_32x32x16_bf16((a), (b), (c), 0, 0, 0)

template <int NKS>
__device__ __forceinline__ void attn_phase(LAS unsigned char* lds, const bf16* Q, const bf16* K, const bf16* V, bf16* O) {
    constexpr int QKD = 16 * NKS, QP = 16 * QKD, RS = QKD * 2 + 16, KCH = QKD / 8, NKC = 64 * KCH;
    constexpr int KB_BYTES = 64 * RS, L_K = 0, L_V = 2 * KB_BYTES, L_WS = L_V + 2 * 8192, L_ST = L_WS + NWAVE * 128;
    static_assert(L_ST + NWAVE * 4096 <= LDS_BYTES, "attention LDS");
    const int BID = obid(), GSZ = ogrid(); int tid_ = threadIdx.x; asm volatile("" : "+v"(tid_));
    const int tid = tid_, lane = tid & 63, r32 = lane & 31, hi = lane >> 5; const int wid = __builtin_amdgcn_readfirstlane(tid >> 6);
    LAS float* wsf = (LAS float*)(lds + L_WS) + wid * 32;
    LAS bf16* stg = (LAS bf16*)(lds + L_ST) + wid * 2048;
    const int kr0 = tid / KCH, kc0 = tid % KCH, kr1 = (tid + 512) / KCH, kc1 = (tid + 512) % KCH; const bool has1 = (tid + 512) < NKC;
    const int vr = tid >> 3, vc = tid & 7;
    const int kl0 = kr0 * RS + kc0 * 16, kl1 = kr1 * RS + kc1 * 16;
    const int vl = vr * 128 + ((((vc >> 2) ^ ((vr >> 1) & 1))) * 64) + (vc & 3) * 16;
    const int kfb = r32 * RS + hi * 16;
    const int i16 = lane & 15, qq = i16 >> 2, pp = i16 & 3, blk = (lane >> 4) & 1, swz = (qq >> 1) & 1;
    const int vfb0 = (4 * hi + qq) * 128 + 32 * blk + 8 * pp + swz * 64, vfb1 = (4 * hi + qq) * 128 + 32 * blk + 8 * pp + (swz ^ 1) * 64;
    for (int bh = BID; bh < NB * NH; bh += GSZ) {
        const int b = bh >> 4, h = bh & 15; const size_t rowbase = (size_t)b * SEQ;
        const bf16* Kh = K + rowbase * QP + h * QKD; const bf16* Vh = V + rowbase * DM + h * 64;
        for (int qi = 0; qi < SEQ / 256; ++qi) {
            const int qb = (SEQ / 256 - 1) - qi; const int q0 = qb * 256; const int NT = 4 * qb + 4; const int NTw = 4 * qb + (wid >> 1) + 1;
            const int qabs = q0 + wid * 32 + r32;
            const bf16* Qw = Q + (rowbase + qabs) * QP + h * QKD + hi * 8;
            bf16x8 qr[NKS];
#pragma unroll
            for (int ks = 0; ks < NKS; ++ks) qr[ks] = *(const bf16x8*)(Qw + ks * 16);
            u32x4 ka, kb2, va;
            ka = *(const u32x4*)(Kh + (size_t)kr0 * QP + kc0 * 8); if (has1) kb2 = *(const u32x4*)(Kh + (size_t)kr1 * QP + kc1 * 8);
            va = *(const u32x4*)(Vh + (size_t)vr * DM + vc * 8);
            *(LAS u32x4*)(lds + L_K + kl0) = ka; if (has1) *(LAS u32x4*)(lds + L_K + kl1) = kb2; *(LAS u32x4*)(lds + L_V + vl) = va;
            __syncthreads();
            float mrow = -1e30f, lrow = 0.f; f32x16 o0, o1;
#pragma unroll
            for (int i = 0; i < 16; ++i) { o0[i] = 0.f; o1[i] = 0.f; }
            for (int t = 0; t < NT; ++t) {
                const int buf = t & 1;
                const bool more = (t + 1 < NT);
                if (more) { const size_t ro = (size_t)(t + 1) * 64;
                    ka = *(const u32x4*)(Kh + (ro + kr0) * QP + kc0 * 8); if (has1) kb2 = *(const u32x4*)(Kh + (ro + kr1) * QP + kc1 * 8);
                    va = *(const u32x4*)(Vh + (ro + vr) * DM + vc * 8); }
                if (t < NTw) {
                    const LAS unsigned char* Kl = lds + L_K + buf * KB_BYTES + kfb; const LAS unsigned char* Vl = lds + L_V + buf * 8192;
                    f32x16 p0, p1;
#pragma unroll
                    for (int i = 0; i < 16; ++i) { p0[i] = 0.f; p1[i] = 0.f; }
#pragma unroll
                    for (int ks = 0; ks < NKS; ++ks) { const bf16x8 a0 = *(const LAS bf16x8*)(Kl + ks * 32), a1 = *(const LAS bf16x8*)(Kl + 32 * RS + ks * 32);
                        p0 = MFMA32(a0, qr[ks], p0); p1 = MFMA32(a1, qr[ks], p1); }
                    if (64 * t + 63 > q0 + wid * 32) {
                        const int kb0 = 64 * t + 4 * hi;
#pragma unroll
                        for (int i = 0; i < 16; ++i) { const int kv = kb0 + (i & 3) + 8 * (i >> 2); if (kv > qabs) p0[i] = -INFINITY; if (kv + 32 > qabs) p1[i] = -INFINITY; }
                    }
                    float rm = fmaxf(p0[0], p1[0]);
#pragma unroll
                    for (int i = 1; i < 16; ++i) rm = fmaxf(rm, fmaxf(p0[i], p1[i]));
                    rm = fmaxf(rm, __shfl_xor(rm, 32));
                    const float mn = fmaxf(mrow, rm); const float alpha = __builtin_amdgcn_exp2f(mrow - mn); mrow = mn;
                    float ls = 0.f;
#pragma unroll
                    for (int i = 0; i < 16; ++i) { p0[i] = __builtin_amdgcn_exp2f(p0[i] - mn); p1[i] = __builtin_amdgcn_exp2f(p1[i] - mn); ls += p0[i] + p1[i]; }
                    lrow = lrow * alpha + ls;
                    if (!__all(alpha == 1.0f)) {
                        if (hi == 0) wsf[r32] = alpha;
                        asm volatile("" ::: "memory");
#pragma unroll
                        for (int g4 = 0; g4 < 4; ++g4) { const f32x4 a = *(const LAS f32x4*)(wsf + 8 * g4 + 4 * hi);
#pragma unroll
                            for (int j = 0; j < 4; ++j) { o0[4 * g4 + j] *= a[j]; o1[4 * g4 + j] *= a[j]; } }
                    }
                    bf16x8 PA[4];
                    { u32x4 w;
                      w = (u32x4){cvtpk(p0[0], p0[1]), cvtpk(p0[2], p0[3]), cvtpk(p0[4], p0[5]), cvtpk(p0[6], p0[7])}; PA[0] = __builtin_bit_cast(bf16x8, w);
                      w = (u32x4){cvtpk(p0[8], p0[9]), cvtpk(p0[10], p0[11]), cvtpk(p0[12], p0[13]), cvtpk(p0[14], p0[15])}; PA[1] = __builtin_bit_cast(bf16x8, w);
                      w = (u32x4){cvtpk(p1[0], p1[1]), cvtpk(p1[2], p1[3]), cvtpk(p1[4], p1[5]), cvtpk(p1[6], p1[7])}; PA[2] = __builtin_bit_cast(bf16x8, w);
                      w = (u32x4){cvtpk(p1[8], p1[9]), cvtpk(p1[10], p1[11]), cvtpk(p1[12], p1[13]), cvtpk(p1[14], p1[15])}; PA[3] = __builtin_bit_cast(bf16x8, w); }
#pragma unroll
                    for (int kk = 0; kk < 4; ++kk) {
                        const s16x4 l0 = vtr(Vl + vfb0 + kk * 2048), h0 = vtr(Vl + vfb0 + kk * 2048 + 1024);
                        const s16x4 l1 = vtr(Vl + vfb1 + kk * 2048), h1 = vtr(Vl + vfb1 + kk * 2048 + 1024);
                        const bf16x8 b0 = (bf16x8){l0[0], l0[1], l0[2], l0[3], h0[0], h0[1], h0[2], h0[3]};
                        const bf16x8 b1 = (bf16x8){l1[0], l1[1], l1[2], l1[3], h1[0], h1[1], h1[2], h1[3]};
                        o0 = MFMA32(PA[kk], b0, o0); o1 = MFMA32(PA[kk], b1, o1);
                    }
                }
                if (more) { const int nb = buf ^ 1;
                    *(LAS u32x4*)(lds + L_K + nb * KB_BYTES + kl0) = ka; if (has1) *(LAS u32x4*)(lds + L_K + nb * KB_BYTES + kl1) = kb2; *(LAS u32x4*)(lds + L_V + nb * 8192 + vl) = va; }
                __syncthreads();
            }
            lrow += __shfl_xor(lrow, 32);
            if (hi == 0) wsf[r32] = 1.0f / lrow;
            asm volatile("" ::: "memory");
#pragma unroll
            for (int g4 = 0; g4 < 4; ++g4) { const f32x4 a = *(const LAS f32x4*)(wsf + 8 * g4 + 4 * hi);
#pragma unroll
                for (int j = 0; j < 4; ++j) { const int i = 4 * g4 + j; const int orow = crow(i, hi);
                    stg[orow * 64 + r32] = (bf16)f2bf(o0[i] * a[j]); stg[orow * 64 + 32 + r32] = (bf16)f2bf(o1[i] * a[j]); } }
            asm volatile("s_waitcnt lgkmcnt(0)" ::: "memory");
            bf16* Ow = O + (rowbase + q0 + wid * 32) * DM + h * 64;
#pragma unroll
            for (int i = 0; i < 4; ++i) { const int row = i * 8 + (lane >> 3), ch = lane & 7; const u32x4 v = *(const LAS u32x4*)(stg + row * 64 + ch * 8); *(u32x4*)(Ow + (size_t)row * DM + ch * 8) = v; }
            __syncthreads();
        }
    }
}

#define XB_TMO      128
#define XB_XCNT(j)  (256  + 64 * (j))
#define XB_XSUB(j)  (1280 + 64 * (j))
#define XB_XGEN(j)  (2304 + 64 * (j))
#define XB_TOP      3328
#define XB_TOPGEN   3392
#define XCD_BAR_WORDS 3456
#define XB_SPIN_CAP (1u << 18)

__device__ __forceinline__ unsigned xb_ld(unsigned* p)              { return __hip_atomic_load(p, __ATOMIC_RELAXED, __HIP_MEMORY_SCOPE_AGENT); }
__device__ __forceinline__ unsigned xb_add(unsigned* p, unsigned v) { return __hip_atomic_fetch_add(p, v, __ATOMIC_RELAXED, __HIP_MEMORY_SCOPE_AGENT); }
__device__ __forceinline__ unsigned xb_xcc_id() { return (unsigned)__builtin_amdgcn_s_getreg((3 << 11) | 20) & 0xFu; }
#define XB_SPIN(cond, bar) do { unsigned _sp = 0; while (cond) { __builtin_amdgcn_s_sleep(1); \
    if ((++_sp & 255u) == 0u) { if (xb_ld(&(bar)[XB_TMO])) break; if (_sp > XB_SPIN_CAP) { atomicAdd(&(bar)[XB_TMO], 1u); break; } } } } while (0)

struct XcdBarrier {
    unsigned* bar; unsigned x;
    volatile LAS unsigned* st;
};

__device__ __forceinline__ XcdBarrier xcd_barrier_post(unsigned* bar, volatile LAS unsigned* st) {
    XcdBarrier b; b.bar = bar; b.x = xb_xcc_id(); b.st = st;
    if (threadIdx.x == 0) (void)xb_add(&bar[XB_XCNT(b.x)], 1u);
    return b;
}
__device__ __forceinline__ void xcd_barrier_complete(unsigned* bar, unsigned x, unsigned& nloc, unsigned& nx) {
    const unsigned G = gridDim.x * gridDim.y * gridDim.z;
    unsigned sum, cnt, mine, sp = 0u;
    for (;;) {
        sum = 0u; cnt = 0u; mine = 0u;
#pragma unroll
        for (unsigned j = 0; j < 16; ++j) { const unsigned c = xb_ld(&bar[XB_XCNT(j)]); sum += c; cnt += (c > 0u) ? 1u : 0u; mine = (j == x) ? c : mine; }
        if (sum == G) break;
        __builtin_amdgcn_s_sleep(1);
        if ((++sp & 255u) == 0u) { if (xb_ld(&bar[XB_TMO])) break; if (sp > XB_SPIN_CAP) { atomicAdd(&bar[XB_TMO], 1u); break; } }
    }
    nloc = mine > 0u ? mine : 1u; nx = cnt > 0u ? cnt : 1u;
}

__device__ __forceinline__ void xcd_barrier(const XcdBarrier& b) {
    asm volatile("s_waitcnt vmcnt(0)" ::: "memory");
    __syncthreads();
    if (threadIdx.x == 0) {
        unsigned* bar = b.bar;
        __builtin_amdgcn_s_waitcnt(0);
        unsigned nloc = b.st[0], nx = b.st[1];
        if (nloc == 0u) { xcd_barrier_complete(bar, b.x, nloc, nx); b.st[0] = nloc; b.st[1] = nx; }
        const unsigned old = xb_add(&bar[XB_XSUB(b.x)], 1u);
        const unsigned gen = old / nloc;
        if (old + 1u == (gen + 1u) * nloc) {
            __builtin_amdgcn_fence(__ATOMIC_RELEASE, "agent");
            asm volatile("s_waitcnt vmcnt(0)" ::: "memory");
            const unsigned og = xb_add(&bar[XB_TOP], 1u);
            const unsigned tg = og / nx;
            if (og + 1u == (tg + 1u) * nx) xb_add(&bar[XB_TOPGEN], 1u);
            else XB_SPIN(xb_ld(&bar[XB_TOPGEN]) == tg, bar);
            __builtin_amdgcn_fence(__ATOMIC_ACQUIRE, "agent");
            xb_add(&bar[XB_XGEN(b.x)], 1u);
            asm volatile("s_waitcnt vmcnt(0)" ::: "memory");
        } else {
            XB_SPIN(xb_ld(&bar[XB_XGEN(b.x)]) == gen, bar);
            __builtin_amdgcn_fence(__ATOMIC_ACQUIRE, "agent");
            asm volatile("s_waitcnt vmcnt(0)" ::: "memory");
        }
    }
    __syncthreads();
}

constexpr int PTR_OFF = 131072;
__device__ __forceinline__ const float* inptr(LAS unsigned char* lds, int i) {
    unsigned off = PTR_OFF + 8 * i; asm volatile("" : "+v"(off));
    const u32x2 v = *(const LAS u32x2*)(lds + off);
    const unsigned lo = __builtin_amdgcn_readfirstlane(v.x), hi = __builtin_amdgcn_readfirstlane(v.y);
    return (const float*)(((unsigned long long)hi << 32) | lo);
}
__global__ void __launch_bounds__(NTHR, 2) trunk_fwd(Params p) {
    extern __shared__ __attribute__((aligned(16))) unsigned char lds_raw[];
    LAS unsigned char* lds = (LAS unsigned char*)lds_raw;
    cg::grid_group grid = cg::this_grid();
#ifndef NO_PRO
    prologue(p, lds);
#endif
    if (threadIdx.x < 22) { const unsigned long long v = (threadIdx.x < 20) ? (unsigned long long)p.in[threadIdx.x < 20 ? threadIdx.x : 0] : (threadIdx.x == 20 ? (unsigned long long)p.out : (unsigned long long)p.ws);
        ((LAS unsigned long long*)(lds + PTR_OFF))[threadIdx.x] = v; }
    if (threadIdx.x < 2) ((volatile LAS unsigned*)(lds + PTR_OFF + 256))[threadIdx.x] = 0u;
    if (blockIdx.x == 0) { unsigned* bw = (unsigned*)(p.ws + WS_CTL); for (int i = threadIdx.x; i < XCD_BAR_WORDS; i += NTHR) __hip_atomic_store(bw + i, 0u, __ATOMIC_RELAXED, __HIP_MEMORY_SCOPE_AGENT); }
    __syncthreads();
    grid.sync();
    const XcdBarrier bar = xcd_barrier_post((unsigned*)(p.ws + WS_CTL), (volatile LAS unsigned*)(lds + PTR_OFF + 256));
#ifdef PROBE_SYNC2
#define GSYNC() do { xcd_barrier(bar); xcd_barrier(bar); } while (0)
#else
#define GSYNC() xcd_barrier(bar)
#endif
#define WSP ((unsigned char*)inptr(lds, 21))
#define XRES ((float*)inptr(lds, 20))
#pragma nounroll
    for (int l = 0; l < DEPTH; ++l) {
        const int j = l >> 1; const bool fox = (l & 1) == 0;
#ifndef NO_NORM
        { unsigned char* ws = WSP; const float* modl = (const float*)(ws + WS_MOD) + (size_t)l * 16 * 6144;
          norm_phase((l == 0) ? inptr(lds, I_X) : XRES, inptr(lds, I_GMIX) + l * DM, modl + 0, modl + 1024, (bf16*)(ws + WS_H), fox, inptr(lds, I_FWIN) + (size_t)j * DM * 3088, inptr(lds, I_FBF) + j * 16, (float*)(ws + WS_LF), lds); }
#endif
        GSYNC();
        if (fox) {
#ifndef NO_CUM
            { unsigned char* ws = WSP; fox_cumsum((const float*)(ws + WS_LF), (bf16*)(ws + WS_Q), (bf16*)(ws + WS_K), lds); }
#endif
#ifndef NO_G1F
            { unsigned char* ws = WSP; const bf16* WinT = (const bf16*)(ws + WS_W + W_FOX + (size_t)j * W_FOX_STRIDE);
              pg8::Gemm g{(const bf16*)(ws + WS_H), WinT, M, 3072, DM}; pg8::StaticOrder S; S.init(M, 3072, ogrid(), obid());
              pg8::EpiQkvFox E{ws, 0.125f * LOG2E};
              pg8::gemm_phase<pg8::EpiQkvFox, pg8::StaticOrder, true, true>(lds, g, S, E); }
#endif
            GSYNC();
#ifndef NO_ATT5
            { unsigned char* ws = WSP; attn_phase<5>(lds, (const bf16*)(ws + WS_Q), (const bf16*)(ws + WS_K), (const bf16*)(ws + WS_V), (bf16*)(ws + WS_H)); }
#ifdef PROBE_ATT2
            { unsigned char* ws = WSP; attn_phase<5>(lds, (const bf16*)(ws + WS_Q), (const bf16*)(ws + WS_K), (const bf16*)(ws + WS_V), (bf16*)(ws + WS_H)); }
#endif
#endif
            GSYNC();
        } else {
#ifndef NO_GD
            { unsigned char* ws = WSP; const bf16* WdT = (const bf16*)(ws + WS_W + W_MLA + (size_t)j * W_MLA_STRIDE);
              pg8::Gemm g{(const bf16*)(ws + WS_H), WdT, M, 512, DM}; pg8::StaticOrder S; S.init(M, 512, ogrid(), obid());
              pg8::EpiMlaDown E{ws};
              pg8::gemm_phase<pg8::EpiMlaDown, pg8::StaticOrder, true, true>(lds, g, S, E); }
#endif
            GSYNC();
#ifndef NO_GQ
            { unsigned char* ws = WSP; const bf16* WuqT = (const bf16*)(ws + WS_W + W_MLA + (size_t)j * W_MLA_STRIDE) + (size_t)512 * 1024;
              int Kq = 256; asm volatile("" : "+s"(Kq));
              pg8::Gemm g{(const bf16*)(ws + WS_CQ), WuqT, M, 1536, Kq}; pg8::StaticOrder S; S.init(M, 1536, ogrid(), obid());
              pg8::EpiMlaQ E{ws, 0.10206207261596575f * LOG2E};
              pg8::gemm_phase<pg8::EpiMlaQ, pg8::StaticOrder, true, true>(lds, g, S, E); }
#endif
#ifndef NO_GKV
            { unsigned char* ws = WSP; const bf16* WukvT = (const bf16*)(ws + WS_W + W_MLA + (size_t)j * W_MLA_STRIDE) + (size_t)512 * 1024 + (size_t)1536 * 256;
              int Kkv = 128; asm volatile("" : "+s"(Kkv));
              pg8::Gemm g{(const bf16*)(ws + WS_CKV), WukvT, M, 2048, Kkv}; pg8::StaticOrder S; S.init(M, 2048, ogrid(), obid());
              pg8::EpiMlaKv E{ws};
              pg8::gemm_phase<pg8::EpiMlaKv, pg8::StaticOrder, true, true>(lds, g, S, E); }
#endif
            GSYNC();
#ifndef NO_ATT6
            { unsigned char* ws = WSP; attn_phase<6>(lds, (const bf16*)(ws + WS_Q), (const bf16*)(ws + WS_K), (const bf16*)(ws + WS_V), (bf16*)(ws + WS_H)); }
#ifdef PROBE_ATT2
            { unsigned char* ws = WSP; attn_phase<6>(lds, (const bf16*)(ws + WS_Q), (const bf16*)(ws + WS_K), (const bf16*)(ws + WS_V), (bf16*)(ws + WS_H)); }
#endif
#endif
            GSYNC();
        }
#ifndef NO_GO
        { unsigned char* ws = WSP; const float* modl = (const float*)(ws + WS_MOD) + (size_t)l * 16 * 6144;
          const bf16* WoutT = fox ? (const bf16*)(ws + WS_W + W_FOX + (size_t)j * W_FOX_STRIDE) + (size_t)3072 * DM : (const bf16*)(ws + WS_W + W_MLA + (size_t)j * W_MLA_STRIDE + 3 * MiB);
          float* xres = XRES;
          pg8::Gemm g{(const bf16*)(ws + WS_H), WoutT, M, DM, DM}; pg8::StaticOrder S; S.init(M, DM, ogrid(), obid());
          pg8::EpiResid E{(l == 0) ? inptr(lds, I_X) : xres, xres, modl + 2048};
          pg8::gemm_phase<pg8::EpiResid, pg8::StaticOrder, true, true>(lds, g, S, E); }
#endif
        GSYNC();
#ifndef NO_NORM2
        { unsigned char* ws = WSP; const float* modl = (const float*)(ws + WS_MOD) + (size_t)l * 16 * 6144;
          norm_phase(XRES, inptr(lds, I_GMLP) + l * DM, modl + 3072, modl + 4096, (bf16*)(ws + WS_H), false, nullptr, nullptr, nullptr, lds); }
#endif
        GSYNC();
#ifndef NO_GU
        { unsigned char* ws = WSP; const bf16* W1T = (const bf16*)(ws + WS_W + W_MLP + (size_t)l * W_MLP_STRIDE);
          pg8::Gemm g{(const bf16*)(ws + WS_H), W1T, M, FF, DM}; pg8::StaticOrder S; S.init(M, FF, ogrid(), obid());
          pg8::EpiRelu2 E{ws};
          pg8::gemm_phase<pg8::EpiRelu2, pg8::StaticOrder, true, true>(lds, g, S, E); }
#endif
        GSYNC();
#ifndef NO_GDN
        { unsigned char* ws = WSP; const float* modl = (const float*)(ws + WS_MOD) + (size_t)l * 16 * 6144;
          const bf16* W2T = (const bf16*)(ws + WS_W + W_MLP + (size_t)l * W_MLP_STRIDE) + (size_t)FF * DM;
          float* xres = XRES;
          pg8::Gemm g{(const bf16*)(ws + WS_BIG), W2T, M, DM, FF}; pg8::StaticOrder S; S.init(M, DM, ogrid(), obid());
          pg8::EpiResid E{xres, xres, modl + 5120};
          pg8::gemm_phase<pg8::EpiResid, pg8::StaticOrder, true, true>(lds, g, S, E); }
#endif
        GSYNC();
    }
    final_norm(XRES, inptr(lds, I_GFIN));
}

extern "C" void kernel_launch(void* const* d_in, const int* in_sizes, int n_in, void* d_out, int out_size, void* d_ws, size_t ws_size, hipStream_t stream) {
    static int grid = 0;
    if (grid == 0) {
        if (n_in != 20 || in_sizes[0] != M * DM || out_size != M * DM || ws_size < WS_END) { fprintf(stderr, "kernel_launch: unexpected shapes (n_in %d, in0 %d, out %d, ws %zu)\n", n_in, n_in > 0 ? in_sizes[0] : -1, out_size, ws_size); grid = -1; return; }
        int dev = 0, cus = 0, per_cu = 0;
        if (hipGetDevice(&dev) != hipSuccess || hipDeviceGetAttribute(&cus, hipDeviceAttributeMultiprocessorCount, dev) != hipSuccess) { fprintf(stderr, "kernel_launch: device query failed\n"); grid = -1; return; }
        if (hipFuncSetAttribute((const void*)trunk_fwd, hipFuncAttributeMaxDynamicSharedMemorySize, LDS_BYTES) != hipSuccess) { fprintf(stderr, "kernel_launch: hipFuncSetAttribute failed\n"); grid = -1; return; }
        if (hipOccupancyMaxActiveBlocksPerMultiprocessor(&per_cu, (const void*)trunk_fwd, NTHR, LDS_BYTES) != hipSuccess || per_cu < 1) { fprintf(stderr, "kernel_launch: occupancy query gave %d\n", per_cu); per_cu = 1; }
        (void)hipGetLastError();
        grid = cus * per_cu;
    }
    if (grid < 0) return;
    Params prm{};
    for (int i = 0; i < 20; ++i) prm.in[i] = (const float*)d_in[i];
    prm.out = (float*)d_out; prm.ws = (unsigned char*)d_ws;
    void* args[] = {&prm};
    hipError_t e = hipLaunchCooperativeKernel((const void*)trunk_fwd, dim3(grid), dim3(NTHR), args, LDS_BYTES, stream);
    if (e != hipSuccess) fprintf(stderr, "kernel_launch: cooperative launch failed: %s (grid %d)\n", hipGetErrorString(e), grid);
}
```

```cpp
#include <hip/hip_runtime.h>
#include <hip/hip_cooperative_groups.h>
#include <cstdio>
#include <cstdint>
namespace cg = cooperative_groups;
#define LAS __attribute__((address_space(3)))
typedef unsigned short bf16;
typedef short bf16x8 __attribute__((ext_vector_type(8)));
typedef short s16x4 __attribute__((ext_vector_type(4)));
typedef float f32x16 __attribute__((ext_vector_type(16)));
typedef float f32x4 __attribute__((ext_vector_type(4)));
typedef float f32x2 __attribute__((ext_vector_type(2)));
typedef unsigned u32x4 __attribute__((ext_vector_type(4)));
typedef unsigned u32x2 __attribute__((ext_vector_type(2)));

constexpr int NB = 16, SEQ = 2048, DM = 1024, NH = 16, FF = 4096, DEPTH = 4;
constexpr int M = NB * SEQ;
constexpr int NTHR = 512, NWAVE = 8;
constexpr float EPS = 1e-6f, LOG2E = 1.4426950408889634f;
constexpr size_t MiB = 1u << 20;
constexpr size_t WS_BIG = 0;
constexpr size_t WS_Q = 0, WS_K = 96 * MiB, WS_V = 192 * MiB;
constexpr size_t WS_H = 256 * MiB;
constexpr size_t WS_CQ = 320 * MiB, WS_CKV = 336 * MiB;
constexpr size_t WS_W = 344 * MiB;
constexpr size_t W_FOX = 0, W_FOX_STRIDE = 8 * MiB;
constexpr size_t W_MLA = 16 * MiB, W_MLA_STRIDE = 5 * MiB;
constexpr size_t W_MLP = 26 * MiB, W_MLP_STRIDE = 16 * MiB;
constexpr size_t WS_MOD = 436 * MiB;
constexpr size_t WS_CS = 438 * MiB;
constexpr size_t WS_LF = 442 * MiB;
constexpr size_t WS_SSQQ = 444 * MiB, WS_SSQKV = 445 * MiB;
constexpr size_t WS_CTL = 446 * MiB;
constexpr size_t WS_END = 447 * MiB;
static_assert(WS_W + W_MLP + 4 * W_MLP_STRIDE <= WS_MOD, "weights fit");
constexpr int LDS_BYTES = 135168;

template <int MASK> __device__ __forceinline__ float xor_sum(float v) {
    if constexpr (MASK == 32) return v + __shfl_xor(v, 32);
    else return v + __builtin_bit_cast(float, __builtin_amdgcn_ds_swizzle(__builtin_bit_cast(int, v), (MASK << 10) | 0x1F));
}
template <int MASK> __device__ __forceinline__ float xor_get(float v, bool upper) {
    if constexpr (MASK == 32) return __shfl_xor(v, 32);
    else return __builtin_bit_cast(float, __builtin_amdgcn_ds_swizzle(__builtin_bit_cast(int, v), (MASK << 10) | 0x1F));
}
__device__ __forceinline__ float wave_sum(float v) { v = xor_sum<1>(v); v = xor_sum<2>(v); v = xor_sum<4>(v); v = xor_sum<8>(v); v = xor_sum<16>(v); v = xor_sum<32>(v); return v; }
namespace pg8 {
#define PG8_LAS __attribute__((address_space(3)))
typedef unsigned short bf16_t;
typedef short bf16x8 __attribute__((ext_vector_type(8)));
typedef float f32x4 __attribute__((ext_vector_type(4)));
typedef unsigned u32x4 __attribute__((ext_vector_type(4)));
constexpr int BM = 256, BK = 64, HALF = 128, HTB = HALF * BK * 2  , STAGE_BYTES = 8 * HTB, NXCD = 8, WGM = 8;

__host__ __device__ __forceinline__ int lds_byte(int r, int c) { const int st = (r >> 4) * 2 + (c >> 5), rr = r & 15, cc = c & 31, ob = rr * 64 + cc * 2; return st * 1024 + (ob ^ (((ob >> 9) & 1) << 5)); }
__host__ __device__ __forceinline__ void stage_rc(int b, int& R, int& C) { const int st = b / 1024, sb = b % 1024, swz = sb ^ (((sb >> 9) & 1) << 5); R = (st >> 1) * 16 + swz / 64; C = (st & 1) * 32 + (swz % 64) / 2; }
__host__ __device__ __forceinline__ int perm32(int rho) { const int n = rho >> 4, i = rho & 15; return 8 * (i >> 2) + 4 * n + (i & 3); }

struct Unit { int pm, pn; };
struct Gemm { const bf16_t* A; const bf16_t* Bt; int M, N, K; };

struct StaticOrder {
    int nM, nN, nwg, G, c;
    __host__ __device__ void init(int M, int N, int G_, int c_) { nM = M / BM; nN = N / BM; nwg = nM * nN; G = G_; c = c_; }
    __host__ __device__ bool next(int i, Unit& u) const {
        const long L = (long)i * G + c; if (L >= nwg) return false;
        int wgid = (int)L; { const int q = nwg / NXCD, r = nwg % NXCD, xcd = wgid % NXCD, off = wgid / NXCD; wgid = (xcd < r ? xcd * (q + 1) : r * (q + 1) + (xcd - r) * q) + off; }
        const int nig = WGM * nN, gid = wgid / nig, fm = gid * WGM, gsz = (nM - fm) < WGM ? (nM - fm) : WGM;
        u.pm = fm + ((wgid % nig) % gsz); u.pn = (wgid % nig) / gsz; return true;
    }
    __device__ __forceinline__ void a_ready(const Unit&) const {}
    __device__ __forceinline__ void done(const Unit&) const {}
};

__device__ __forceinline__ unsigned cvt_pk_bf16(float lo, float hi) { unsigned r; asm volatile("v_cvt_pk_bf16_f32 %0, %1, %2" : "=v"(r) : "v"(lo), "v"(hi)); return r; }
typedef float f32x2 __attribute__((ext_vector_type(2)));
typedef unsigned u32x2 __attribute__((ext_vector_type(2)));
#define GAS __attribute__((address_space(1)))
typedef GAS bf16_t gbf16; typedef GAS float gf32; typedef GAS unsigned char gu8;
constexpr float RMS_EPS = 1e-6f;
__device__ __forceinline__ u32x4 pack8(const f32x4& v0, const f32x4& v1) { u32x4 w; w.x = cvt_pk_bf16(v0[0], v0[1]); w.y = cvt_pk_bf16(v0[2], v0[3]); w.z = cvt_pk_bf16(v1[0], v1[1]); w.w = cvt_pk_bf16(v1[2], v1[3]); return w; }
__device__ __forceinline__ u32x2 pack4(const f32x4& v) { u32x2 w; w.x = cvt_pk_bf16(v[0], v[1]); w.y = cvt_pk_bf16(v[2], v[3]); return w; }

struct EpiQkvFox {
    static constexpr bool PERM = true, AFTER_DRAIN = false;
    unsigned char* ws; float qscale;
    __device__ __forceinline__ void operator()(const f32x4 (&acc)[2][2][4][2], const Unit& u, int wr, int wc, int fr, int fq) const {
        gbf16* Q = (gbf16*)((gu8*)ws + WS_Q); gbf16* Kp = (gbf16*)((gu8*)ws + WS_K); gbf16* V = (gbf16*)((gu8*)ws + WS_V);
        const int row0 = u.pm * BM + wr * 64 + fr;
        const int t = u.pn >> 2;
        const int cin0 = (u.pn & 3) * BM + wc * 32 + 8 * fq;
        const float sc = (t == 0) ? qscale : 1.f;
#pragma unroll
        for (int ai = 0; ai < 2; ++ai)
#pragma unroll
            for (int m = 0; m < 4; ++m) { const unsigned row = (unsigned)(row0 + ai * HALF + m * 16);
#pragma unroll
                for (int bj = 0; bj < 2; ++bj) { const int cin = cin0 + bj * HALF;
                    gbf16* dst = (t == 2) ? (V + row * 1024 + cin) : ((t == 0 ? Q : Kp) + row * 1280 + (cin >> 6) * 80 + (cin & 63));
                    *(GAS u32x4*)dst = pack8(acc[ai][bj][m][0] * sc, acc[ai][bj][m][1] * sc); } }
    }
};
struct EpiRelu2 {
    static constexpr bool PERM = true, AFTER_DRAIN = false;
    unsigned char* ws;
    __device__ __forceinline__ void operator()(const f32x4 (&acc)[2][2][4][2], const Unit& u, int wr, int wc, int fr, int fq) const {
        gbf16* H = (gbf16*)((gu8*)ws + WS_BIG);
        const int row0 = u.pm * BM + wr * 64 + fr; const int col0 = u.pn * BM + wc * 32 + 8 * fq;
#pragma unroll
        for (int ai = 0; ai < 2; ++ai)
#pragma unroll
            for (int m = 0; m < 4; ++m) { gbf16* rowp = H + (unsigned)(row0 + ai * HALF + m * 16) * 4096u + (unsigned)col0;
#pragma unroll
                for (int bj = 0; bj < 2; ++bj) { f32x4 v0 = acc[ai][bj][m][0], v1 = acc[ai][bj][m][1];
#pragma unroll
                    for (int j = 0; j < 4; ++j) { const float a = fmaxf(v0[j], 0.f), b = fmaxf(v1[j], 0.f); v0[j] = a * a; v1[j] = b * b; }
                    *(GAS u32x4*)(rowp + bj * HALF) = pack8(v0, v1); } }
    }
};
struct EpiResid {
    static constexpr bool PERM = false, AFTER_DRAIN = false;
    const float* base_; float* out_; const float* gate_;
    __device__ __forceinline__ void operator()(const f32x4 (&acc)[2][2][4][2], const Unit& u, int wr, int wc, int fr, int fq) const {
        const gf32* base = (const gf32*)base_; gf32* out = (gf32*)out_; const gf32* gate = (const gf32*)gate_;
        const int row0 = u.pm * BM + wr * 64 + fr; const int col0 = u.pn * BM + wc * 32 + 4 * fq;
        const gf32* gp = gate + (size_t)(u.pm >> 3) * 6144 + col0;
        f32x4 gv[2][2];
#pragma unroll
        for (int bj = 0; bj < 2; ++bj)
#pragma unroll
            for (int n = 0; n < 2; ++n) gv[bj][n] = *(const GAS f32x4*)(gp + bj * HALF + n * 16);
#pragma unroll
        for (int ai = 0; ai < 2; ++ai)
#pragma unroll
            for (int m = 0; m < 4; ++m) { const unsigned off = (unsigned)(row0 + ai * HALF + m * 16) * 1024u + (unsigned)col0;
#pragma unroll
                for (int bj = 0; bj < 2; ++bj)
#pragma unroll
                    for (int n = 0; n < 2; ++n) { const f32x4 bs = *(const GAS f32x4*)(base + off + bj * HALF + n * 16);
                        *(GAS f32x4*)(out + off + bj * HALF + n * 16) = bs + gv[bj][n] * acc[ai][bj][m][n]; } }
    }
};
struct EpiMlaKv {
    static constexpr bool PERM = true, AFTER_DRAIN = false;
    unsigned char* ws;
    __device__ __forceinline__ void operator()(const f32x4 (&acc)[2][2][4][2], const Unit& u, int wr, int wc, int fr, int fq) const {
        const gf32* ssq = (const gf32*)((gu8*)ws + WS_SSQKV); gbf16* Kp = (gbf16*)((gu8*)ws + WS_K); gbf16* V = (gbf16*)((gu8*)ws + WS_V);
        const int row0 = u.pm * BM + wr * 64 + fr;
        const int t = u.pn >> 2; const int cin0 = (u.pn & 3) * BM + wc * 32 + 8 * fq;
#pragma unroll
        for (int ai = 0; ai < 2; ++ai)
#pragma unroll
            for (int m = 0; m < 4; ++m) { const unsigned row = (unsigned)(row0 + ai * HALF + m * 16);
                const f32x4 s4 = *(const GAS f32x4*)(ssq + row * 4);
                const float rs = __builtin_amdgcn_rsqf(((s4[0] + s4[1]) + (s4[2] + s4[3])) * (1.0f / 128.0f) + RMS_EPS);
#pragma unroll
                for (int bj = 0; bj < 2; ++bj) { const int cin = cin0 + bj * HALF;
                    gbf16* dst = t ? (V + row * 1024 + cin) : (Kp + row * 1536 + (cin >> 6) * 96 + (cin & 63));
                    *(GAS u32x4*)dst = pack8(acc[ai][bj][m][0] * rs, acc[ai][bj][m][1] * rs); }
                asm volatile("" ::: "memory"); }
    }
};
struct EpiMlaQ {
    static constexpr bool PERM = true, AFTER_DRAIN = false;
    unsigned char* ws; float qscale;
    __device__ __forceinline__ void operator()(const f32x4 (&acc)[2][2][4][2], const Unit& u, int wr, int wc, int fr, int fq) const {
        const gf32* ssq = (const gf32*)((gu8*)ws + WS_SSQQ); const gf32* cst = (const gf32*)((gu8*)ws + WS_CS); gbf16* Q = (gbf16*)((gu8*)ws + WS_Q);
        const int row0 = u.pm * BM + wr * 64 + fr;
#pragma unroll
        for (int ai = 0; ai < 2; ++ai)
#pragma unroll
            for (int m = 0; m < 4; ++m) { const unsigned row = (unsigned)(row0 + ai * HALF + m * 16);
                const f32x4 s4 = *(const GAS f32x4*)(ssq + row * 4);
                const float rs = qscale * __builtin_amdgcn_rsqf(((s4[0] + s4[1]) + (s4[2] + s4[3])) * (1.0f / 256.0f) + RMS_EPS);
                if (u.pn < 4) {
#pragma unroll
                    for (int bj = 0; bj < 2; ++bj) { const int cin = u.pn * BM + bj * HALF + wc * 32 + 8 * fq;
                        *(GAS u32x4*)(Q + row * 1536 + (cin >> 6) * 96 + (cin & 63)) = pack8(acc[ai][bj][m][0] * rs, acc[ai][bj][m][1] * rs); }
                } else {
                    const int i0 = 8 * (fq & 1); const float sg = (fq < 2) ? -1.0f : 1.0f;
                    const f32x4 c0 = *(const GAS f32x4*)(cst + row * 32 + i0), c1 = *(const GAS f32x4*)(cst + row * 32 + i0 + 4);
                    const f32x4 n0 = *(const GAS f32x4*)(cst + row * 32 + 16 + i0) * sg, n1 = *(const GAS f32x4*)(cst + row * 32 + 16 + i0 + 4) * sg;
#pragma unroll
                    for (int bj = 0; bj < 2; ++bj) { const int head = ((u.pn - 4) * BM + bj * HALF + wc * 32) >> 5;
                        const f32x4 a0 = acc[ai][bj][m][0] * rs, a1 = acc[ai][bj][m][1] * rs; f32x4 p0, p1;
#pragma unroll
                        for (int j = 0; j < 4; ++j) { p0[j] = __shfl_xor(a0[j], 32); p1[j] = __shfl_xor(a1[j], 32); }
                        *(GAS u32x4*)(Q + row * 1536 + head * 96 + 64 + 8 * fq) = pack8(a0 * c0 + p0 * n0, a1 * c1 + p1 * n1); }
                }
                asm volatile("" ::: "memory");
            }
    }
};
struct EpiMlaDown {
    static constexpr bool PERM = false, AFTER_DRAIN = false;
    unsigned char* ws;
    __device__ __forceinline__ void operator()(const f32x4 (&acc)[2][2][4][2], const Unit& u, int wr, int wc, int fr, int fq) const {
        gbf16* cq = (gbf16*)((gu8*)ws + WS_CQ); gbf16* ckv = (gbf16*)((gu8*)ws + WS_CKV); gf32* ssqq = (gf32*)((gu8*)ws + WS_SSQQ); gf32* ssqkv = (gf32*)((gu8*)ws + WS_SSQKV); const gf32* cst = (const gf32*)((gu8*)ws + WS_CS); gbf16* Kp = (gbf16*)((gu8*)ws + WS_K);
        const int row0 = u.pm * BM + wr * 64 + fr;
#pragma unroll
        for (int ai = 0; ai < 2; ++ai)
#pragma unroll
            for (int m = 0; m < 4; ++m) { const unsigned row = (unsigned)(row0 + ai * HALF + m * 16);
                if (u.pn == 0) {
                    float ss = 0.f;
#pragma unroll
                    for (int bj = 0; bj < 2; ++bj)
#pragma unroll
                        for (int n = 0; n < 2; ++n) { const f32x4 v = acc[ai][bj][m][n]; ss += (v[0] * v[0] + v[1] * v[1]) + (v[2] * v[2] + v[3] * v[3]);
                            *(GAS u32x2*)(cq + row * 256 + bj * HALF + wc * 32 + n * 16 + 4 * fq) = pack4(v); }
                    ss = xor_sum<16>(ss); ss = xor_sum<32>(ss);
                    if (fq == 0) ssqq[row * 4 + wc] = ss;
                } else {
                    float ss = 0.f;
#pragma unroll
                    for (int n = 0; n < 2; ++n) { const f32x4 v = acc[ai][0][m][n]; ss += (v[0] * v[0] + v[1] * v[1]) + (v[2] * v[2] + v[3] * v[3]);
                        *(GAS u32x2*)(ckv + row * 128 + wc * 32 + n * 16 + 4 * fq) = pack4(v); }
                    ss = xor_sum<16>(ss); ss = xor_sum<32>(ss);
                    if (fq == 0) ssqkv[row * 4 + wc] = ss;
                    if (wc == 0) {
                        const f32x4 cs = *(const GAS f32x4*)(cst + row * 32 + 4 * fq), sn = *(const GAS f32x4*)(cst + row * 32 + 16 + 4 * fq);
                        const f32x4 x1 = acc[ai][1][m][0], x2 = acc[ai][1][m][1];
                        const u32x2 o1 = pack4(x1 * cs - x2 * sn), o2 = pack4(x2 * cs + x1 * sn);
                        gbf16* dst = Kp + row * 1536 + 64 + 4 * fq;
#pragma unroll
                        for (int hd = 0; hd < 16; ++hd) { *(GAS u32x2*)(dst + hd * 96) = o1; *(GAS u32x2*)(dst + hd * 96 + 16) = o2; }
                    }
                }
            }
    }
};

template <class Epi, class Sched, bool ALIGN_EPI = false, bool SP2 = false>
__device__ __forceinline__ void gemm_phase(PG8_LAS unsigned char* lds, const Gemm g, const Sched& S, const Epi& E, const int wv_) {
    int tid_; asm volatile("v_mbcnt_lo_u32_b32 %0, -1, 0\n\tv_mbcnt_hi_u32_b32 %0, -1, %0" : "=v"(tid_)); tid_ += wv_ * 64;
    const int tid = tid_, wid = __builtin_amdgcn_readfirstlane(tid >> 6), lane = tid & 63, wr = wid >> 2, wc = wid & 3, fr = lane & 15, fq = lane >> 4;
    const int K = g.K, nt = K / BK;
    unsigned voffA[2], voffB[2];
#pragma unroll
    for (int i = 0; i < 2; ++i) { int R, C; stage_rc(tid * 16 + i * 8192, R, C); const int Rb = Epi::PERM ? ((R & ~31) + perm32(R & 31)) : R;
        voffA[i] = (unsigned)(R * K + C) * 2u; voffB[i] = (unsigned)(Rb * K + C) * 2u; }
    const size_t kstep = (size_t)(BK * 2);
    const size_t hstep = (size_t)HALF * K * 2;
    const size_t tstep = 2 * hstep;
    const unsigned ldsw = (unsigned)wid * 1024u;
    const int aoff = lds_byte(wr * 64 + fr, fq * 8), boff = lds_byte(wc * 32 + fr, fq * 8);
#define PG8_SA(b, h) (((b) * 2 + (h)) * HTB)
#define PG8_SB(b, h) ((4 + (b) * 2 + (h)) * HTB)
#define PG8_STAGE(bufoff, gbase, voff) do { _Pragma("unroll") for (int _i = 0; _i < 2; ++_i) \
        __builtin_amdgcn_global_load_lds((const unsigned*)((const char*)(gbase) + (voff)[_i]), (PG8_LAS unsigned*)(lds + (bufoff) + ldsw + _i * 8192), 16, 0, 0); } while (0)
#define PG8_LDA(dst, b, h) do { _Pragma("unroll") for (int m = 0; m < 4; ++m) _Pragma("unroll") for (int k = 0; k < 2; ++k) dst[m][k] = *(const PG8_LAS bf16x8*)(lds + PG8_SA(b, h) + aoff + m * 2048 + k * 1024); } while (0)
#define PG8_LDB(dst, b, h) do { _Pragma("unroll") for (int n = 0; n < 2; ++n) _Pragma("unroll") for (int k = 0; k < 2; ++k) dst[n][k] = *(const PG8_LAS bf16x8*)(lds + PG8_SB(b, h) + boff + n * 2048 + k * 1024); } while (0)
#define PG8_MMA(ai, bj, At, Bt) do { __builtin_amdgcn_s_setprio(1); _Pragma("unroll") for (int m = 0; m < 4; ++m) _Pragma("unroll") for (int n = 0; n < 2; ++n) _Pragma("unroll") for (int k = 0; k < 2; ++k) \
        acc[ai][bj][m][n] = __builtin_amdgcn_mfma_f32_16x16x32_bf16(Bt[n][k], At[m][k], acc[ai][bj][m][n], 0, 0, 0); __builtin_amdgcn_s_setprio(0); } while (0)
#define PG8_WAIT_V(n) asm volatile("s_waitcnt vmcnt(" #n ")" ::: "memory")
#define PG8_WAIT_L(n) asm volatile("s_waitcnt lgkmcnt(" #n ")" ::: "memory")
#define PG8_BAR __builtin_amdgcn_s_barrier()
#define PG8_SCHED __builtin_amdgcn_sched_barrier(0)
    Unit cur, nxt; int ui = 0;
    if (!S.next(0, cur)) return;
    f32x4 acc[2][2][4][2];
#pragma unroll
    for (int a = 0; a < 2; ++a)
#pragma unroll
        for (int b = 0; b < 2; ++b)
#pragma unroll
            for (int m = 0; m < 4; ++m)
#pragma unroll
                for (int n = 0; n < 2; ++n) acc[a][b][m][n] = (f32x4){0.f, 0.f, 0.f, 0.f};
    bf16x8 At[4][2], B0[2][2], B1[2][2];
    const char* cA = (const char*)g.A + (size_t)cur.pm * tstep; const char* cB = (const char*)g.Bt + (size_t)cur.pn * tstep;
    S.a_ready(cur);
    if constexpr (SP2) {
        PG8_STAGE(PG8_SB(0, 0), cB, voffB); PG8_STAGE(PG8_SB(0, 1), cB + hstep, voffB); PG8_STAGE(PG8_SA(0, 0), cA, voffA); PG8_STAGE(PG8_SA(0, 1), cA + hstep, voffA);
        if (wr == 1) PG8_BAR;
        PG8_WAIT_V(2); PG8_BAR;
        PG8_STAGE(PG8_SB(1, 0), cB + kstep, voffB); PG8_STAGE(PG8_SA(1, 0), cA + kstep, voffA); PG8_STAGE(PG8_SB(1, 1), cB + hstep + kstep, voffB);
        PG8_WAIT_V(6); PG8_BAR;
    } else {
        PG8_STAGE(PG8_SB(0, 0), cB, voffB); PG8_STAGE(PG8_SA(0, 0), cA, voffA); PG8_STAGE(PG8_SB(0, 1), cB + hstep, voffB); PG8_STAGE(PG8_SA(0, 1), cA + hstep, voffA);
        if (wr == 1) PG8_BAR;
        PG8_WAIT_V(4); PG8_BAR;
        PG8_STAGE(PG8_SB(1, 0), cB + kstep, voffB); PG8_STAGE(PG8_SA(1, 0), cA + kstep, voffA); PG8_STAGE(PG8_SB(1, 1), cB + hstep + kstep, voffB);
        PG8_WAIT_V(6); PG8_BAR;
    }
    for (;;) {
        const bool has_next = S.next(ui + 1, nxt);
        const char* nA = has_next ? (const char*)g.A + (size_t)nxt.pm * tstep : cA; const char* nB = has_next ? (const char*)g.Bt + (size_t)nxt.pn * tstep : cB;
        for (int t = 0; t < nt; t += 2) {
            const bool last = (t == nt - 2);
            const char* a1 = cA + (size_t)(t + 1) * kstep;
            const char* a2 = last ? nA : cA + (size_t)(t + 2) * kstep; const char* b2 = last ? nB : cB + (size_t)(t + 2) * kstep;
            const char* a3 = a2 + kstep; const char* b3 = b2 + kstep;
            if (last && has_next) S.a_ready(nxt);
            if constexpr (SP2) {
            PG8_LDB(B0, 0, 0); PG8_LDB(B1, 0, 1); PG8_SCHED; PG8_LDA(At, 0, 0); PG8_STAGE(PG8_SA(1, 1), a1 + hstep, voffA);
            PG8_WAIT_V(8); PG8_WAIT_L(0); PG8_BAR; PG8_MMA(0, 0, At, B0); PG8_MMA(0, 1, At, B1); PG8_BAR; PG8_SCHED;
            PG8_LDA(At, 0, 1); PG8_STAGE(PG8_SB(0, 0), b2, voffB); PG8_STAGE(PG8_SB(0, 1), b2 + hstep, voffB); PG8_STAGE(PG8_SA(0, 0), a2, voffA);
            PG8_WAIT_V(8); PG8_WAIT_L(0); PG8_BAR; PG8_MMA(1, 0, At, B0); PG8_MMA(1, 1, At, B1); PG8_BAR; PG8_SCHED;
            PG8_LDB(B0, 1, 0); PG8_LDB(B1, 1, 1); PG8_SCHED; PG8_LDA(At, 1, 0); PG8_STAGE(PG8_SA(0, 1), a2 + hstep, voffA);
            PG8_WAIT_V(8); PG8_WAIT_L(0); PG8_BAR; PG8_MMA(0, 0, At, B0); PG8_MMA(0, 1, At, B1); PG8_BAR; PG8_SCHED;
            PG8_LDA(At, 1, 1); PG8_STAGE(PG8_SB(1, 0), b3, voffB); PG8_STAGE(PG8_SB(1, 1), b3 + hstep, voffB); PG8_STAGE(PG8_SA(1, 0), a3, voffA);
            PG8_WAIT_V(8); PG8_WAIT_L(0); PG8_BAR; PG8_MMA(1, 0, At, B0); PG8_MMA(1, 1, At, B1); PG8_BAR; PG8_SCHED;
            } else {
            PG8_LDB(B0, 0, 0); PG8_SCHED; PG8_LDA(At, 0, 0); PG8_STAGE(PG8_SA(1, 1), a1 + hstep, voffA);
            PG8_WAIT_L(8); PG8_BAR; PG8_WAIT_L(0); PG8_MMA(0, 0, At, B0); PG8_BAR; PG8_SCHED;
            PG8_LDB(B1, 0, 1); PG8_STAGE(PG8_SB(0, 0), b2, voffB);
            PG8_BAR; PG8_WAIT_L(0); PG8_MMA(0, 1, At, B1); PG8_BAR;
            PG8_LDA(At, 0, 1); PG8_STAGE(PG8_SA(0, 0), a2, voffA);
            PG8_BAR; PG8_WAIT_L(0); PG8_MMA(1, 0, At, B0); PG8_BAR; PG8_SCHED;
            PG8_STAGE(PG8_SB(0, 1), b2 + hstep, voffB);
            PG8_WAIT_V(6); PG8_BAR; PG8_MMA(1, 1, At, B1); PG8_BAR;
            PG8_LDB(B0, 1, 0); PG8_SCHED; PG8_LDA(At, 1, 0); PG8_STAGE(PG8_SA(0, 1), a2 + hstep, voffA);
            PG8_WAIT_L(8); PG8_BAR; PG8_WAIT_L(0); PG8_MMA(0, 0, At, B0); PG8_BAR; PG8_SCHED;
            PG8_LDB(B1, 1, 1); PG8_STAGE(PG8_SB(1, 0), b3, voffB);
            PG8_BAR; PG8_WAIT_L(0); PG8_MMA(0, 1, At, B1); PG8_BAR;
            PG8_LDA(At, 1, 1); PG8_STAGE(PG8_SA(1, 0), a3, voffA);
            PG8_BAR; PG8_WAIT_L(0); PG8_MMA(1, 0, At, B0); PG8_BAR; PG8_SCHED;
            PG8_STAGE(PG8_SB(1, 1), b3 + hstep, voffB);
            PG8_WAIT_V(6); PG8_BAR; PG8_MMA(1, 1, At, B1); PG8_BAR;
            }
        }
        if constexpr (ALIGN_EPI) { if (wr == 0) PG8_BAR; }
        if constexpr (!Epi::AFTER_DRAIN) { E(acc, cur, wr, wc, fr, fq); S.done(cur); }
        if (!has_next) break;
#pragma unroll
        for (int a = 0; a < 2; ++a)
#pragma unroll
            for (int b = 0; b < 2; ++b)
#pragma unroll
                for (int m = 0; m < 4; ++m)
#pragma unroll
                    for (int n = 0; n < 2; ++n) acc[a][b][m][n] = (f32x4){0.f, 0.f, 0.f, 0.f};
        cur = nxt; cA = nA; cB = nB; ++ui;
        if constexpr (ALIGN_EPI) { if (wr == 1) PG8_BAR; }
    }
    PG8_WAIT_V(0);
    if constexpr (!ALIGN_EPI) { if (wr == 0) PG8_BAR; }
    PG8_BAR;
    if constexpr (Epi::AFTER_DRAIN) { E.fused(acc, cur, wr, wc, fr, fq, lds, wid, lane); S.done(cur); }
#undef PG8_SA
#undef PG8_SB
#undef PG8_STAGE
#undef PG8_LDA
#undef PG8_LDB
#undef PG8_MMA
#undef PG8_WAIT_V
#undef PG8_WAIT_L
#undef PG8_BAR
#undef PG8_SCHED
}
}

__device__ __forceinline__ int olane() { int l; asm volatile("v_mbcnt_lo_u32_b32 %0, -1, 0\n\tv_mbcnt_hi_u32_b32 %0, -1, %0" : "=v"(l)); return l; }
__device__ __forceinline__ int otid(int wv) { return wv * 64 + olane(); }
__device__ __forceinline__ int obid() { int b = blockIdx.x; asm volatile("" : "+s"(b)); return b; }
__device__ __forceinline__ int ogrid() { int g = gridDim.x; asm volatile("" : "+s"(g)); return g; }
__device__ __forceinline__ unsigned f2bf(float f) { unsigned u = __builtin_bit_cast(unsigned, f); return (u + 0x7fffu + ((u >> 16) & 1u)) >> 16; }
__device__ __forceinline__ unsigned pk2(float lo, float hi) { return f2bf(lo) | (f2bf(hi) << 16); }
__device__ __forceinline__ float bf2f(unsigned b) { return __builtin_bit_cast(float, b << 16); }

__device__ __forceinline__ void transpose_item(const float* W, int ld, int K, int N, bf16* WT, int map, int drow0, const float* gk, LAS float* scr, int item, int lane) {
    const int nblk = N / 32, kb = item / nblk, nb = item % nblk, k0 = 64 * kb, n0 = 32 * nb;
    int drow;
    if (map == 1) { const int hd = n0 / 96, d = n0 % 96; drow = (d < 64) ? hd * 64 + d : 1024 + hd * 32 + (d - 64); }
    else if (map == 2) { const int hd = n0 / 128, d = n0 % 128; drow = (d < 64) ? hd * 64 + d : 1024 + hd * 64 + (d - 64); }
    else drow = drow0 + n0;
    { const int kr = lane >> 3, c4 = lane & 7; f32x4 t[8];
#pragma unroll
      for (int i = 0; i < 8; ++i) t[i] = *(const f32x4*)(W + (size_t)(k0 + 8 * i + kr) * ld + n0 + 4 * c4);
#pragma unroll
      for (int i = 0; i < 8; ++i) { const int kk = 8 * i + kr; f32x4 v = t[i]; if (gk) v = v * gk[k0 + kk];
          LAS float* d = scr + kk * 33 + 4 * c4; d[0] = v[0]; d[1] = v[1]; d[2] = v[2]; d[3] = v[3]; } }
    asm volatile("s_waitcnt lgkmcnt(0)" ::: "memory");
    const int c = lane & 7;
#pragma unroll
    for (int j = 0; j < 4; ++j) { const int n = (lane >> 3) + 8 * j; const LAS float* s = scr + (8 * c) * 33 + n;
        u32x4 o; o.x = pk2(s[0 * 33], s[1 * 33]); o.y = pk2(s[2 * 33], s[3 * 33]); o.z = pk2(s[4 * 33], s[5 * 33]); o.w = pk2(s[6 * 33], s[7 * 33]);
        *(u32x4*)(WT + (size_t)(drow + n) * K + k0 + 8 * c) = o; }
    asm volatile("s_waitcnt lgkmcnt(0)" ::: "memory");
}

struct Params { const float* in[20]; float* out; unsigned char* ws; };
enum { I_X = 0, I_C, I_POS, I_ADAW, I_ADAB, I_GMIX, I_GMLP, I_FWIN, I_FBF, I_FWOUT, I_MDQ, I_MQG, I_MUQ, I_MDKV, I_MKVG, I_MUKV, I_MOUT, I_W1, I_W2, I_GFIN };

__device__ __forceinline__ void prologue(const Params& p, LAS unsigned char* lds, const int wv_) {
    const int BID = obid(), GSZ = ogrid(); const int tid_ = otid(wv_);
    const int tid = tid_, lane = tid & 63, wave = __builtin_amdgcn_readfirstlane(tid >> 6);
    unsigned char* ws = p.ws;
    {
        LAS float* cact = (LAS float*)lds;
        LAS float* part = (LAS float*)(lds + 65536);
        const float* c = p.in[I_C];
        for (int idx = tid; idx < NB * DM; idx += NTHR) { const int b = idx >> 10, k = idx & 1023; const float v = c[idx]; cact[k * 16 + b] = v / (1.0f + __expf(-v)); }
        __syncthreads();
        float* mod = (float*)(ws + WS_MOD);
        for (int item = BID; item < 4 * 48; item += GSZ) {
            const int l = item / 48, n0 = (item % 48) * 128, col = tid & 127, ks = tid >> 7;
            float acc[16];
#pragma unroll
            for (int b = 0; b < 16; ++b) acc[b] = 0.f;
            const float* wp = p.in[I_ADAW] + ((size_t)l * DM + ks * 256) * 6144 + n0 + col;
            const LAS f32x4* cp = (const LAS f32x4*)(cact + ks * 256 * 16);
#pragma unroll 8
            for (int k = 0; k < 256; ++k) { const float w = wp[(size_t)k * 6144];
                const f32x4 c0 = cp[k * 4 + 0], c1 = cp[k * 4 + 1], c2 = cp[k * 4 + 2], c3 = cp[k * 4 + 3];
                acc[0] += w * c0[0]; acc[1] += w * c0[1]; acc[2] += w * c0[2]; acc[3] += w * c0[3];
                acc[4] += w * c1[0]; acc[5] += w * c1[1]; acc[6] += w * c1[2]; acc[7] += w * c1[3];
                acc[8] += w * c2[0]; acc[9] += w * c2[1]; acc[10] += w * c2[2]; acc[11] += w * c2[3];
                acc[12] += w * c3[0]; acc[13] += w * c3[1]; acc[14] += w * c3[2]; acc[15] += w * c3[3]; }
#pragma unroll
            for (int b = 0; b < 16; ++b) part[(ks * 16 + b) * 128 + col] = acc[b];
            __syncthreads();
            for (int o = tid; o < 2048; o += NTHR) { const int b = o >> 7, cc = o & 127;
                const float s = (part[(0 * 16 + b) * 128 + cc] + part[(1 * 16 + b) * 128 + cc]) + (part[(2 * 16 + b) * 128 + cc] + part[(3 * 16 + b) * 128 + cc]);
                mod[((size_t)l * 16 + b) * 6144 + n0 + cc] = s + p.in[I_ADAB][(size_t)l * 6144 + n0 + cc]; }
            __syncthreads();
        }
    }
    __syncthreads();
    {
        const int* pos = (const int*)p.in[I_POS]; float* cst = (float*)(ws + WS_CS);
        for (size_t idx = (size_t)BID * NTHR + tid; idx < (size_t)M * 16; idx += (size_t)GSZ * NTHR) {
            const int tok = (int)(idx >> 4), i = (int)(idx & 15);
            const float invf = exp2f(-(float)i * (13.287712379549449f / 16.0f));
            const float ang = (float)pos[tok] * invf;
            double rev = (double)ang * 0.15915494309189535; rev -= __builtin_rint(rev);
            const float rf = (float)rev;
            cst[(size_t)tok * 32 + i] = __builtin_amdgcn_cosf(rf); cst[(size_t)tok * 32 + 16 + i] = __builtin_amdgcn_sinf(rf);
        }
    }
    for (int j = 0; j < 2; ++j) { u32x4* z = (u32x4*)(ws + WS_W + W_MLA + j * W_MLA_STRIDE + (size_t)416 * 1024 * 2);
        for (int idx = BID * NTHR + tid; idx < 96 * 1024 * 2 / 16; idx += GSZ * NTHR) z[idx] = (u32x4){0u, 0u, 0u, 0u}; }
    {
        LAS float* scr = (LAS float*)(lds + wave * 16384);
        const int gw = BID * NWAVE + wave, NGW = GSZ * NWAVE;
        constexpr int N_MLP = 4 * 4096, N_FOX = 2 * 2048, N_MLA = 2 * 1040;
        for (int it = gw; it < N_MLP + N_FOX + N_MLA; it += NGW) {
            int r = it;
            if (r < N_MLP) { const int l = r >> 12, rr = r & 4095; bf16* wb = (bf16*)(ws + WS_W + W_MLP + (size_t)l * W_MLP_STRIDE);
                if (rr < 2048) transpose_item(p.in[I_W1] + (size_t)l * DM * FF, FF, DM, FF, wb, 0, 0, nullptr, scr, rr, lane);
                else transpose_item(p.in[I_W2] + (size_t)l * DM * FF, DM, FF, DM, wb + (size_t)FF * DM, 0, 0, nullptr, scr, rr - 2048, lane);
                continue; }
            r -= N_MLP;
            if (r < N_FOX) { const int j = r >> 11, rr = r & 2047; bf16* wb = (bf16*)(ws + WS_W + W_FOX + (size_t)j * W_FOX_STRIDE);
                if (rr < 1536) transpose_item(p.in[I_FWIN] + (size_t)j * DM * 3088, 3088, DM, 3072, wb, 0, 0, nullptr, scr, rr, lane);
                else transpose_item(p.in[I_FWOUT] + (size_t)j * DM * DM, DM, DM, DM, wb + (size_t)3072 * DM, 0, 0, nullptr, scr, rr - 1536, lane);
                continue; }
            r -= N_FOX;
            { const int j = r / 1040, rr = r % 1040; bf16* wb = (bf16*)(ws + WS_W + W_MLA + (size_t)j * W_MLA_STRIDE);
                if (rr < 128) transpose_item(p.in[I_MDQ] + (size_t)j * DM * 256, 256, DM, 256, wb, 0, 0, nullptr, scr, rr, lane);
                else if (rr < 208) transpose_item(p.in[I_MDKV] + (size_t)j * DM * 160, 160, DM, 160, wb, 0, 256, nullptr, scr, rr - 128, lane);
                else if (rr < 400) transpose_item(p.in[I_MUQ] + (size_t)j * 256 * 1536, 1536, 256, 1536, wb + (size_t)512 * 1024, 1, 0, p.in[I_MQG] + j * 256, scr, rr - 208, lane);
                else if (rr < 528) transpose_item(p.in[I_MUKV] + (size_t)j * 128 * 2048, 2048, 128, 2048, wb + (size_t)512 * 1024 + (size_t)1536 * 256, 2, 0, p.in[I_MKVG] + j * 128, scr, rr - 400, lane);
                else transpose_item(p.in[I_MOUT] + (size_t)j * DM * DM, DM, DM, DM, (bf16*)((unsigned char*)wb + 3 * MiB), 0, 0, nullptr, scr, rr - 528, lane);
            }
        }
    }
}

template <int NR, bool gates>
__device__ __forceinline__ void norm_phase(const float* x, const float* g, const float* sh0, const float* sc0, bf16* hout, const float* wfsrc, const float* bfv, float* lf, LAS unsigned char* lds, const int wv_) {
    const int BID = obid(), GSZ = ogrid(); const int tid_ = otid(wv_);
    const int tid = tid_, lane = tid & 63, wave = __builtin_amdgcn_readfirstlane(tid >> 6);
    LAS float* wfs = (LAS float*)lds;
    if constexpr (gates) {
        for (int idx = tid; idx < 16 * 1024; idx += NTHR) { const int k = idx >> 4, j = idx & 15; wfs[j * 1024 + k] = wfsrc[(size_t)k * 3088 + 3072 + j]; }
        __syncthreads();
    }
    const int gw = BID * NWAVE + wave, NGW = GSZ * NWAVE;
    for (int row0 = gw * NR; row0 < M; row0 += NGW * NR) {
        const int b = row0 >> 11;
        f32x4 v[NR][4]; float ss[NR];
#pragma unroll
        for (int r = 0; r < NR; ++r) { const f32x4* xr = (const f32x4*)(x + (size_t)(row0 + r) * DM) + lane;
#pragma unroll
            for (int j = 0; j < 4; ++j) v[r][j] = xr[64 * j]; }
#pragma unroll
        for (int r = 0; r < NR; ++r) { float s = 0.f;
#pragma unroll
            for (int j = 0; j < 4; ++j) s += (v[r][j][0] * v[r][j][0] + v[r][j][1] * v[r][j][1]) + (v[r][j][2] * v[r][j][2] + v[r][j][3] * v[r][j][3]);
            ss[r] = s; }
#pragma unroll
        for (int r = 0; r < NR; ++r) ss[r] = wave_sum(ss[r]);
        const f32x4* gp = (const f32x4*)g + lane; const f32x4* shp = (const f32x4*)(sh0 + (size_t)b * 6144) + lane; const f32x4* scp = (const f32x4*)(sc0 + (size_t)b * 6144) + lane;
#pragma unroll
        for (int j = 0; j < 4; ++j) { const f32x4 aa = gp[64 * j] * (scp[64 * j] + 1.0f), sh = shp[64 * j];
#pragma unroll
            for (int r = 0; r < NR; ++r) { const float rstd = __builtin_amdgcn_rsqf(ss[r] * (1.0f / DM) + EPS);
                v[r][j] = (v[r][j] * rstd) * aa + sh;
                u32x2 w; w.x = pk2(v[r][j][0], v[r][j][1]); w.y = pk2(v[r][j][2], v[r][j][3]); ((u32x2*)(hout + (size_t)(row0 + r) * DM) + lane)[64 * j] = w; } }
        if constexpr (gates) {
            static_assert(NR == 2, "the gate path pairs two rows in f32x2");
            f32x2 vv[4][4], z[16];
#pragma unroll
            for (int jj = 0; jj < 4; ++jj)
#pragma unroll
                for (int e = 0; e < 4; ++e) vv[jj][e] = (f32x2){v[0][jj][e], v[1][jj][e]};
#pragma unroll
            for (int jg = 0; jg < 16; ++jg) {
                f32x2 acc = (f32x2){0.f, 0.f};
#pragma unroll
                for (int jj = 0; jj < 4; ++jj) { const f32x4 w = *(const LAS f32x4*)(wfs + jg * 1024 + 256 * jj + 4 * lane);
                    acc += (vv[jj][0] * w[0] + vv[jj][1] * w[1]) + (vv[jj][2] * w[2] + vv[jj][3] * w[3]); }
                z[jg] = acc;
                if (jg & 1) asm volatile("" ::: "memory"); }
            const bool b5 = (lane & 32) != 0, b4 = (lane & 16) != 0, b3 = (lane & 8) != 0, b2 = (lane & 4) != 0;
            f32x2 a8[8], a4[4], a2[2], a1;
#pragma unroll
            for (int i = 0; i < 8; ++i) { const f32x2 send = b5 ? z[i] : z[i + 8], keep = b5 ? z[i + 8] : z[i]; a8[i] = keep + (f32x2){xor_get<32>(send[0], b5), xor_get<32>(send[1], b5)}; }
#pragma unroll
            for (int i = 0; i < 4; ++i) { const f32x2 send = b4 ? a8[i] : a8[i + 4], keep = b4 ? a8[i + 4] : a8[i]; a4[i] = keep + (f32x2){xor_get<16>(send[0], b4), xor_get<16>(send[1], b4)}; }
#pragma unroll
            for (int i = 0; i < 2; ++i) { const f32x2 send = b3 ? a4[i] : a4[i + 2], keep = b3 ? a4[i + 2] : a4[i]; a2[i] = keep + (f32x2){xor_get<8>(send[0], b3), xor_get<8>(send[1], b3)}; }
            { const f32x2 send = b2 ? a2[0] : a2[1], keep = b2 ? a2[1] : a2[0]; a1 = keep + (f32x2){xor_get<4>(send[0], b2), xor_get<4>(send[1], b2)}; }
            a1 = (f32x2){xor_sum<2>(a1[0]), xor_sum<2>(a1[1])}; a1 = (f32x2){xor_sum<1>(a1[0]), xor_sum<1>(a1[1])};
            const int gate = (b5 ? 8 : 0) + (b4 ? 4 : 0) + (b3 ? 2 : 0) + (b2 ? 1 : 0);
            if ((lane & 3) == 0) { const float bb = bfv[gate];
#pragma unroll
                for (int r = 0; r < NR; ++r) { const float zz = a1[r] + bb; lf[(size_t)(row0 + r) * 16 + gate] = fminf(zz, 0.f) - __logf(1.0f + __expf(-fabsf(zz))); } }
        }
    }
}

__device__ __forceinline__ void final_norm(float* x, const float* g, const int wv_) {
    constexpr int NR = 4;
    const int BID = obid(), GSZ = ogrid(); const int tid_ = otid(wv_);
    const int tid = tid_, lane = tid & 63, wave = __builtin_amdgcn_readfirstlane(tid >> 6);
    const int gw = BID * NWAVE + wave, NGW = GSZ * NWAVE;
    for (int row0 = gw * NR; row0 < M; row0 += NGW * NR) {
        f32x4 v[NR][4]; float ss[NR];
#pragma unroll
        for (int r = 0; r < NR; ++r) { const f32x4* xr = (const f32x4*)(x + (size_t)(row0 + r) * DM) + lane;
#pragma unroll
            for (int j = 0; j < 4; ++j) v[r][j] = xr[64 * j]; }
#pragma unroll
        for (int r = 0; r < NR; ++r) { float s = 0.f;
#pragma unroll
            for (int j = 0; j < 4; ++j) s += (v[r][j][0] * v[r][j][0] + v[r][j][1] * v[r][j][1]) + (v[r][j][2] * v[r][j][2] + v[r][j][3] * v[r][j][3]);
            ss[r] = wave_sum(s); }
        const f32x4* gp = (const f32x4*)g + lane;
#pragma unroll
        for (int j = 0; j < 4; ++j) { const f32x4 gg = gp[64 * j];
#pragma unroll
            for (int r = 0; r < NR; ++r) { const float rstd = __builtin_amdgcn_rsqf(ss[r] * (1.0f / DM) + EPS); ((f32x4*)(x + (size_t)(row0 + r) * DM) + lane)[64 * j] = (v[r][j] * rstd) * gg; } }
    }
}

__device__ __forceinline__ void fox_cumsum(const float* lf, bf16* Qb, bf16* Kb, LAS unsigned char* lds, const int wv_) {
    const int BID = obid(), GSZ = ogrid(); const int tid_ = otid(wv_);
    const int tid = tid_, lane = tid & 63, wave = __builtin_amdgcn_readfirstlane(tid >> 6);
    LAS float* wtot = (LAS float*)lds;
    for (int bh = BID; bh < NB * NH; bh += GSZ) {
        const int b = bh >> 4, h = bh & 15; const int s0 = 4 * tid;
        float a[4];
#pragma unroll
        for (int i = 0; i < 4; ++i) a[i] = lf[((size_t)(b * SEQ + s0 + i)) * 16 + h];
        a[1] += a[0]; a[2] += a[1]; a[3] += a[2];
        float xs = a[3];
#pragma unroll
        for (int off = 1; off < 64; off <<= 1) { const float t = __shfl_up(xs, off); if (lane >= off) xs += t; }
        if (lane == 63) wtot[wave] = xs;
        __syncthreads();
        float base = 0.f;
#pragma unroll
        for (int w = 0; w < NWAVE; ++w) { const float t = wtot[w]; if (w < wave) base += t; }
        const float excl = xs - a[3] + base;
#pragma unroll
        for (int i = 0; i < 4; ++i) {
            const float F = (a[i] + excl) * LOG2E;
            const unsigned fh = f2bf(F); const float r1 = F - bf2f(fh); const unsigned fm = f2bf(r1); const float r2 = r1 - bf2f(fm); const unsigned fl = f2bf(r2);
            const size_t tok = (size_t)(b * SEQ + s0 + i);
            u32x4* qd = (u32x4*)(Qb + tok * 1280 + h * 80 + 64); u32x4* kd = (u32x4*)(Kb + tok * 1280 + h * 80 + 64);
            unsigned zz = 0u; asm volatile("" : "+v"(zz));
            qd[0] = (u32x4){0x3F803F80u, 0x3F80u | (fh << 16), fm | (fl << 16), zz}; qd[1] = (u32x4){zz, zz, zz, zz};
            kd[0] = (u32x4){(fh ^ 0x8000u) | ((fm ^ 0x8000u) << 16), (fl ^ 0x8000u) | (0x3F80u << 16), 0x3F803F80u, zz}; kd[1] = (u32x4){zz, zz, zz, zz};
        }
        __syncthreads();
    }
}

constexpr int PTR_OFF = 131072;
__device__ __forceinline__ int crow(int r, int hi) { return (r & 3) + 8 * (r >> 2) + 4 * hi; }
__device__ __forceinline__ unsigned cvtpk(float lo, float hi) { typedef __bf16 bf16x2_t __attribute__((ext_vector_type(2))); f32x2 v = {lo, hi}; bf16x2_t b = __builtin_convertvector(v, bf16x2_t); return __builtin_bit_cast(unsigned, b); }
typedef short v4i16_t __attribute__((ext_vector_type(4)));
__device__ __forceinline__ s16x4 vtr(const LAS unsigned char* p) { return __builtin_bit_cast(s16x4, __builtin_amdgcn_ds_read_tr16_b64_v4i16((LAS v4i16_t*)p)); }
#define MFMA32(a, b, c) __builtin_amdgcn_mfma_f32_32x32x16_bf16((a), (b), (c), 0, 0, 0)

template <int NKS>
__device__ __forceinline__ void attn_phase(LAS unsigned char* lds, const bf16* Q_, const bf16* K_, const bf16* V_, bf16* O_, const int wv_) {
    constexpr int QKD = 16 * NKS, QP = 16 * QKD, RS = QKD * 2 + 16, KCH = QKD / 8, NKC = 64 * KCH;
    constexpr int KB_BYTES = 64 * RS, L_K = 0, L_V = 2 * KB_BYTES, L_WS = L_V + 2 * 8192, L_ST = L_WS + NWAVE * 128;
    constexpr float THR = 20.0f;
    static_assert(L_ST + NWAVE * 4096 <= PTR_OFF, "attention LDS");
    typedef __attribute__((address_space(1))) const bf16 gcb; typedef __attribute__((address_space(1))) bf16 gb;
    gcb* Q = (gcb*)Q_; gcb* K = (gcb*)K_; gcb* V = (gcb*)V_; gb* O = (gb*)O_;
    const int BID = obid(), GSZ = ogrid(); const int tid_ = otid(wv_);
    const int tid = tid_, lane = tid & 63, r32 = lane & 31, hi = lane >> 5; const int wid = __builtin_amdgcn_readfirstlane(tid >> 6);
    LAS float* wsf = (LAS float*)(lds + L_WS) + wid * 32;
    LAS bf16* stg = (LAS bf16*)(lds + L_ST) + wid * 2048;
    constexpr int KCP = KCH + 1, NCHK = 64 * KCP; static_assert(NCHK % 64 == 0 && NCHK <= 1024, "K image is a whole number of 1 KiB pieces");
    const bool has1 = (wid + 8) * 64 < NCHK;
    const int ca = wid * 64 + lane, cb = has1 ? ca + 512 : ca;
    const unsigned kgo0 = (unsigned)((ca / KCP) * QP + ((ca % KCP) < KCH ? (ca % KCP) : 0) * 8), kgo1 = (unsigned)((cb / KCP) * QP + ((cb % KCP) < KCH ? (cb % KCP) : 0) * 8);
    const int vr = ca >> 3, vp = ca & 7; const unsigned vgo = (unsigned)(vr * DM + ((((vp >> 2) ^ ((vr >> 1) & 1)) << 2) | (vp & 3)) * 8);
    const int kd0 = wid * 1024, kd1 = (wid + 8) * 1024, vd = wid * 1024;
    const int kfb = r32 * RS + hi * 16;
    const int i16 = lane & 15, qq = i16 >> 2, pp = i16 & 3, blk = (lane >> 4) & 1, swz = (qq >> 1) & 1;
    const int vfb0 = (4 * hi + qq) * 128 + 32 * blk + 8 * pp + swz * 64, vfb1 = (4 * hi + qq) * 128 + 32 * blk + 8 * pp + (swz ^ 1) * 64;
#define A_GLDS(GP, LOFF) do { unsigned keep_; const unsigned ldst_ = (unsigned)__builtin_amdgcn_readfirstlane((int)(unsigned)(size_t)(lds + (LOFF))); \
        asm volatile("s_mov_b32 %0, m0\n\ts_mov_b32 m0, %2\n\ts_nop 0\n\tglobal_load_lds_dwordx4 %1, off\n\ts_mov_b32 m0, %0" : "=&s"(keep_) : "v"(GP), "s"(ldst_) : "memory"); } while (0)
#define A_DMAK(t, buf) do { gcb* Kt_ = Kh + (size_t)((unsigned)(t) * 64u) * QP; asm volatile("" : "+s"(Kt_)); A_GLDS(Kt_ + kgo0, L_K + (buf) * KB_BYTES + kd0); \
        if (has1) A_GLDS(Kt_ + kgo1, L_K + (buf) * KB_BYTES + kd1); } while (0)
#define A_DMAV(t, buf) do { gcb* Vt_ = Vh + (size_t)((unsigned)(t) * 64u) * DM; asm volatile("" : "+s"(Vt_)); A_GLDS(Vt_ + vgo, L_V + (buf) * 8192 + vd); } while (0)
#define A_DMAWAIT() asm volatile("s_waitcnt vmcnt(0)" ::: "memory")
#define A_QK(P0, P1, buf, CINIT) do { const LAS unsigned char* Kl_ = lds + L_K + (buf) * KB_BYTES + kfb; \
        bf16x8 a0_ = *(const LAS bf16x8*)(Kl_), a1_ = *(const LAS bf16x8*)(Kl_ + 32 * RS); \
        _Pragma("unroll") for (int ks = 0; ks < NKS; ++ks) { bf16x8 n0_ = a0_, n1_ = a1_; \
            if (ks + 1 < NKS) { n0_ = *(const LAS bf16x8*)(Kl_ + (ks + 1) * 32); n1_ = *(const LAS bf16x8*)(Kl_ + 32 * RS + (ks + 1) * 32); } \
            if (ks == 0) { P0 = MFMA32(a0_, qr[0], CINIT); P1 = MFMA32(a1_, qr[0], CINIT); } else { P0 = MFMA32(a0_, qr[ks], P0); P1 = MFMA32(a1_, qr[ks], P1); } \
            a0_ = n0_; a1_ = n1_; } } while (0)
#define A_VRD(kk, L0, H0, L1, H1) do { L0 = vtr(Vl_ + vfb0 + (kk) * 2048); H0 = vtr(Vl_ + vfb0 + (kk) * 2048 + 1024); L1 = vtr(Vl_ + vfb1 + (kk) * 2048); H1 = vtr(Vl_ + vfb1 + (kk) * 2048 + 1024); } while (0)
#define A_PV(buf) do { const LAS unsigned char* Vl_ = lds + L_V + (buf) * 8192; s16x4 l0_, h0_, l1_, h1_; A_VRD(0, l0_, h0_, l1_, h1_); \
        _Pragma("unroll") for (int kk = 0; kk < 4; ++kk) { s16x4 nl0_ = l0_, nh0_ = h0_, nl1_ = l1_, nh1_ = h1_; \
            if (kk + 1 < 4) A_VRD(kk + 1, nl0_, nh0_, nl1_, nh1_); \
            const bf16x8 b0_ = (bf16x8){l0_[0], l0_[1], l0_[2], l0_[3], h0_[0], h0_[1], h0_[2], h0_[3]}, b1_ = (bf16x8){l1_[0], l1_[1], l1_[2], l1_[3], h1_[0], h1_[1], h1_[2], h1_[3]}; \
            o0 = MFMA32(PAp[kk], b0_, o0); o1 = MFMA32(PAp[kk], b1_, o1); \
            l0_ = nl0_; h0_ = nh0_; l1_ = nl1_; h1_ = nh1_; } } while (0)
#define A_MASK(t) do { const int kb0_ = 64 * (t) + 4 * hi; \
        _Pragma("unroll") for (int i = 0; i < 16; ++i) { const int kv_ = kb0_ + (i & 3) + 8 * (i >> 2); if (kv_ > qabs) pc0[i] = -INFINITY; if (kv_ + 32 > qabs) pc1[i] = -INFINITY; } } while (0)
#define A_ROWMAX(RM) do { float a_ = __builtin_fmaxf(__builtin_fmaxf(pc0[0], pc0[1]), pc1[0]), b_ = __builtin_fmaxf(__builtin_fmaxf(pc0[2], pc0[3]), pc1[1]); a_ = __builtin_fmaxf(__builtin_fmaxf(a_, pc1[2]), pc1[3]); \
        _Pragma("unroll") for (int r = 4; r < 16; r += 4) { a_ = __builtin_fmaxf(__builtin_fmaxf(a_, pc0[r]), pc0[r + 1]); b_ = __builtin_fmaxf(__builtin_fmaxf(b_, pc0[r + 2]), pc0[r + 3]); \
            a_ = __builtin_fmaxf(__builtin_fmaxf(a_, pc1[r]), pc1[r + 1]); b_ = __builtin_fmaxf(__builtin_fmaxf(b_, pc1[r + 2]), pc1[r + 3]); } \
        RM = __builtin_fmaxf(a_, b_); { auto rr_ = __builtin_amdgcn_permlane32_swap(__float_as_uint(RM), __float_as_uint(RM), false, false); RM = __builtin_fmaxf(__uint_as_float(rr_[0]), __uint_as_float(rr_[1])); } } while (0)
#define A_EXPPACK() do { float ls_ = 0.f; \
        _Pragma("unroll") for (int i = 0; i < 16; ++i) { pc0[i] = __builtin_amdgcn_exp2f(pc0[i]); pc1[i] = __builtin_amdgcn_exp2f(pc1[i]); ls_ += pc0[i] + pc1[i]; } \
        lrow += ls_; u32x4 w_; \
        w_ = (u32x4){cvtpk(pc0[0], pc0[1]), cvtpk(pc0[2], pc0[3]), cvtpk(pc0[4], pc0[5]), cvtpk(pc0[6], pc0[7])}; PAc[0] = __builtin_bit_cast(bf16x8, w_); \
        w_ = (u32x4){cvtpk(pc0[8], pc0[9]), cvtpk(pc0[10], pc0[11]), cvtpk(pc0[12], pc0[13]), cvtpk(pc0[14], pc0[15])}; PAc[1] = __builtin_bit_cast(bf16x8, w_); \
        w_ = (u32x4){cvtpk(pc1[0], pc1[1]), cvtpk(pc1[2], pc1[3]), cvtpk(pc1[4], pc1[5]), cvtpk(pc1[6], pc1[7])}; PAc[2] = __builtin_bit_cast(bf16x8, w_); \
        w_ = (u32x4){cvtpk(pc1[8], pc1[9]), cvtpk(pc1[10], pc1[11]), cvtpk(pc1[12], pc1[13]), cvtpk(pc1[14], pc1[15])}; PAc[3] = __builtin_bit_cast(bf16x8, w_); } while (0)
#define A_VALU(t, BAND) do { if (BAND) A_MASK(t); float rm_; A_ROWMAX(rm_); rm_ -= mrow; upd = __any(rm_ > THR); \
        if (upd) { const float dl_ = __builtin_fmaxf(rm_, 0.f); mrow += dl_; \
            fsc = __builtin_amdgcn_exp2f(-dl_); lrow *= fsc; } \
        _Pragma("unroll") for (int i = 0; i < 16; ++i) { pc0[i] -= mrow; pc1[i] -= mrow; } \
        A_EXPPACK(); } while (0)
#define A_KRD(ks) do { kf_[2 * (ks)] = *(const LAS bf16x8*)(Kl_ + (ks) * 32); kf_[2 * (ks) + 1] = *(const LAS bf16x8*)(Kl_ + 32 * RS + (ks) * 32); } while (0)
#define A_MFMA(t, DOQK, DOPV) do { const LAS unsigned char* Kl_ = lds + L_K + (((t) + 1) & 1) * KB_BYTES + kfb; const LAS unsigned char* Vl_ = lds + L_V + (((t) - 1) & 1) * 8192; \
        s16x4 vl0_[4], vh0_[4], vl1_[4], vh1_[4]; \
        if (DOQK) { bf16x8 kf_[2 * NKS]; \
            A_KRD(0); A_KRD(1); \
            __builtin_amdgcn_sched_barrier(0); \
            _Pragma("unroll") for (int ks = 0; ks < NKS; ++ks) { \
                if (ks == 0) { pn0 = MFMA32(kf_[0], qr[0], ((f32x16)(0.0f))); pn1 = MFMA32(kf_[1], qr[0], ((f32x16)(0.0f))); } \
                else { pn0 = MFMA32(kf_[2 * ks], qr[ks], pn0); pn1 = MFMA32(kf_[2 * ks + 1], qr[ks], pn1); } \
                if (ks + 2 < NKS) A_KRD(ks + 2); \
                if (ks >= NKS - 2) A_VRD(ks - (NKS - 2), vl0_[ks - (NKS - 2)], vh0_[ks - (NKS - 2)], vl1_[ks - (NKS - 2)], vh1_[ks - (NKS - 2)]); \
                __builtin_amdgcn_sched_barrier(0); } } \
        else if (DOPV) { A_VRD(0, vl0_[0], vh0_[0], vl1_[0], vh1_[0]); A_VRD(1, vl0_[1], vh0_[1], vl1_[1], vh1_[1]); } \
        if (DOPV) { \
            _Pragma("unroll") for (int kk = 0; kk < 4; ++kk) { \
                const bf16x8 b0_ = (bf16x8){vl0_[kk][0], vl0_[kk][1], vl0_[kk][2], vl0_[kk][3], vh0_[kk][0], vh0_[kk][1], vh0_[kk][2], vh0_[kk][3]}; \
                const bf16x8 b1_ = (bf16x8){vl1_[kk][0], vl1_[kk][1], vl1_[kk][2], vl1_[kk][3], vh1_[kk][0], vh1_[kk][1], vh1_[kk][2], vh1_[kk][3]}; \
                o0 = MFMA32(PAp[kk], b0_, o0); o1 = MFMA32(PAp[kk], b1_, o1); \
                if (kk + 2 < 4) A_VRD(kk + 2, vl0_[kk + 2], vh0_[kk + 2], vl1_[kk + 2], vh1_[kk + 2]); \
                __builtin_amdgcn_sched_barrier(0); } } } while (0)
    const bool teamed = (GSZ == 256);
    const int xcd = BID & 7, slot = BID >> 3, team = slot >> 3, mem = slot & 7;
#ifdef PROBE_AT
    unsigned long long pacc = 0, pt0 = 0;
#define PT_BEG(C) do { if (PROBE_AT == (C)) pt0 = __builtin_amdgcn_s_memtime(); } while (0)
#define PT_END(C) do { if (PROBE_AT == (C)) pacc += __builtin_amdgcn_s_memtime() - pt0; } while (0)
#else
#define PT_BEG(C) do {} while (0)
#define PT_END(C) do {} while (0)
#endif
    const int nit = teamed ? 8 : 8 * ((NB * NH - BID + GSZ - 1) / GSZ);
#define A_UNIT(i, BH, QB) do { if (teamed) { BH = (xcd * 4 + team) * 8 + (i); QB = (mem + (i)) & 7; } else { BH = BID + ((i) >> 3) * GSZ; QB = 7 - ((i) & 7); } } while (0)
    bf16x8 qr[NKS];
#define A_PREFETCH(i) do { int bh_, qb_; A_UNIT(i, bh_, qb_); const size_t rb_ = (size_t)(bh_ >> 4) * SEQ; const int h_ = bh_ & 15; \
        gcb* Kh = K + rb_ * QP + h_ * QKD; gcb* Vh = V + rb_ * DM + h_ * 64; gcb* Qu_ = Q + (rb_ + qb_ * 256 + wid * 32) * QP + h_ * QKD; \
        unsigned qgo_; { int lq = lane; asm volatile("" : "+v"(lq)); qgo_ = (unsigned)((lq & 31) * QP + (lq >> 5) * 8); } \
        _Pragma("unroll") for (int ks = 0; ks < NKS; ++ks) qr[ks] = *(const __attribute__((address_space(1))) bf16x8*)(Qu_ + qgo_ + ks * 16); \
        A_DMAK(0, 0); A_DMAV(0, 0); A_DMAK(1, 1); } while (0)
    if (nit > 0) A_PREFETCH(0);
    for (int it = 0; it < nit; ++it) {
        int bh, qb; A_UNIT(it, bh, qb);
        const int b = bh >> 4, h = bh & 15; const size_t rowbase = (size_t)b * SEQ;
        gcb* Kh = K + rowbase * QP + h * QKD; gcb* Vh = V + rowbase * DM + h * 64;
        {
            const int q0 = qb * 256; const int NT = 4 * qb + 4;
            PT_BEG('U');
            const int qabs = q0 + wid * 32 + r32; const int Tw = 4 * qb + (wid >> 1);
            A_DMAWAIT(); __syncthreads();
            f32x16 pc0, pc1, pn0, pn1, o0 = (f32x16)(0.0f), o1 = (f32x16)(0.0f);
            A_QK(pc0, pc1, 0, ((f32x16)(0.0f))); A_QK(pn0, pn1, 1, ((f32x16)(0.0f)));
            bf16x8 PAp[4], PAc[4]; float mrow, lrow = 0.f, fsc = 1.f; bool upd = false;
            { if (NT == 4) A_MASK(0);
              float rm_; A_ROWMAX(rm_); mrow = rm_;
#pragma unroll
              for (int i = 0; i < 16; ++i) { pc0[i] -= mrow; pc1[i] -= mrow; }
              A_EXPPACK(); }
#pragma unroll
            for (int k4 = 0; k4 < 4; ++k4) PAp[k4] = PAc[k4];
            pc0 = pn0; pc1 = pn1;
            __syncthreads();
            A_DMAK(2, 0);
            A_DMAWAIT(); __syncthreads();
            PT_END('U');
            for (int t = 1; t < NT; ++t) {
                if (t + 2 < NT) A_DMAK(t + 2, t & 1);
                A_DMAV(t, t & 1);
                const bool band = (t >= NT - 4);
                const bool doqk = (t + 1 <= Tw), dopv = (t - 1 <= Tw), dova = (t <= Tw);
                A_MFMA(t, doqk, dopv);
                if (dova) { A_VALU(t, band); } else { upd = false; }
                if (upd) {
                    if (hi == 0) wsf[r32] = fsc;
                    asm volatile("" ::: "memory");
#pragma unroll
                    for (int g4 = 0; g4 < 4; ++g4) { const f32x4 a = *(const LAS f32x4*)(wsf + 8 * g4 + 4 * hi);
#pragma unroll
                        for (int j = 0; j < 4; ++j) { o0[4 * g4 + j] *= a[j]; o1[4 * g4 + j] *= a[j]; } }
                    asm volatile("" ::: "memory");
                }
                A_DMAWAIT(); __syncthreads();
                pc0 = pn0; pc1 = pn1;
#pragma unroll
                for (int k4 = 0; k4 < 4; ++k4) PAp[k4] = PAc[k4];
            }
            PT_BEG('U');
            { const int inx = (it + 1 < nit) ? it + 1 : it; A_PREFETCH(inx); }
            if (NT - 1 <= Tw) { A_PV((NT - 1) & 1); }
            lrow = xor_sum<32>(lrow);
            { int le = lane; asm volatile("" : "+v"(le));
              const int r32e = le & 31, hie = le >> 5;
              if (hie == 0) wsf[r32e] = 1.0f / lrow;
              asm volatile("" ::: "memory");
              LAS bf16* st0 = stg + (4 * hie) * 64 + r32e;
#pragma unroll
              for (int g4 = 0; g4 < 4; ++g4) { const f32x4 a = *(const LAS f32x4*)(wsf + 8 * g4 + 4 * hie);
#pragma unroll
                  for (int j = 0; j < 4; ++j) { const int i = 4 * g4 + j;
                      st0[(8 * g4 + j) * 64] = (bf16)f2bf(o0[i] * a[j]); st0[(8 * g4 + j) * 64 + 32] = (bf16)f2bf(o1[i] * a[j]); } }
              asm volatile("s_waitcnt lgkmcnt(0)" ::: "memory");
              const unsigned lo_ = (unsigned)((le >> 3) * DM + (le & 7) * 8); const LAS bf16* sr0 = stg + (le >> 3) * 64 + (le & 7) * 8;
#pragma unroll
              for (int i = 0; i < 4; ++i) { gb* Ow = O + (rowbase + q0 + wid * 32 + i * 8) * DM + h * 64; const u32x4 v = *(const LAS u32x4*)(sr0 + i * 8 * 64); *(__attribute__((address_space(1))) u32x4*)(Ow + lo_) = v; } }
            A_DMAWAIT(); __syncthreads();
            PT_END('U');
        }
    }
#ifdef PROBE_AT
    { const unsigned long long w0 = __builtin_amdgcn_s_memtime(); while (__builtin_amdgcn_s_memtime() - w0 < pacc) __builtin_amdgcn_s_sleep(4); }
#endif
#undef PT_BEG
#undef PT_END
#undef A_GLDS
#undef A_UNIT
#undef A_PREFETCH
#undef A_DMAK
#undef A_DMAV
#undef A_DMAWAIT
#undef A_QK
#undef A_PV
#undef A_VRD
#undef A_MASK
#undef A_ROWMAX
#undef A_EXPPACK
#undef A_VALU
#undef A_MFMA
#undef A_KRD
}

#define XB_TMO      128
#define XB_XCNT(j)  (256  + 64 * (j))
#define XB_XSUB(j)  (1280 + 64 * (j))
#define XB_XGEN(j)  (2304 + 64 * (j))
#define XB_TOP      3328
#define XB_TOPGEN   3392
#define XCD_BAR_WORDS 3456
#define XB_SPIN_CAP (1u << 18)

__device__ __forceinline__ unsigned xb_ld(unsigned* p)              { return __hip_atomic_load(p, __ATOMIC_RELAXED, __HIP_MEMORY_SCOPE_AGENT); }
__device__ __forceinline__ unsigned xb_add(unsigned* p, unsigned v) { return __hip_atomic_fetch_add(p, v, __ATOMIC_RELAXED, __HIP_MEMORY_SCOPE_AGENT); }
__device__ __forceinline__ unsigned xb_xcc_id() { return (unsigned)__builtin_amdgcn_s_getreg((3 << 11) | 20) & 0xFu; }
#define XB_SPIN(cond, bar) do { unsigned _sp = 0; while (cond) { __builtin_amdgcn_s_sleep(1); \
    if ((++_sp & 255u) == 0u) { if (xb_ld(&(bar)[XB_TMO])) break; if (_sp > XB_SPIN_CAP) { atomicAdd(&(bar)[XB_TMO], 1u); break; } } } } while (0)

struct XcdBarrier {
    unsigned* bar; unsigned x;
    volatile LAS unsigned* st;
};

__device__ __forceinline__ XcdBarrier xcd_barrier_post(unsigned* bar, volatile LAS unsigned* st, const int wv_) {
    XcdBarrier b; b.bar = bar; b.x = xb_xcc_id(); b.st = st;
    if (otid(wv_) == 0) (void)xb_add(&bar[XB_XCNT(b.x)], 1u);
    return b;
}
__device__ __forceinline__ void xcd_barrier_complete(unsigned* bar, unsigned x, unsigned& nloc, unsigned& nx) {
    const unsigned G = gridDim.x * gridDim.y * gridDim.z;
    unsigned sum, cnt, mine, sp = 0u;
    for (;;) {
        sum = 0u; cnt = 0u; mine = 0u;
#pragma unroll
        for (unsigned j = 0; j < 16; ++j) { const unsigned c = xb_ld(&bar[XB_XCNT(j)]); sum += c; cnt += (c > 0u) ? 1u : 0u; mine = (j == x) ? c : mine; }
        if (sum == G) break;
        __builtin_amdgcn_s_sleep(1);
        if ((++sp & 255u) == 0u) { if (xb_ld(&bar[XB_TMO])) break; if (sp > XB_SPIN_CAP) { atomicAdd(&bar[XB_TMO], 1u); break; } }
    }
    nloc = mine > 0u ? mine : 1u; nx = cnt > 0u ? cnt : 1u;
}

__device__ __forceinline__ void xcd_barrier(const XcdBarrier& b, const int wv_) {
    asm volatile("s_waitcnt vmcnt(0)" ::: "memory");
    __syncthreads();
    if (otid(wv_) == 0) {
        unsigned* bar = b.bar;
        __builtin_amdgcn_s_waitcnt(0);
        unsigned nloc = b.st[0], nx = b.st[1];
        if (nloc == 0u) { xcd_barrier_complete(bar, b.x, nloc, nx); b.st[0] = nloc; b.st[1] = nx; }
        const unsigned old = xb_add(&bar[XB_XSUB(b.x)], 1u);
        const unsigned gen = old / nloc;
        if (old + 1u == (gen + 1u) * nloc) {
            __builtin_amdgcn_fence(__ATOMIC_RELEASE, "agent");
            asm volatile("s_waitcnt vmcnt(0)" ::: "memory");
            const unsigned og = xb_add(&bar[XB_TOP], 1u);
            const unsigned tg = og / nx;
            if (og + 1u == (tg + 1u) * nx) xb_add(&bar[XB_TOPGEN], 1u);
            else XB_SPIN(xb_ld(&bar[XB_TOPGEN]) == tg, bar);
            __builtin_amdgcn_fence(__ATOMIC_ACQUIRE, "agent");
            xb_add(&bar[XB_XGEN(b.x)], 1u);
            asm volatile("s_waitcnt vmcnt(0)" ::: "memory");
        } else {
            XB_SPIN(xb_ld(&bar[XB_XGEN(b.x)]) == gen, bar);
            __builtin_amdgcn_fence(__ATOMIC_ACQUIRE, "agent");
            asm volatile("s_waitcnt vmcnt(0)" ::: "memory");
        }
    }
    __syncthreads();
}

__device__ __forceinline__ const float* inptr(LAS unsigned char* lds, int i) {
    unsigned off = PTR_OFF + 8 * i; asm volatile("" : "+v"(off));
    const u32x2 v = *(const LAS u32x2*)(lds + off);
    const unsigned lo = __builtin_amdgcn_readfirstlane(v.x), hi = __builtin_amdgcn_readfirstlane(v.y);
    return (const float*)(((unsigned long long)hi << 32) | lo);
}
__global__ void __launch_bounds__(NTHR, 2) trunk_fwd(Params p) {
    extern __shared__ __attribute__((aligned(16))) unsigned char lds_raw[];
    LAS unsigned char* lds = (LAS unsigned char*)lds_raw;
    cg::grid_group grid = cg::this_grid();
    const int wv_ = __builtin_amdgcn_readfirstlane(threadIdx.x >> 6);
#ifdef PROBE_CAT
    const unsigned long long tp0_ = __builtin_amdgcn_s_memrealtime();
#endif
#ifndef NO_PRO
    prologue(p, lds, wv_);
#endif
#ifdef PROBE_CAT
    if (PROBE_CAT == 'P') { const unsigned long long d_ = __builtin_amdgcn_s_memrealtime() - tp0_; const unsigned long long w0_ = __builtin_amdgcn_s_memrealtime(); while (__builtin_amdgcn_s_memrealtime() - w0_ < d_) __builtin_amdgcn_s_sleep(8); }
#endif
    { const int t0 = otid(wv_); if (t0 < 22) { const unsigned long long v = (t0 < 20) ? (unsigned long long)p.in[t0 < 20 ? t0 : 0] : (t0 == 20 ? (unsigned long long)p.out : (unsigned long long)p.ws);
        ((LAS unsigned long long*)(lds + PTR_OFF))[t0] = v; }
      if (t0 < 2) ((volatile LAS unsigned*)(lds + PTR_OFF + 256))[t0] = 0u; }
    if (blockIdx.x == 0) { unsigned* bw = (unsigned*)(p.ws + WS_CTL); for (int i = otid(wv_); i < XCD_BAR_WORDS; i += NTHR) __hip_atomic_store(bw + i, 0u, __ATOMIC_RELAXED, __HIP_MEMORY_SCOPE_AGENT); }
    __syncthreads();
    grid.sync();
    const XcdBarrier bar = xcd_barrier_post((unsigned*)(p.ws + WS_CTL), (volatile LAS unsigned*)(lds + PTR_OFF + 256), wv_);
#ifdef PROBE_CAT
    unsigned long long tprev_ = __builtin_amdgcn_s_memrealtime();
#define GSYNC(C) do { if ((C) == PROBE_CAT) { const unsigned long long d_ = __builtin_amdgcn_s_memrealtime() - tprev_; const unsigned long long w0_ = __builtin_amdgcn_s_memrealtime(); \
        while (__builtin_amdgcn_s_memrealtime() - w0_ < d_) __builtin_amdgcn_s_sleep(8); } xcd_barrier(bar, wv_); tprev_ = __builtin_amdgcn_s_memrealtime(); } while (0)
#else
#define GSYNC(C) xcd_barrier(bar, wv_)
#endif
#define WSP ((unsigned char*)inptr(lds, 21))
#define XRES ((float*)inptr(lds, 20))
#pragma nounroll
    for (int l = 0; l < DEPTH; ++l) {
        const int j = l >> 1; const bool fox = (l & 1) == 0;
#ifndef NO_NORM
        { unsigned char* ws = WSP; const float* modl = (const float*)(ws + WS_MOD) + (size_t)l * 16 * 6144;
          if (fox) norm_phase<2, true>((l == 0) ? inptr(lds, I_X) : XRES, inptr(lds, I_GMIX) + l * DM, modl + 0, modl + 1024, (bf16*)(ws + WS_H), inptr(lds, I_FWIN) + (size_t)j * DM * 3088, inptr(lds, I_FBF) + j * 16, (float*)(ws + WS_LF), lds, wv_);
          else norm_phase<4, false>(XRES, inptr(lds, I_GMIX) + l * DM, modl + 0, modl + 1024, (bf16*)(ws + WS_H), nullptr, nullptr, nullptr, lds, wv_); }
#endif
        GSYNC('N');
        if (fox) {
#ifndef NO_CUM
            { unsigned char* ws = WSP; fox_cumsum((const float*)(ws + WS_LF), (bf16*)(ws + WS_Q), (bf16*)(ws + WS_K), lds, wv_); }
#endif
#ifndef NO_G1F
            { unsigned char* ws = WSP; const bf16* WinT = (const bf16*)(ws + WS_W + W_FOX + (size_t)j * W_FOX_STRIDE);
              pg8::Gemm g{(const bf16*)(ws + WS_H), WinT, M, 3072, DM}; pg8::StaticOrder S; S.init(M, 3072, ogrid(), obid());
              pg8::EpiQkvFox E{ws, 0.125f * LOG2E};
              pg8::gemm_phase<pg8::EpiQkvFox, pg8::StaticOrder, true, true>(lds, g, S, E, wv_); }
#endif
            GSYNC('G');
#ifndef NO_ATT5
            { unsigned char* ws = WSP; attn_phase<5>(lds, (const bf16*)(ws + WS_Q), (const bf16*)(ws + WS_K), (const bf16*)(ws + WS_V), (bf16*)(ws + WS_H), wv_); }
#ifdef PROBE_ATT2
            { unsigned char* ws = WSP; attn_phase<5>(lds, (const bf16*)(ws + WS_Q), (const bf16*)(ws + WS_K), (const bf16*)(ws + WS_V), (bf16*)(ws + WS_H), wv_); }
#endif
#endif
            GSYNC('A');
        } else {
#ifndef NO_GD
            { unsigned char* ws = WSP; const bf16* WdT = (const bf16*)(ws + WS_W + W_MLA + (size_t)j * W_MLA_STRIDE);
              pg8::Gemm g{(const bf16*)(ws + WS_H), WdT, M, 512, DM}; pg8::StaticOrder S; S.init(M, 512, ogrid(), obid());
              pg8::EpiMlaDown E{ws};
              pg8::gemm_phase<pg8::EpiMlaDown, pg8::StaticOrder, true, true>(lds, g, S, E, wv_); }
#endif
            GSYNC('H');
#ifndef NO_GQ
            { unsigned char* ws = WSP; const bf16* WuqT = (const bf16*)(ws + WS_W + W_MLA + (size_t)j * W_MLA_STRIDE) + (size_t)512 * 1024;
              int Kq = 256; asm volatile("" : "+s"(Kq));
              pg8::Gemm g{(const bf16*)(ws + WS_CQ), WuqT, M, 1536, Kq}; pg8::StaticOrder S; S.init(M, 1536, ogrid(), obid());
              pg8::EpiMlaQ E{ws, 0.10206207261596575f * LOG2E};
              pg8::gemm_phase<pg8::EpiMlaQ, pg8::StaticOrder, true, true>(lds, g, S, E, wv_); }
#endif
#ifndef NO_GKV
            { unsigned char* ws = WSP; const bf16* WukvT = (const bf16*)(ws + WS_W + W_MLA + (size_t)j * W_MLA_STRIDE) + (size_t)512 * 1024 + (size_t)1536 * 256;
              int Kkv = 128; asm volatile("" : "+s"(Kkv));
              pg8::Gemm g{(const bf16*)(ws + WS_CKV), WukvT, M, 2048, Kkv}; pg8::StaticOrder S; S.init(M, 2048, ogrid(), obid());
              pg8::EpiMlaKv E{ws};
              pg8::gemm_phase<pg8::EpiMlaKv, pg8::StaticOrder, true, true>(lds, g, S, E, wv_); }
#endif
            GSYNC('Q');
#ifndef NO_ATT6
            { unsigned char* ws = WSP; attn_phase<6>(lds, (const bf16*)(ws + WS_Q), (const bf16*)(ws + WS_K), (const bf16*)(ws + WS_V), (bf16*)(ws + WS_H), wv_); }
#ifdef PROBE_ATT2
            { unsigned char* ws = WSP; attn_phase<6>(lds, (const bf16*)(ws + WS_Q), (const bf16*)(ws + WS_K), (const bf16*)(ws + WS_V), (bf16*)(ws + WS_H), wv_); }
#endif
#endif
            GSYNC('B');
        }
#ifndef NO_GO
        { unsigned char* ws = WSP; const float* modl = (const float*)(ws + WS_MOD) + (size_t)l * 16 * 6144;
          const bf16* WoutT = fox ? (const bf16*)(ws + WS_W + W_FOX + (size_t)j * W_FOX_STRIDE) + (size_t)3072 * DM : (const bf16*)(ws + WS_W + W_MLA + (size_t)j * W_MLA_STRIDE + 3 * MiB);
          float* xres = XRES;
          pg8::Gemm g{(const bf16*)(ws + WS_H), WoutT, M, DM, DM}; pg8::StaticOrder S; S.init(M, DM, ogrid(), obid());
          pg8::EpiResid E{(l == 0) ? inptr(lds, I_X) : xres, xres, modl + 2048};
          pg8::gemm_phase<pg8::EpiResid, pg8::StaticOrder, true, true>(lds, g, S, E, wv_); }
#endif
        GSYNC('O');
#ifndef NO_NORM2
        { unsigned char* ws = WSP; const float* modl = (const float*)(ws + WS_MOD) + (size_t)l * 16 * 6144;
          norm_phase<4, false>(XRES, inptr(lds, I_GMLP) + l * DM, modl + 3072, modl + 4096, (bf16*)(ws + WS_H), nullptr, nullptr, nullptr, lds, wv_); }
#endif
        GSYNC('M');
#ifndef NO_GU
        { unsigned char* ws = WSP; const bf16* W1T = (const bf16*)(ws + WS_W + W_MLP + (size_t)l * W_MLP_STRIDE);
          pg8::Gemm g{(const bf16*)(ws + WS_H), W1T, M, FF, DM}; pg8::StaticOrder S; S.init(M, FF, ogrid(), obid());
          pg8::EpiRelu2 E{ws};
          pg8::gemm_phase<pg8::EpiRelu2, pg8::StaticOrder, true, true>(lds, g, S, E, wv_); }
#endif
        GSYNC('U');
#ifndef NO_GDN
        { unsigned char* ws = WSP; const float* modl = (const float*)(ws + WS_MOD) + (size_t)l * 16 * 6144;
          const bf16* W2T = (const bf16*)(ws + WS_W + W_MLP + (size_t)l * W_MLP_STRIDE) + (size_t)FF * DM;
          float* xres = XRES;
          pg8::Gemm g{(const bf16*)(ws + WS_BIG), W2T, M, DM, FF}; pg8::StaticOrder S; S.init(M, DM, ogrid(), obid());
          pg8::EpiResid E{xres, xres, modl + 5120};
          pg8::gemm_phase<pg8::EpiResid, pg8::StaticOrder, true, true>(lds, g, S, E, wv_); }
#endif
        GSYNC('D');
    }
    final_norm(XRES, inptr(lds, I_GFIN), wv_);
#ifdef PROBE_CAT
    if (PROBE_CAT == 'F') { const unsigned long long d_ = __builtin_amdgcn_s_memrealtime() - tprev_; const unsigned long long w0_ = __builtin_amdgcn_s_memrealtime(); while (__builtin_amdgcn_s_memrealtime() - w0_ < d_) __builtin_amdgcn_s_sleep(8); }
#endif
}

extern "C" void kernel_launch(void* const* d_in, const int* in_sizes, int n_in, void* d_out, int out_size, void* d_ws, size_t ws_size, hipStream_t stream) {
    static int grid = 0;
    if (grid == 0) {
        if (n_in != 20 || in_sizes[0] != M * DM || out_size != M * DM || ws_size < WS_END) { fprintf(stderr, "kernel_launch: unexpected shapes (n_in %d, in0 %d, out %d, ws %zu)\n", n_in, n_in > 0 ? in_sizes[0] : -1, out_size, ws_size); grid = -1; return; }
        int dev = 0, cus = 0, per_cu = 0;
        if (hipGetDevice(&dev) != hipSuccess || hipDeviceGetAttribute(&cus, hipDeviceAttributeMultiprocessorCount, dev) != hipSuccess) { fprintf(stderr, "kernel_launch: device query failed\n"); grid = -1; return; }
        if (hipFuncSetAttribute((const void*)trunk_fwd, hipFuncAttributeMaxDynamicSharedMemorySize, LDS_BYTES) != hipSuccess) { fprintf(stderr, "kernel_launch: hipFuncSetAttribute failed\n"); grid = -1; return; }
        if (hipOccupancyMaxActiveBlocksPerMultiprocessor(&per_cu, (const void*)trunk_fwd, NTHR, LDS_BYTES) != hipSuccess || per_cu < 1) { fprintf(stderr, "kernel_launch: occupancy query gave %d\n", per_cu); per_cu = 1; }
        (void)hipGetLastError();
        grid = cus * per_cu;
    }
    if (grid < 0) return;
    Params prm{};
    for (int i = 0; i < 20; ++i) prm.in[i] = (const float*)d_in[i];
    prm.out = (float*)d_out; prm.ws = (unsigned char*)d_ws;
    void* args[] = {&prm};
    hipError_t e = hipLaunchCooperativeKernel((const void*)trunk_fwd, dim3(grid), dim3(NTHR), args, LDS_BYTES, stream);
    if (e != hipSuccess) fprintf(stderr, "kernel_launch: cooperative launch failed: %s (grid %d)\n", hipGetErrorString(e), grid);
}
```

```cpp
#include <hip/hip_runtime.h>
#include <hip/hip_cooperative_groups.h>
#include <cstdio>
#include <cstdint>
namespace cg = cooperative_groups;
#define LAS __attribute__((address_space(3)))
typedef unsigned short bf16;
typedef short bf16x8 __attribute__((ext_vector_type(8)));
typedef short s16x4 __attribute__((ext_vector_type(4)));
typedef float f32x16 __attribute__((ext_vector_type(16)));
typedef float f32x4 __attribute__((ext_vector_type(4)));
typedef float f32x2 __attribute__((ext_vector_type(2)));
typedef unsigned u32x4 __attribute__((ext_vector_type(4)));
typedef unsigned u32x2 __attribute__((ext_vector_type(2)));

constexpr int NB = 16, SEQ = 2048, DM = 1024, NH = 16, FF = 4096, DEPTH = 4;
constexpr int M = NB * SEQ;
constexpr int NTHR = 512, NWAVE = 8;
constexpr float EPS = 1e-6f, LOG2E = 1.4426950408889634f;
constexpr size_t MiB = 1u << 20;
constexpr size_t WS_BIG = 0;
constexpr size_t WS_Q = 0, WS_K = 96 * MiB, WS_V = 192 * MiB;
constexpr size_t WS_H = 256 * MiB;
constexpr size_t WS_CQ = 320 * MiB, WS_CKV = 336 * MiB;
constexpr size_t WS_W = 344 * MiB;
constexpr size_t W_FOX = 0, W_FOX_STRIDE = 8 * MiB;
constexpr size_t W_MLA = 16 * MiB, W_MLA_STRIDE = 5 * MiB;
constexpr size_t W_MLP = 26 * MiB, W_MLP_STRIDE = 16 * MiB;
constexpr size_t WS_MOD = 436 * MiB;
constexpr size_t WS_CS = 438 * MiB;
constexpr size_t WS_LF = 442 * MiB;
constexpr size_t WS_SSQQ = 444 * MiB, WS_SSQKV = 445 * MiB;
constexpr size_t WS_CTL = 446 * MiB;
constexpr size_t WS_XB = 447 * MiB;
constexpr size_t WS_END = 511 * MiB;
static_assert(WS_W + W_MLP + 4 * W_MLP_STRIDE <= WS_MOD, "weights fit");
constexpr int LDS_BYTES = 135168;

template <int MASK> __device__ __forceinline__ float xor_sum(float v) {
    if constexpr (MASK == 32) return v + __shfl_xor(v, 32);
    else return v + __builtin_bit_cast(float, __builtin_amdgcn_ds_swizzle(__builtin_bit_cast(int, v), (MASK << 10) | 0x1F));
}
template <int MASK> __device__ __forceinline__ float xor_get(float v, bool upper) {
    if constexpr (MASK == 32) return __shfl_xor(v, 32);
    else return __builtin_bit_cast(float, __builtin_amdgcn_ds_swizzle(__builtin_bit_cast(int, v), (MASK << 10) | 0x1F));
}
__device__ __forceinline__ float wave_sum(float v) { v = xor_sum<1>(v); v = xor_sum<2>(v); v = xor_sum<4>(v); v = xor_sum<8>(v); v = xor_sum<16>(v); v = xor_sum<32>(v); return v; }
namespace pg8 {
#define PG8_LAS __attribute__((address_space(3)))
typedef unsigned short bf16_t;
typedef short bf16x8 __attribute__((ext_vector_type(8)));
typedef float f32x4 __attribute__((ext_vector_type(4)));
typedef unsigned u32x4 __attribute__((ext_vector_type(4)));
constexpr int BM = 256, BK = 64, HALF = 128, HTB = HALF * BK * 2  , STAGE_BYTES = 8 * HTB, NXCD = 8, WGM = 8;

__host__ __device__ __forceinline__ int lds_byte(int r, int c) { const int st = (r >> 4) * 2 + (c >> 5), rr = r & 15, cc = c & 31, ob = rr * 64 + cc * 2; return st * 1024 + (ob ^ (((ob >> 9) & 1) << 5)); }
__host__ __device__ __forceinline__ void stage_rc(int b, int& R, int& C) { const int st = b / 1024, sb = b % 1024, swz = sb ^ (((sb >> 9) & 1) << 5); R = (st >> 1) * 16 + swz / 64; C = (st & 1) * 32 + (swz % 64) / 2; }
__host__ __device__ __forceinline__ int perm32(int rho) { const int n = rho >> 4, i = rho & 15; return 8 * (i >> 2) + 4 * n + (i & 3); }

struct Unit { int pm, pn; };
struct Gemm { const bf16_t* A; const bf16_t* Bt; int M, N, K; };

struct StaticOrder {
    int nM, nN, nwg, G, c;
    __host__ __device__ void init(int M, int N, int G_, int c_) { nM = M / BM; nN = N / BM; nwg = nM * nN; G = G_; c = c_; }
    __host__ __device__ bool next(int i, Unit& u) const {
        const long L = (long)i * G + c; if (L >= nwg) return false;
        int wgid = (int)L; { const int q = nwg / NXCD, r = nwg % NXCD, xcd = wgid % NXCD, off = wgid / NXCD; wgid = (xcd < r ? xcd * (q + 1) : r * (q + 1) + (xcd - r) * q) + off; }
        const int nig = WGM * nN, gid = wgid / nig, fm = gid * WGM, gsz = (nM - fm) < WGM ? (nM - fm) : WGM;
        u.pm = fm + ((wgid % nig) % gsz); u.pn = (wgid % nig) / gsz; return true;
    }
    __device__ __forceinline__ void a_ready(const Unit&) const {}
    __device__ __forceinline__ void done(const Unit&) const {}
};

__device__ __forceinline__ unsigned cvt_pk_bf16(float lo, float hi) { unsigned r; asm volatile("v_cvt_pk_bf16_f32 %0, %1, %2" : "=v"(r) : "v"(lo), "v"(hi)); return r; }
typedef float f32x2 __attribute__((ext_vector_type(2)));
typedef unsigned u32x2 __attribute__((ext_vector_type(2)));
#define GAS __attribute__((address_space(1)))
typedef GAS bf16_t gbf16; typedef GAS float gf32; typedef GAS unsigned char gu8;
constexpr float RMS_EPS = 1e-6f;
__device__ __forceinline__ u32x4 pack8(const f32x4& v0, const f32x4& v1) { u32x4 w; w.x = cvt_pk_bf16(v0[0], v0[1]); w.y = cvt_pk_bf16(v0[2], v0[3]); w.z = cvt_pk_bf16(v1[0], v1[1]); w.w = cvt_pk_bf16(v1[2], v1[3]); return w; }
__device__ __forceinline__ u32x2 pack4(const f32x4& v) { u32x2 w; w.x = cvt_pk_bf16(v[0], v[1]); w.y = cvt_pk_bf16(v[2], v[3]); return w; }

struct EpiQkvFox {
    static constexpr bool PERM = true, AFTER_DRAIN = false;
    unsigned char* ws; float qscale;
    __device__ __forceinline__ void operator()(const f32x4 (&acc)[2][2][4][2], const Unit& u, int wr, int wc, int fr, int fq) const {
        gbf16* Q = (gbf16*)((gu8*)ws + WS_Q); gbf16* Kp = (gbf16*)((gu8*)ws + WS_K); gbf16* V = (gbf16*)((gu8*)ws + WS_V);
        const int row0 = u.pm * BM + wr * 64 + fr;
        const int t = u.pn >> 2;
        const int cin0 = (u.pn & 3) * BM + wc * 32 + 8 * fq;
        const float sc = (t == 0) ? qscale : 1.f;
#pragma unroll
        for (int ai = 0; ai < 2; ++ai)
#pragma unroll
            for (int m = 0; m < 4; ++m) { const unsigned row = (unsigned)(row0 + ai * HALF + m * 16);
#pragma unroll
                for (int bj = 0; bj < 2; ++bj) { const int cin = cin0 + bj * HALF;
                    gbf16* dst = (t == 2) ? (V + row * 1024 + cin) : ((t == 0 ? Q : Kp) + row * 1280 + (cin >> 6) * 80 + (cin & 63));
                    *(GAS u32x4*)dst = pack8(acc[ai][bj][m][0] * sc, acc[ai][bj][m][1] * sc); } }
    }
};
struct EpiRelu2 {
    static constexpr bool PERM = true, AFTER_DRAIN = false;
    unsigned char* ws;
    __device__ __forceinline__ void operator()(const f32x4 (&acc)[2][2][4][2], const Unit& u, int wr, int wc, int fr, int fq) const {
        gbf16* H = (gbf16*)((gu8*)ws + WS_BIG);
        const int row0 = u.pm * BM + wr * 64 + fr; const int col0 = u.pn * BM + wc * 32 + 8 * fq;
#pragma unroll
        for (int ai = 0; ai < 2; ++ai)
#pragma unroll
            for (int m = 0; m < 4; ++m) { gbf16* rowp = H + (unsigned)(row0 + ai * HALF + m * 16) * 4096u + (unsigned)col0;
#pragma unroll
                for (int bj = 0; bj < 2; ++bj) { f32x4 v0 = acc[ai][bj][m][0], v1 = acc[ai][bj][m][1];
#pragma unroll
                    for (int j = 0; j < 4; ++j) { const float a = fmaxf(v0[j], 0.f), b = fmaxf(v1[j], 0.f); v0[j] = a * a; v1[j] = b * b; }
                    *(GAS u32x4*)(rowp + bj * HALF) = pack8(v0, v1); } }
    }
};
struct EpiResid {
    static constexpr bool PERM = true, AFTER_DRAIN = false;
    const float* base32_; bf16_t* xb_; const float* gate_;
    __device__ __forceinline__ void operator()(const f32x4 (&acc)[2][2][4][2], const Unit& u, int wr, int wc, int fr, int fq) const {
        const gf32* base32 = (const gf32*)base32_; gbf16* xb = (gbf16*)xb_; const gf32* gate = (const gf32*)gate_;
        const int row0 = u.pm * BM + wr * 64 + fr; const int col0 = u.pn * BM + wc * 32 + 8 * fq;
        const gf32* gp = gate + (size_t)(u.pm >> 3) * 6144 + col0;
        f32x4 gv[2][2];
#pragma unroll
        for (int bj = 0; bj < 2; ++bj)
#pragma unroll
            for (int n = 0; n < 2; ++n) gv[bj][n] = *(const GAS f32x4*)(gp + bj * HALF + n * 4);
#pragma unroll
        for (int ai = 0; ai < 2; ++ai)
#pragma unroll
            for (int m = 0; m < 4; ++m) { const unsigned off = (unsigned)(row0 + ai * HALF + m * 16) * 1024u + (unsigned)col0;
#pragma unroll
                for (int bj = 0; bj < 2; ++bj) { f32x4 b0, b1;
                    if (base32_) { b0 = *(const GAS f32x4*)(base32 + off + bj * HALF); b1 = *(const GAS f32x4*)(base32 + off + bj * HALF + 4); }
                    else { const u32x4 w = *(const GAS u32x4*)(xb + off + bj * HALF);
                        b0 = (f32x4){__builtin_bit_cast(float, w.x << 16), __builtin_bit_cast(float, w.x & 0xffff0000u), __builtin_bit_cast(float, w.y << 16), __builtin_bit_cast(float, w.y & 0xffff0000u)};
                        b1 = (f32x4){__builtin_bit_cast(float, w.z << 16), __builtin_bit_cast(float, w.z & 0xffff0000u), __builtin_bit_cast(float, w.w << 16), __builtin_bit_cast(float, w.w & 0xffff0000u)}; }
                    *(GAS u32x4*)(xb + off + bj * HALF) = pack8(b0 + gv[bj][0] * acc[ai][bj][m][0], b1 + gv[bj][1] * acc[ai][bj][m][1]); } }
    }
};
struct EpiMlaKv {
    static constexpr bool PERM = true, AFTER_DRAIN = false;
    unsigned char* ws;
    __device__ __forceinline__ void operator()(const f32x4 (&acc)[2][2][4][2], const Unit& u, int wr, int wc, int fr, int fq) const {
        const gf32* ssq = (const gf32*)((gu8*)ws + WS_SSQKV); gbf16* Kp = (gbf16*)((gu8*)ws + WS_K); gbf16* V = (gbf16*)((gu8*)ws + WS_V);
        const int row0 = u.pm * BM + wr * 64 + fr;
        const int t = u.pn >> 2; const int cin0 = (u.pn & 3) * BM + wc * 32 + 8 * fq;
#pragma unroll
        for (int ai = 0; ai < 2; ++ai)
#pragma unroll
            for (int m = 0; m < 4; ++m) { const unsigned row = (unsigned)(row0 + ai * HALF + m * 16);
                const f32x4 s4 = *(const GAS f32x4*)(ssq + row * 4);
                const float rs = __builtin_amdgcn_rsqf(((s4[0] + s4[1]) + (s4[2] + s4[3])) * (1.0f / 128.0f) + RMS_EPS);
#pragma unroll
                for (int bj = 0; bj < 2; ++bj) { const int cin = cin0 + bj * HALF;
                    gbf16* dst = t ? (V + row * 1024 + cin) : (Kp + row * 1536 + (cin >> 6) * 96 + (cin & 63));
                    *(GAS u32x4*)dst = pack8(acc[ai][bj][m][0] * rs, acc[ai][bj][m][1] * rs); }
                asm volatile("" ::: "memory"); }
    }
};
struct EpiMlaQ {
    static constexpr bool PERM = false, AFTER_DRAIN = false;
    unsigned char* ws; float qscale;
    __device__ __forceinline__ void operator()(const f32x4 (&acc)[2][2][4][2], const Unit& u, int wr, int wc, int fr, int fq) const {
        const gf32* ssq = (const gf32*)((gu8*)ws + WS_SSQQ); const gf32* cst = (const gf32*)((gu8*)ws + WS_CS); gbf16* Q = (gbf16*)((gu8*)ws + WS_Q);
        const int row0 = u.pm * BM + wr * 64 + fr;
#pragma unroll
        for (int ai = 0; ai < 2; ++ai)
#pragma unroll
            for (int m = 0; m < 4; ++m) { const unsigned row = (unsigned)(row0 + ai * HALF + m * 16);
                const f32x4 s4 = *(const GAS f32x4*)(ssq + row * 4);
                const float rs = qscale * __builtin_amdgcn_rsqf(((s4[0] + s4[1]) + (s4[2] + s4[3])) * (1.0f / 256.0f) + RMS_EPS);
                if (u.pn < 4) {
#pragma unroll
                    for (int bj = 0; bj < 2; ++bj)
#pragma unroll
                        for (int n = 0; n < 2; ++n) { const int cin = u.pn * BM + bj * HALF + wc * 32 + n * 16 + 4 * fq;
                            *(GAS u32x2*)(Q + row * 1536 + (cin >> 6) * 96 + (cin & 63)) = pack4(acc[ai][bj][m][n] * rs); }
                } else {
                    const f32x4 cs = *(const GAS f32x4*)(cst + row * 32 + 4 * fq), sn = *(const GAS f32x4*)(cst + row * 32 + 16 + 4 * fq);
#pragma unroll
                    for (int bj = 0; bj < 2; ++bj) { const int head = ((u.pn - 4) * BM + bj * HALF + wc * 32) >> 5;
                        const f32x4 x1 = acc[ai][bj][m][0] * rs, x2 = acc[ai][bj][m][1] * rs;
                        gbf16* dst = Q + row * 1536 + head * 96 + 64 + 4 * fq;
                        *(GAS u32x2*)dst = pack4(x1 * cs - x2 * sn); *(GAS u32x2*)(dst + 16) = pack4(x2 * cs + x1 * sn); }
                }
                asm volatile("" ::: "memory");
            }
    }
};
struct EpiMlaDown {
    static constexpr bool PERM = false, AFTER_DRAIN = false;
    unsigned char* ws;
    __device__ __forceinline__ void operator()(const f32x4 (&acc)[2][2][4][2], const Unit& u, int wr, int wc, int fr, int fq) const {
        gbf16* cq = (gbf16*)((gu8*)ws + WS_CQ); gbf16* ckv = (gbf16*)((gu8*)ws + WS_CKV); gf32* ssqq = (gf32*)((gu8*)ws + WS_SSQQ); gf32* ssqkv = (gf32*)((gu8*)ws + WS_SSQKV); const gf32* cst = (const gf32*)((gu8*)ws + WS_CS); gbf16* Kp = (gbf16*)((gu8*)ws + WS_K);
        const int row0 = u.pm * BM + wr * 64 + fr;
#pragma unroll
        for (int ai = 0; ai < 2; ++ai)
#pragma unroll
            for (int m = 0; m < 4; ++m) { const unsigned row = (unsigned)(row0 + ai * HALF + m * 16);
                if (u.pn == 0) {
                    float ss = 0.f;
#pragma unroll
                    for (int bj = 0; bj < 2; ++bj)
#pragma unroll
                        for (int n = 0; n < 2; ++n) { const f32x4 v = acc[ai][bj][m][n]; ss += (v[0] * v[0] + v[1] * v[1]) + (v[2] * v[2] + v[3] * v[3]);
                            *(GAS u32x2*)(cq + row * 256 + bj * HALF + wc * 32 + n * 16 + 4 * fq) = pack4(v); }
                    ss = xor_sum<16>(ss); ss = xor_sum<32>(ss);
                    if (fq == 0) ssqq[row * 4 + wc] = ss;
                } else {
                    float ss = 0.f;
#pragma unroll
                    for (int n = 0; n < 2; ++n) { const f32x4 v = acc[ai][0][m][n]; ss += (v[0] * v[0] + v[1] * v[1]) + (v[2] * v[2] + v[3] * v[3]);
                        *(GAS u32x2*)(ckv + row * 128 + wc * 32 + n * 16 + 4 * fq) = pack4(v); }
                    ss = xor_sum<16>(ss); ss = xor_sum<32>(ss);
                    if (fq == 0) ssqkv[row * 4 + wc] = ss;
                    if (wc == 0) {
                        const f32x4 cs = *(const GAS f32x4*)(cst + row * 32 + 4 * fq), sn = *(const GAS f32x4*)(cst + row * 32 + 16 + 4 * fq);
                        const f32x4 x1 = acc[ai][1][m][0], x2 = acc[ai][1][m][1];
                        const u32x2 o1 = pack4(x1 * cs - x2 * sn), o2 = pack4(x2 * cs + x1 * sn);
                        gbf16* dst = Kp + row * 1536 + 64 + 4 * fq;
#pragma unroll
                        for (int hd = 0; hd < 16; ++hd) { *(GAS u32x2*)(dst + hd * 96) = o1; *(GAS u32x2*)(dst + hd * 96 + 16) = o2; }
                    }
                }
            }
    }
};

template <class Epi, class Sched, bool ALIGN_EPI = false, bool SP2 = false>
__device__ __forceinline__ void gemm_phase(PG8_LAS unsigned char* lds, const Gemm g, const Sched& S, const Epi& E, const int wv_) {
    int tid_; asm volatile("v_mbcnt_lo_u32_b32 %0, -1, 0\n\tv_mbcnt_hi_u32_b32 %0, -1, %0" : "=v"(tid_)); tid_ += wv_ * 64;
    const int tid = tid_, wid = __builtin_amdgcn_readfirstlane(tid >> 6), lane = tid & 63, wr = wid >> 2, wc = wid & 3, fr = lane & 15, fq = lane >> 4;
    const int K = g.K, nt = K / BK;
    unsigned voffA[2], voffB[2];
#pragma unroll
    for (int i = 0; i < 2; ++i) { int R, C; stage_rc(tid * 16 + i * 8192, R, C); const int Rb = Epi::PERM ? ((R & ~31) + perm32(R & 31)) : R;
        voffA[i] = (unsigned)(R * K + C) * 2u; voffB[i] = (unsigned)(Rb * K + C) * 2u; }
    const size_t kstep = (size_t)(BK * 2);
    const size_t hstep = (size_t)HALF * K * 2;
    const size_t tstep = 2 * hstep;
    const unsigned ldsw = (unsigned)wid * 1024u;
    const int aoff = lds_byte(wr * 64 + fr, fq * 8), boff = lds_byte(wc * 32 + fr, fq * 8);
#define PG8_SA(b, h) (((b) * 2 + (h)) * HTB)
#define PG8_SB(b, h) ((4 + (b) * 2 + (h)) * HTB)
#define PG8_STAGE(bufoff, gbase, voff) do { _Pragma("unroll") for (int _i = 0; _i < 2; ++_i) \
        __builtin_amdgcn_global_load_lds((const unsigned*)((const char*)(gbase) + (voff)[_i]), (PG8_LAS unsigned*)(lds + (bufoff) + ldsw + _i * 8192), 16, 0, 0); } while (0)
#define PG8_LDA(dst, b, h) do { _Pragma("unroll") for (int m = 0; m < 4; ++m) _Pragma("unroll") for (int k = 0; k < 2; ++k) dst[m][k] = *(const PG8_LAS bf16x8*)(lds + PG8_SA(b, h) + aoff + m * 2048 + k * 1024); } while (0)
#define PG8_LDB(dst, b, h) do { _Pragma("unroll") for (int n = 0; n < 2; ++n) _Pragma("unroll") for (int k = 0; k < 2; ++k) dst[n][k] = *(const PG8_LAS bf16x8*)(lds + PG8_SB(b, h) + boff + n * 2048 + k * 1024); } while (0)
#define PG8_MMA(ai, bj, At, Bt) do { __builtin_amdgcn_s_setprio(1); _Pragma("unroll") for (int m = 0; m < 4; ++m) _Pragma("unroll") for (int n = 0; n < 2; ++n) _Pragma("unroll") for (int k = 0; k < 2; ++k) \
        acc[ai][bj][m][n] = __builtin_amdgcn_mfma_f32_16x16x32_bf16(Bt[n][k], At[m][k], acc[ai][bj][m][n], 0, 0, 0); __builtin_amdgcn_s_setprio(0); } while (0)
#define PG8_WAIT_V(n) asm volatile("s_waitcnt vmcnt(" #n ")" ::: "memory")
#define PG8_WAIT_L(n) asm volatile("s_waitcnt lgkmcnt(" #n ")" ::: "memory")
#define PG8_BAR __builtin_amdgcn_s_barrier()
#define PG8_SCHED __builtin_amdgcn_sched_barrier(0)
    Unit cur, nxt; int ui = 0;
    if (!S.next(0, cur)) return;
    f32x4 acc[2][2][4][2];
#pragma unroll
    for (int a = 0; a < 2; ++a)
#pragma unroll
        for (int b = 0; b < 2; ++b)
#pragma unroll
            for (int m = 0; m < 4; ++m)
#pragma unroll
                for (int n = 0; n < 2; ++n) acc[a][b][m][n] = (f32x4){0.f, 0.f, 0.f, 0.f};
    bf16x8 At[4][2], B0[2][2], B1[2][2];
    const char* cA = (const char*)g.A + (size_t)cur.pm * tstep; const char* cB = (const char*)g.Bt + (size_t)cur.pn * tstep;
    S.a_ready(cur);
    if constexpr (SP2) {
        PG8_STAGE(PG8_SB(0, 0), cB, voffB); PG8_STAGE(PG8_SB(0, 1), cB + hstep, voffB); PG8_STAGE(PG8_SA(0, 0), cA, voffA); PG8_STAGE(PG8_SA(0, 1), cA + hstep, voffA);
        if (wr == 1) PG8_BAR;
        PG8_WAIT_V(2); PG8_BAR;
        PG8_STAGE(PG8_SB(1, 0), cB + kstep, voffB); PG8_STAGE(PG8_SA(1, 0), cA + kstep, voffA); PG8_STAGE(PG8_SB(1, 1), cB + hstep + kstep, voffB);
        PG8_WAIT_V(6); PG8_BAR;
    } else {
        PG8_STAGE(PG8_SB(0, 0), cB, voffB); PG8_STAGE(PG8_SA(0, 0), cA, voffA); PG8_STAGE(PG8_SB(0, 1), cB + hstep, voffB); PG8_STAGE(PG8_SA(0, 1), cA + hstep, voffA);
        if (wr == 1) PG8_BAR;
        PG8_WAIT_V(4); PG8_BAR;
        PG8_STAGE(PG8_SB(1, 0), cB + kstep, voffB); PG8_STAGE(PG8_SA(1, 0), cA + kstep, voffA); PG8_STAGE(PG8_SB(1, 1), cB + hstep + kstep, voffB);
        PG8_WAIT_V(6); PG8_BAR;
    }
    for (;;) {
        const bool has_next = S.next(ui + 1, nxt);
        const char* nA = has_next ? (const char*)g.A + (size_t)nxt.pm * tstep : cA; const char* nB = has_next ? (const char*)g.Bt + (size_t)nxt.pn * tstep : cB;
        for (int t = 0; t < nt; t += 2) {
            const bool last = (t == nt - 2);
            const char* a1 = cA + (size_t)(t + 1) * kstep;
            const char* a2 = last ? nA : cA + (size_t)(t + 2) * kstep; const char* b2 = last ? nB : cB + (size_t)(t + 2) * kstep;
            const char* a3 = a2 + kstep; const char* b3 = b2 + kstep;
            if (last && has_next) S.a_ready(nxt);
            if constexpr (SP2) {
            PG8_LDB(B0, 0, 0); PG8_LDB(B1, 0, 1); PG8_SCHED; PG8_LDA(At, 0, 0); PG8_STAGE(PG8_SA(1, 1), a1 + hstep, voffA);
            PG8_WAIT_V(8); PG8_WAIT_L(0); PG8_BAR; PG8_MMA(0, 0, At, B0); PG8_MMA(0, 1, At, B1); PG8_BAR; PG8_SCHED;
            PG8_LDA(At, 0, 1); PG8_STAGE(PG8_SB(0, 0), b2, voffB); PG8_STAGE(PG8_SB(0, 1), b2 + hstep, voffB); PG8_STAGE(PG8_SA(0, 0), a2, voffA);
            PG8_WAIT_V(8); PG8_WAIT_L(0); PG8_BAR; PG8_MMA(1, 0, At, B0); PG8_MMA(1, 1, At, B1); PG8_BAR; PG8_SCHED;
            PG8_LDB(B0, 1, 0); PG8_LDB(B1, 1, 1); PG8_SCHED; PG8_LDA(At, 1, 0); PG8_STAGE(PG8_SA(0, 1), a2 + hstep, voffA);
            PG8_WAIT_V(8); PG8_WAIT_L(0); PG8_BAR; PG8_MMA(0, 0, At, B0); PG8_MMA(0, 1, At, B1); PG8_BAR; PG8_SCHED;
            PG8_LDA(At, 1, 1); PG8_STAGE(PG8_SB(1, 0), b3, voffB); PG8_STAGE(PG8_SB(1, 1), b3 + hstep, voffB); PG8_STAGE(PG8_SA(1, 0), a3, voffA);
            PG8_WAIT_V(8); PG8_WAIT_L(0); PG8_BAR; PG8_MMA(1, 0, At, B0); PG8_MMA(1, 1, At, B1); PG8_BAR; PG8_SCHED;
            } else {
            PG8_LDB(B0, 0, 0); PG8_SCHED; PG8_LDA(At, 0, 0); PG8_STAGE(PG8_SA(1, 1), a1 + hstep, voffA);
            PG8_WAIT_L(8); PG8_BAR; PG8_WAIT_L(0); PG8_MMA(0, 0, At, B0); PG8_BAR; PG8_SCHED;
            PG8_LDB(B1, 0, 1); PG8_STAGE(PG8_SB(0, 0), b2, voffB);
            PG8_BAR; PG8_WAIT_L(0); PG8_MMA(0, 1, At, B1); PG8_BAR;
            PG8_LDA(At, 0, 1); PG8_STAGE(PG8_SA(0, 0), a2, voffA);
            PG8_BAR; PG8_WAIT_L(0); PG8_MMA(1, 0, At, B0); PG8_BAR; PG8_SCHED;
            PG8_STAGE(PG8_SB(0, 1), b2 + hstep, voffB);
            PG8_WAIT_V(6); PG8_BAR; PG8_MMA(1, 1, At, B1); PG8_BAR;
            PG8_LDB(B0, 1, 0); PG8_SCHED; PG8_LDA(At, 1, 0); PG8_STAGE(PG8_SA(0, 1), a2 + hstep, voffA);
            PG8_WAIT_L(8); PG8_BAR; PG8_WAIT_L(0); PG8_MMA(0, 0, At, B0); PG8_BAR; PG8_SCHED;
            PG8_LDB(B1, 1, 1); PG8_STAGE(PG8_SB(1, 0), b3, voffB);
            PG8_BAR; PG8_WAIT_L(0); PG8_MMA(0, 1, At, B1); PG8_BAR;
            PG8_LDA(At, 1, 1); PG8_STAGE(PG8_SA(1, 0), a3, voffA);
            PG8_BAR; PG8_WAIT_L(0); PG8_MMA(1, 0, At, B0); PG8_BAR; PG8_SCHED;
            PG8_STAGE(PG8_SB(1, 1), b3 + hstep, voffB);
            PG8_WAIT_V(6); PG8_BAR; PG8_MMA(1, 1, At, B1); PG8_BAR;
            }
        }
        if constexpr (ALIGN_EPI) { if (wr == 0) PG8_BAR; }
        if constexpr (!Epi::AFTER_DRAIN) { E(acc, cur, wr, wc, fr, fq); S.done(cur); }
        if (!has_next) break;
#pragma unroll
        for (int a = 0; a < 2; ++a)
#pragma unroll
            for (int b = 0; b < 2; ++b)
#pragma unroll
                for (int m = 0; m < 4; ++m)
#pragma unroll
                    for (int n = 0; n < 2; ++n) acc[a][b][m][n] = (f32x4){0.f, 0.f, 0.f, 0.f};
        cur = nxt; cA = nA; cB = nB; ++ui;
        if constexpr (ALIGN_EPI) { if (wr == 1) PG8_BAR; }
    }
    PG8_WAIT_V(0);
    if constexpr (!ALIGN_EPI) { if (wr == 0) PG8_BAR; }
    PG8_BAR;
    if constexpr (Epi::AFTER_DRAIN) { E.fused(acc, cur, wr, wc, fr, fq, lds, wid, lane); S.done(cur); }
#undef PG8_SA
#undef PG8_SB
#undef PG8_STAGE
#undef PG8_LDA
#undef PG8_LDB
#undef PG8_MMA
#undef PG8_WAIT_V
#undef PG8_WAIT_L
#undef PG8_BAR
#undef PG8_SCHED
}
}

__device__ __forceinline__ int olane() { int l; asm volatile("v_mbcnt_lo_u32_b32 %0, -1, 0\n\tv_mbcnt_hi_u32_b32 %0, -1, %0" : "=v"(l)); return l; }
__device__ __forceinline__ int otid(int wv) { return wv * 64 + olane(); }
__device__ __forceinline__ int obid() { int b = blockIdx.x; asm volatile("" : "+s"(b)); return b; }
__device__ __forceinline__ int ogrid() { int g = gridDim.x; asm volatile("" : "+s"(g)); return g; }
__device__ __forceinline__ unsigned f2bf(float f) { unsigned u = __builtin_bit_cast(unsigned, f); return (u + 0x7fffu + ((u >> 16) & 1u)) >> 16; }
__device__ __forceinline__ unsigned pk2(float lo, float hi) { return f2bf(lo) | (f2bf(hi) << 16); }
__device__ __forceinline__ float bf2f(unsigned b) { return __builtin_bit_cast(float, b << 16); }

__device__ __forceinline__ void transpose_item(const float* W, int ld, int K, int N, bf16* WT, int map, int drow0, const float* gk, LAS float* scr, int item, int lane) {
    const int nblk = N / 32, kb = item / nblk, nb = item % nblk, k0 = 64 * kb, n0 = 32 * nb;
    int drow;
    if (map == 1) { const int hd = n0 / 96, d = n0 % 96; drow = (d < 64) ? hd * 64 + d : 1024 + hd * 32 + (d - 64); }
    else if (map == 2) { const int hd = n0 / 128, d = n0 % 128; drow = (d < 64) ? hd * 64 + d : 1024 + hd * 64 + (d - 64); }
    else drow = drow0 + n0;
    { const int kr = lane >> 3, c4 = lane & 7; f32x4 t[8];
#pragma unroll
      for (int i = 0; i < 8; ++i) t[i] = *(const f32x4*)(W + (size_t)(k0 + 8 * i + kr) * ld + n0 + 4 * c4);
#pragma unroll
      for (int i = 0; i < 8; ++i) { const int kk = 8 * i + kr; f32x4 v = t[i]; if (gk) v = v * gk[k0 + kk];
          LAS float* d = scr + kk * 33 + 4 * c4; d[0] = v[0]; d[1] = v[1]; d[2] = v[2]; d[3] = v[3]; } }
    asm volatile("s_waitcnt lgkmcnt(0)" ::: "memory");
    const int c = lane & 7;
#pragma unroll
    for (int j = 0; j < 4; ++j) { const int n = (lane >> 3) + 8 * j; const LAS float* s = scr + (8 * c) * 33 + n;
        u32x4 o; o.x = pk2(s[0 * 33], s[1 * 33]); o.y = pk2(s[2 * 33], s[3 * 33]); o.z = pk2(s[4 * 33], s[5 * 33]); o.w = pk2(s[6 * 33], s[7 * 33]);
        *(u32x4*)(WT + (size_t)(drow + n) * K + k0 + 8 * c) = o; }
    asm volatile("s_waitcnt lgkmcnt(0)" ::: "memory");
}

struct Params { const float* in[20]; float* out; unsigned char* ws; };
enum { I_X = 0, I_C, I_POS, I_ADAW, I_ADAB, I_GMIX, I_GMLP, I_FWIN, I_FBF, I_FWOUT, I_MDQ, I_MQG, I_MUQ, I_MDKV, I_MKVG, I_MUKV, I_MOUT, I_W1, I_W2, I_GFIN };

__device__ __forceinline__ void prologue(const Params& p, LAS unsigned char* lds, const int wv_) {
    const int BID = obid(), GSZ = ogrid(); const int tid_ = otid(wv_);
    const int tid = tid_, lane = tid & 63, wave = __builtin_amdgcn_readfirstlane(tid >> 6);
    unsigned char* ws = p.ws;
    {
        LAS float* cact = (LAS float*)lds;
        LAS float* part = (LAS float*)(lds + 65536);
        const float* c = p.in[I_C];
        for (int idx = tid; idx < NB * DM; idx += NTHR) { const int b = idx >> 10, k = idx & 1023; const float v = c[idx]; cact[k * 16 + b] = v / (1.0f + __expf(-v)); }
        __syncthreads();
        float* mod = (float*)(ws + WS_MOD);
        for (int item = BID; item < 4 * 48; item += GSZ) {
            const int l = item / 48, n0 = (item % 48) * 128, col = tid & 127, ks = tid >> 7;
            float acc[16];
#pragma unroll
            for (int b = 0; b < 16; ++b) acc[b] = 0.f;
            const float* wp = p.in[I_ADAW] + ((size_t)l * DM + ks * 256) * 6144 + n0 + col;
            const LAS f32x4* cp = (const LAS f32x4*)(cact + ks * 256 * 16);
#pragma unroll 8
            for (int k = 0; k < 256; ++k) { const float w = wp[(size_t)k * 6144];
                const f32x4 c0 = cp[k * 4 + 0], c1 = cp[k * 4 + 1], c2 = cp[k * 4 + 2], c3 = cp[k * 4 + 3];
                acc[0] += w * c0[0]; acc[1] += w * c0[1]; acc[2] += w * c0[2]; acc[3] += w * c0[3];
                acc[4] += w * c1[0]; acc[5] += w * c1[1]; acc[6] += w * c1[2]; acc[7] += w * c1[3];
                acc[8] += w * c2[0]; acc[9] += w * c2[1]; acc[10] += w * c2[2]; acc[11] += w * c2[3];
                acc[12] += w * c3[0]; acc[13] += w * c3[1]; acc[14] += w * c3[2]; acc[15] += w * c3[3]; }
#pragma unroll
            for (int b = 0; b < 16; ++b) part[(ks * 16 + b) * 128 + col] = acc[b];
            __syncthreads();
            for (int o = tid; o < 2048; o += NTHR) { const int b = o >> 7, cc = o & 127;
                const float s = (part[(0 * 16 + b) * 128 + cc] + part[(1 * 16 + b) * 128 + cc]) + (part[(2 * 16 + b) * 128 + cc] + part[(3 * 16 + b) * 128 + cc]);
                mod[((size_t)l * 16 + b) * 6144 + n0 + cc] = s + p.in[I_ADAB][(size_t)l * 6144 + n0 + cc]; }
            __syncthreads();
        }
    }
    __syncthreads();
    {
        const int* pos = (const int*)p.in[I_POS]; float* cst = (float*)(ws + WS_CS);
        for (size_t idx = (size_t)BID * NTHR + tid; idx < (size_t)M * 16; idx += (size_t)GSZ * NTHR) {
            const int tok = (int)(idx >> 4), i = (int)(idx & 15);
            const float invf = exp2f(-(float)i * (13.287712379549449f / 16.0f));
            const float ang = (float)pos[tok] * invf;
            double rev = (double)ang * 0.15915494309189535; rev -= __builtin_rint(rev);
            const float rf = (float)rev;
            cst[(size_t)tok * 32 + i] = __builtin_amdgcn_cosf(rf); cst[(size_t)tok * 32 + 16 + i] = __builtin_amdgcn_sinf(rf);
        }
    }
    for (int j = 0; j < 2; ++j) { u32x4* z = (u32x4*)(ws + WS_W + W_MLA + j * W_MLA_STRIDE + (size_t)416 * 1024 * 2);
        for (int idx = BID * NTHR + tid; idx < 96 * 1024 * 2 / 16; idx += GSZ * NTHR) z[idx] = (u32x4){0u, 0u, 0u, 0u}; }
    {
        LAS float* scr = (LAS float*)(lds + wave * 16384);
        const int gw = BID * NWAVE + wave, NGW = GSZ * NWAVE;
        constexpr int N_MLP = 4 * 4096, N_FOX = 2 * 2048, N_MLA = 2 * 1040;
        for (int it = gw; it < N_MLP + N_FOX + N_MLA; it += NGW) {
            int r = it;
            if (r < N_MLP) { const int l = r >> 12, rr = r & 4095; bf16* wb = (bf16*)(ws + WS_W + W_MLP + (size_t)l * W_MLP_STRIDE);
                if (rr < 2048) transpose_item(p.in[I_W1] + (size_t)l * DM * FF, FF, DM, FF, wb, 0, 0, nullptr, scr, rr, lane);
                else transpose_item(p.in[I_W2] + (size_t)l * DM * FF, DM, FF, DM, wb + (size_t)FF * DM, 0, 0, nullptr, scr, rr - 2048, lane);
                continue; }
            r -= N_MLP;
            if (r < N_FOX) { const int j = r >> 11, rr = r & 2047; bf16* wb = (bf16*)(ws + WS_W + W_FOX + (size_t)j * W_FOX_STRIDE);
                if (rr < 1536) transpose_item(p.in[I_FWIN] + (size_t)j * DM * 3088, 3088, DM, 3072, wb, 0, 0, nullptr, scr, rr, lane);
                else transpose_item(p.in[I_FWOUT] + (size_t)j * DM * DM, DM, DM, DM, wb + (size_t)3072 * DM, 0, 0, nullptr, scr, rr - 1536, lane);
                continue; }
            r -= N_FOX;
            { const int j = r / 1040, rr = r % 1040; bf16* wb = (bf16*)(ws + WS_W + W_MLA + (size_t)j * W_MLA_STRIDE);
                if (rr < 128) transpose_item(p.in[I_MDQ] + (size_t)j * DM * 256, 256, DM, 256, wb, 0, 0, nullptr, scr, rr, lane);
                else if (rr < 208) transpose_item(p.in[I_MDKV] + (size_t)j * DM * 160, 160, DM, 160, wb, 0, 256, nullptr, scr, rr - 128, lane);
                else if (rr < 400) transpose_item(p.in[I_MUQ] + (size_t)j * 256 * 1536, 1536, 256, 1536, wb + (size_t)512 * 1024, 1, 0, p.in[I_MQG] + j * 256, scr, rr - 208, lane);
                else if (rr < 528) transpose_item(p.in[I_MUKV] + (size_t)j * 128 * 2048, 2048, 128, 2048, wb + (size_t)512 * 1024 + (size_t)1536 * 256, 2, 0, p.in[I_MKVG] + j * 128, scr, rr - 400, lane);
                else transpose_item(p.in[I_MOUT] + (size_t)j * DM * DM, DM, DM, DM, (bf16*)((unsigned char*)wb + 3 * MiB), 0, 0, nullptr, scr, rr - 528, lane);
            }
        }
    }
}

template <int NR, bool gates>
__device__ __forceinline__ void norm_phase(const void* xv, const bool xbf, const float* g, const float* sh0, const float* sc0, bf16* hout, const float* wfsrc, const float* bfv, float* lf, LAS unsigned char* lds, const int wv_) {
    const int BID = obid(), GSZ = ogrid(); const int tid_ = otid(wv_);
    const int tid = tid_, lane = tid & 63, wave = __builtin_amdgcn_readfirstlane(tid >> 6);
    LAS float* wfs = (LAS float*)lds;
    if constexpr (gates) {
        for (int idx = tid; idx < 16 * 1024; idx += NTHR) { const int k = idx >> 4, j = idx & 15; wfs[j * 1024 + k] = wfsrc[(size_t)k * 3088 + 3072 + j]; }
        __syncthreads();
    }
    const int gw = BID * NWAVE + wave, NGW = GSZ * NWAVE;
    for (int row0 = gw * NR; row0 < M; row0 += NGW * NR) {
        const int b = row0 >> 11;
        f32x4 v[NR][4]; float ss[NR];
        if (xbf) {
#pragma unroll
            for (int r = 0; r < NR; ++r) { const u32x2* xr = (const u32x2*)((const bf16*)xv + (size_t)(row0 + r) * DM) + lane;
#pragma unroll
                for (int j = 0; j < 4; ++j) { const u32x2 w = xr[64 * j];
                    v[r][j] = (f32x4){__builtin_bit_cast(float, w.x << 16), __builtin_bit_cast(float, w.x & 0xffff0000u), __builtin_bit_cast(float, w.y << 16), __builtin_bit_cast(float, w.y & 0xffff0000u)}; } }
        } else {
#pragma unroll
            for (int r = 0; r < NR; ++r) { const f32x4* xr = (const f32x4*)((const float*)xv + (size_t)(row0 + r) * DM) + lane;
#pragma unroll
                for (int j = 0; j < 4; ++j) v[r][j] = xr[64 * j]; }
        }
#pragma unroll
        for (int r = 0; r < NR; ++r) { float s = 0.f;
#pragma unroll
            for (int j = 0; j < 4; ++j) s += (v[r][j][0] * v[r][j][0] + v[r][j][1] * v[r][j][1]) + (v[r][j][2] * v[r][j][2] + v[r][j][3] * v[r][j][3]);
            ss[r] = s; }
#pragma unroll
        for (int r = 0; r < NR; ++r) ss[r] = wave_sum(ss[r]);
        const f32x4* gp = (const f32x4*)g + lane; const f32x4* shp = (const f32x4*)(sh0 + (size_t)b * 6144) + lane; const f32x4* scp = (const f32x4*)(sc0 + (size_t)b * 6144) + lane;
#pragma unroll
        for (int j = 0; j < 4; ++j) { const f32x4 aa = gp[64 * j] * (scp[64 * j] + 1.0f), sh = shp[64 * j];
#pragma unroll
            for (int r = 0; r < NR; ++r) { const float rstd = __builtin_amdgcn_rsqf(ss[r] * (1.0f / DM) + EPS);
                v[r][j] = (v[r][j] * rstd) * aa + sh;
                u32x2 w; w.x = pk2(v[r][j][0], v[r][j][1]); w.y = pk2(v[r][j][2], v[r][j][3]); ((u32x2*)(hout + (size_t)(row0 + r) * DM) + lane)[64 * j] = w; } }
        if constexpr (gates) {
            static_assert(NR == 2, "the gate path pairs two rows in f32x2");
            f32x2 vv[4][4], z[16];
#pragma unroll
            for (int jj = 0; jj < 4; ++jj)
#pragma unroll
                for (int e = 0; e < 4; ++e) vv[jj][e] = (f32x2){v[0][jj][e], v[1][jj][e]};
#pragma unroll
            for (int jg = 0; jg < 16; ++jg) {
                f32x2 acc = (f32x2){0.f, 0.f};
#pragma unroll
                for (int jj = 0; jj < 4; ++jj) { const f32x4 w = *(const LAS f32x4*)(wfs + jg * 1024 + 256 * jj + 4 * lane);
                    acc += (vv[jj][0] * w[0] + vv[jj][1] * w[1]) + (vv[jj][2] * w[2] + vv[jj][3] * w[3]); }
                z[jg] = acc;
                if (jg & 1) asm volatile("" ::: "memory"); }
            const bool b5 = (lane & 32) != 0, b4 = (lane & 16) != 0, b3 = (lane & 8) != 0, b2 = (lane & 4) != 0;
            f32x2 a8[8], a4[4], a2[2], a1;
#pragma unroll
            for (int i = 0; i < 8; ++i) { const f32x2 send = b5 ? z[i] : z[i + 8], keep = b5 ? z[i + 8] : z[i]; a8[i] = keep + (f32x2){xor_get<32>(send[0], b5), xor_get<32>(send[1], b5)}; }
#pragma unroll
            for (int i = 0; i < 4; ++i) { const f32x2 send = b4 ? a8[i] : a8[i + 4], keep = b4 ? a8[i + 4] : a8[i]; a4[i] = keep + (f32x2){xor_get<16>(send[0], b4), xor_get<16>(send[1], b4)}; }
#pragma unroll
            for (int i = 0; i < 2; ++i) { const f32x2 send = b3 ? a4[i] : a4[i + 2], keep = b3 ? a4[i + 2] : a4[i]; a2[i] = keep + (f32x2){xor_get<8>(send[0], b3), xor_get<8>(send[1], b3)}; }
            { const f32x2 send = b2 ? a2[0] : a2[1], keep = b2 ? a2[1] : a2[0]; a1 = keep + (f32x2){xor_get<4>(send[0], b2), xor_get<4>(send[1], b2)}; }
            a1 = (f32x2){xor_sum<2>(a1[0]), xor_sum<2>(a1[1])}; a1 = (f32x2){xor_sum<1>(a1[0]), xor_sum<1>(a1[1])};
            const int gate = (b5 ? 8 : 0) + (b4 ? 4 : 0) + (b3 ? 2 : 0) + (b2 ? 1 : 0);
            if ((lane & 3) == 0) { const float bb = bfv[gate];
#pragma unroll
                for (int r = 0; r < NR; ++r) { const float zz = a1[r] + bb; lf[(size_t)(row0 + r) * 16 + gate] = fminf(zz, 0.f) - __logf(1.0f + __expf(-fabsf(zz))); } }
        }
    }
}

__device__ __forceinline__ void final_norm(const bf16* xb, float* out, const float* g, const int wv_) {
    constexpr int NR = 4;
    const int BID = obid(), GSZ = ogrid(); const int tid_ = otid(wv_);
    const int tid = tid_, lane = tid & 63, wave = __builtin_amdgcn_readfirstlane(tid >> 6);
    const int gw = BID * NWAVE + wave, NGW = GSZ * NWAVE;
    for (int row0 = gw * NR; row0 < M; row0 += NGW * NR) {
        f32x4 v[NR][4]; float ss[NR];
#pragma unroll
        for (int r = 0; r < NR; ++r) { const u32x2* xr = (const u32x2*)(xb + (size_t)(row0 + r) * DM) + lane;
#pragma unroll
            for (int j = 0; j < 4; ++j) { const u32x2 w = xr[64 * j];
                v[r][j] = (f32x4){__builtin_bit_cast(float, w.x << 16), __builtin_bit_cast(float, w.x & 0xffff0000u), __builtin_bit_cast(float, w.y << 16), __builtin_bit_cast(float, w.y & 0xffff0000u)}; } }
#pragma unroll
        for (int r = 0; r < NR; ++r) { float s = 0.f;
#pragma unroll
            for (int j = 0; j < 4; ++j) s += (v[r][j][0] * v[r][j][0] + v[r][j][1] * v[r][j][1]) + (v[r][j][2] * v[r][j][2] + v[r][j][3] * v[r][j][3]);
            ss[r] = wave_sum(s); }
        const f32x4* gp = (const f32x4*)g + lane;
#pragma unroll
        for (int j = 0; j < 4; ++j) { const f32x4 gg = gp[64 * j];
#pragma unroll
            for (int r = 0; r < NR; ++r) { const float rstd = __builtin_amdgcn_rsqf(ss[r] * (1.0f / DM) + EPS); ((f32x4*)(out + (size_t)(row0 + r) * DM) + lane)[64 * j] = (v[r][j] * rstd) * gg; } }
    }
}

__device__ __forceinline__ void fox_cumsum(const float* lf, bf16* Qb, bf16* Kb, LAS unsigned char* lds, const int wv_) {
    const int BID = obid(), GSZ = ogrid(); const int tid_ = otid(wv_);
    const int tid = tid_, lane = tid & 63, wave = __builtin_amdgcn_readfirstlane(tid >> 6);
    LAS float* wtot = (LAS float*)lds;
    for (int bh = BID; bh < NB * NH; bh += GSZ) {
        const int b = bh >> 4, h = bh & 15; const int s0 = 4 * tid;
        float a[4];
#pragma unroll
        for (int i = 0; i < 4; ++i) a[i] = lf[((size_t)(b * SEQ + s0 + i)) * 16 + h];
        a[1] += a[0]; a[2] += a[1]; a[3] += a[2];
        float xs = a[3];
#pragma unroll
        for (int off = 1; off < 64; off <<= 1) { const float t = __shfl_up(xs, off); if (lane >= off) xs += t; }
        if (lane == 63) wtot[wave] = xs;
        __syncthreads();
        float base = 0.f;
#pragma unroll
        for (int w = 0; w < NWAVE; ++w) { const float t = wtot[w]; if (w < wave) base += t; }
        const float excl = xs - a[3] + base;
#pragma unroll
        for (int i = 0; i < 4; ++i) {
            const float F = (a[i] + excl) * LOG2E;
            const unsigned fh = f2bf(F); const float r1 = F - bf2f(fh); const unsigned fm = f2bf(r1); const float r2 = r1 - bf2f(fm); const unsigned fl = f2bf(r2);
            const size_t tok = (size_t)(b * SEQ + s0 + i);
            u32x4* qd = (u32x4*)(Qb + tok * 1280 + h * 80 + 64); u32x4* kd = (u32x4*)(Kb + tok * 1280 + h * 80 + 64);
            unsigned zz = 0u; asm volatile("" : "+v"(zz));
            qd[0] = (u32x4){0x3F803F80u, 0x3F80u | (fh << 16), fm | (fl << 16), zz}; qd[1] = (u32x4){zz, zz, zz, zz};
            kd[0] = (u32x4){(fh ^ 0x8000u) | ((fm ^ 0x8000u) << 16), (fl ^ 0x8000u) | (0x3F80u << 16), 0x3F803F80u, zz}; kd[1] = (u32x4){zz, zz, zz, zz};
        }
        __syncthreads();
    }
}

constexpr int PTR_OFF = 131072;
__device__ __forceinline__ int crow(int r, int hi) { return (r & 3) + 8 * (r >> 2) + 4 * hi; }
__device__ __forceinline__ unsigned cvtpk(float lo, float hi) { typedef __bf16 bf16x2_t __attribute__((ext_vector_type(2))); f32x2 v = {lo, hi}; bf16x2_t b = __builtin_convertvector(v, bf16x2_t); return __builtin_bit_cast(unsigned, b); }
typedef short v4i16_t __attribute__((ext_vector_type(4)));
__device__ __forceinline__ s16x4 vtr(const LAS unsigned char* p) { return __builtin_bit_cast(s16x4, __builtin_amdgcn_ds_read_tr16_b64_v4i16((LAS v4i16_t*)p)); }
#define MFMA32(a, b, c) __builtin_amdgcn_mfma_f32_32x32x16_bf16((a), (b), (c), 0, 0, 0)

template <int NKS>
__device__ __forceinline__ void attn_phase(LAS unsigned char* lds, const bf16* Q_, const bf16* K_, const bf16* V_, bf16* O_, const int wv_) {
    constexpr int QKD = 16 * NKS, QP = 16 * QKD, RS = QKD * 2 + 16, KCH = QKD / 8, NKC = 64 * KCH;
    constexpr int KB_BYTES = 64 * RS, L_K = 0, L_V = 2 * KB_BYTES, L_WS = L_V + 2 * 8192, L_ST = L_WS + NWAVE * 128;
    constexpr float THR = 20.0f;
    static_assert(L_ST + NWAVE * 4096 <= PTR_OFF, "attention LDS");
    typedef __attribute__((address_space(1))) const bf16 gcb; typedef __attribute__((address_space(1))) bf16 gb;
    gcb* Q = (gcb*)Q_; gcb* K = (gcb*)K_; gcb* V = (gcb*)V_; gb* O = (gb*)O_;
    const int BID = obid(), GSZ = ogrid(); const int tid_ = otid(wv_);
    const int tid = tid_, lane = tid & 63, r32 = lane & 31, hi = lane >> 5; const int wid = __builtin_amdgcn_readfirstlane(tid >> 6);
    LAS float* wsf = (LAS float*)(lds + L_WS) + wid * 32;
    LAS bf16* stg = (LAS bf16*)(lds + L_ST) + wid * 2048;
    constexpr int KCP = KCH + 1, NCHK = 64 * KCP; static_assert(NCHK % 64 == 0 && NCHK <= 1024, "K image is a whole number of 1 KiB pieces");
    const bool has1 = (wid + 8) * 64 < NCHK;
    const int ca = wid * 64 + lane, cb = has1 ? ca + 512 : ca;
    const unsigned kgo0 = (unsigned)((ca / KCP) * QP + ((ca % KCP) < KCH ? (ca % KCP) : 0) * 8), kgo1 = (unsigned)((cb / KCP) * QP + ((cb % KCP) < KCH ? (cb % KCP) : 0) * 8);
    const int vr = ca >> 3, vp = ca & 7; const unsigned vgo = (unsigned)(vr * DM + ((((vp >> 2) ^ ((vr >> 1) & 1)) << 2) | (vp & 3)) * 8);
    const int kd0 = wid * 1024, kd1 = (wid + 8) * 1024, vd = wid * 1024;
    const int kfb = r32 * RS + hi * 16;
    const int i16 = lane & 15, qq = i16 >> 2, pp = i16 & 3, blk = (lane >> 4) & 1, swz = (qq >> 1) & 1;
    const int vfb0 = (4 * hi + qq) * 128 + 32 * blk + 8 * pp + swz * 64, vfb1 = (4 * hi + qq) * 128 + 32 * blk + 8 * pp + (swz ^ 1) * 64;
#define A_GLDS(GP, LOFF) do { unsigned keep_; const unsigned ldst_ = (unsigned)__builtin_amdgcn_readfirstlane((int)(unsigned)(size_t)(lds + (LOFF))); \
        asm volatile("s_mov_b32 %0, m0\n\ts_mov_b32 m0, %2\n\ts_nop 0\n\tglobal_load_lds_dwordx4 %1, off\n\ts_mov_b32 m0, %0" : "=&s"(keep_) : "v"(GP), "s"(ldst_) : "memory"); } while (0)
#define A_DMAK(t, buf) do { gcb* Kt_ = Kh + (size_t)((unsigned)(t) * 64u) * QP; asm volatile("" : "+s"(Kt_)); A_GLDS(Kt_ + kgo0, L_K + (buf) * KB_BYTES + kd0); \
        if (has1) A_GLDS(Kt_ + kgo1, L_K + (buf) * KB_BYTES + kd1); } while (0)
#define A_DMAV(t, buf) do { gcb* Vt_ = Vh + (size_t)((unsigned)(t) * 64u) * DM; asm volatile("" : "+s"(Vt_)); A_GLDS(Vt_ + vgo, L_V + (buf) * 8192 + vd); } while (0)
#define A_DMAWAIT() asm volatile("s_waitcnt vmcnt(0)" ::: "memory")
#define A_QK(P0, P1, buf, CINIT) do { const LAS unsigned char* Kl_ = lds + L_K + (buf) * KB_BYTES + kfb; \
        bf16x8 a0_ = *(const LAS bf16x8*)(Kl_), a1_ = *(const LAS bf16x8*)(Kl_ + 32 * RS); \
        _Pragma("unroll") for (int ks = 0; ks < NKS; ++ks) { bf16x8 n0_ = a0_, n1_ = a1_; \
            if (ks + 1 < NKS) { n0_ = *(const LAS bf16x8*)(Kl_ + (ks + 1) * 32); n1_ = *(const LAS bf16x8*)(Kl_ + 32 * RS + (ks + 1) * 32); } \
            if (ks == 0) { P0 = MFMA32(a0_, qr[0], CINIT); P1 = MFMA32(a1_, qr[0], CINIT); } else { P0 = MFMA32(a0_, qr[ks], P0); P1 = MFMA32(a1_, qr[ks], P1); } \
            a0_ = n0_; a1_ = n1_; } } while (0)
#define A_VRD(kk, L0, H0, L1, H1) do { L0 = vtr(Vl_ + vfb0 + (kk) * 2048); H0 = vtr(Vl_ + vfb0 + (kk) * 2048 + 1024); L1 = vtr(Vl_ + vfb1 + (kk) * 2048); H1 = vtr(Vl_ + vfb1 + (kk) * 2048 + 1024); } while (0)
#define A_PV(buf) do { const LAS unsigned char* Vl_ = lds + L_V + (buf) * 8192; s16x4 l0_, h0_, l1_, h1_; A_VRD(0, l0_, h0_, l1_, h1_); \
        _Pragma("unroll") for (int kk = 0; kk < 4; ++kk) { s16x4 nl0_ = l0_, nh0_ = h0_, nl1_ = l1_, nh1_ = h1_; \
            if (kk + 1 < 4) A_VRD(kk + 1, nl0_, nh0_, nl1_, nh1_); \
            const bf16x8 b0_ = (bf16x8){l0_[0], l0_[1], l0_[2], l0_[3], h0_[0], h0_[1], h0_[2], h0_[3]}, b1_ = (bf16x8){l1_[0], l1_[1], l1_[2], l1_[3], h1_[0], h1_[1], h1_[2], h1_[3]}; \
            o0 = MFMA32(PAp[kk], b0_, o0); o1 = MFMA32(PAp[kk], b1_, o1); \
            l0_ = nl0_; h0_ = nh0_; l1_ = nl1_; h1_ = nh1_; } } while (0)
#define A_MASK(t) do { const int kb0_ = 64 * (t) + 4 * hi; \
        _Pragma("unroll") for (int i = 0; i < 16; ++i) { const int kv_ = kb0_ + (i & 3) + 8 * (i >> 2); if (kv_ > qabs) pc0[i] = -INFINITY; if (kv_ + 32 > qabs) pc1[i] = -INFINITY; } } while (0)
#define A_ROWMAX(RM) do { float a_ = __builtin_fmaxf(__builtin_fmaxf(pc0[0], pc0[1]), pc1[0]), b_ = __builtin_fmaxf(__builtin_fmaxf(pc0[2], pc0[3]), pc1[1]); a_ = __builtin_fmaxf(__builtin_fmaxf(a_, pc1[2]), pc1[3]); \
        _Pragma("unroll") for (int r = 4; r < 16; r += 4) { a_ = __builtin_fmaxf(__builtin_fmaxf(a_, pc0[r]), pc0[r + 1]); b_ = __builtin_fmaxf(__builtin_fmaxf(b_, pc0[r + 2]), pc0[r + 3]); \
            a_ = __builtin_fmaxf(__builtin_fmaxf(a_, pc1[r]), pc1[r + 1]); b_ = __builtin_fmaxf(__builtin_fmaxf(b_, pc1[r + 2]), pc1[r + 3]); } \
        RM = __builtin_fmaxf(a_, b_); { auto rr_ = __builtin_amdgcn_permlane32_swap(__float_as_uint(RM), __float_as_uint(RM), false, false); RM = __builtin_fmaxf(__uint_as_float(rr_[0]), __uint_as_float(rr_[1])); } } while (0)
#define A_EXPPACK() do { float ls_ = 0.f; \
        _Pragma("unroll") for (int i = 0; i < 16; ++i) { pc0[i] = __builtin_amdgcn_exp2f(pc0[i]); pc1[i] = __builtin_amdgcn_exp2f(pc1[i]); ls_ += pc0[i] + pc1[i]; } \
        lrow += ls_; u32x4 w_; \
        w_ = (u32x4){cvtpk(pc0[0], pc0[1]), cvtpk(pc0[2], pc0[3]), cvtpk(pc0[4], pc0[5]), cvtpk(pc0[6], pc0[7])}; PAc[0] = __builtin_bit_cast(bf16x8, w_); \
        w_ = (u32x4){cvtpk(pc0[8], pc0[9]), cvtpk(pc0[10], pc0[11]), cvtpk(pc0[12], pc0[13]), cvtpk(pc0[14], pc0[15])}; PAc[1] = __builtin_bit_cast(bf16x8, w_); \
        w_ = (u32x4){cvtpk(pc1[0], pc1[1]), cvtpk(pc1[2], pc1[3]), cvtpk(pc1[4], pc1[5]), cvtpk(pc1[6], pc1[7])}; PAc[2] = __builtin_bit_cast(bf16x8, w_); \
        w_ = (u32x4){cvtpk(pc1[8], pc1[9]), cvtpk(pc1[10], pc1[11]), cvtpk(pc1[12], pc1[13]), cvtpk(pc1[14], pc1[15])}; PAc[3] = __builtin_bit_cast(bf16x8, w_); } while (0)
#define A_VALU(t, BAND) do { if (BAND) A_MASK(t); float rm_; A_ROWMAX(rm_); rm_ -= mrow; upd = __any(rm_ > THR); \
        if (upd) { const float dl_ = __builtin_fmaxf(rm_, 0.f); mrow += dl_; \
            fsc = __builtin_amdgcn_exp2f(-dl_); lrow *= fsc; } \
        _Pragma("unroll") for (int i = 0; i < 16; ++i) { pc0[i] -= mrow; pc1[i] -= mrow; } \
        A_EXPPACK(); } while (0)
#define A_KRD(ks) do { kf_[2 * (ks)] = *(const LAS bf16x8*)(Kl_ + (ks) * 32); kf_[2 * (ks) + 1] = *(const LAS bf16x8*)(Kl_ + 32 * RS + (ks) * 32); } while (0)
#define A_MFMA(t, DOQK, DOPV) do { const LAS unsigned char* Kl_ = lds + L_K + (((t) + 1) & 1) * KB_BYTES + kfb; const LAS unsigned char* Vl_ = lds + L_V + (((t) - 1) & 1) * 8192; \
        s16x4 vl0_[4], vh0_[4], vl1_[4], vh1_[4]; \
        if (DOQK) { bf16x8 kf_[2 * NKS]; \
            A_KRD(0); A_KRD(1); \
            __builtin_amdgcn_sched_barrier(0); \
            _Pragma("unroll") for (int ks = 0; ks < NKS; ++ks) { \
                if (ks == 0) { pn0 = MFMA32(kf_[0], qr[0], ((f32x16)(0.0f))); pn1 = MFMA32(kf_[1], qr[0], ((f32x16)(0.0f))); } \
                else { pn0 = MFMA32(kf_[2 * ks], qr[ks], pn0); pn1 = MFMA32(kf_[2 * ks + 1], qr[ks], pn1); } \
                if (ks + 2 < NKS) A_KRD(ks + 2); \
                if (ks >= NKS - 2) A_VRD(ks - (NKS - 2), vl0_[ks - (NKS - 2)], vh0_[ks - (NKS - 2)], vl1_[ks - (NKS - 2)], vh1_[ks - (NKS - 2)]); \
                __builtin_amdgcn_sched_barrier(0); } } \
        else if (DOPV) { A_VRD(0, vl0_[0], vh0_[0], vl1_[0], vh1_[0]); A_VRD(1, vl0_[1], vh0_[1], vl1_[1], vh1_[1]); } \
        if (DOPV) { \
            _Pragma("unroll") for (int kk = 0; kk < 4; ++kk) { \
                const bf16x8 b0_ = (bf16x8){vl0_[kk][0], vl0_[kk][1], vl0_[kk][2], vl0_[kk][3], vh0_[kk][0], vh0_[kk][1], vh0_[kk][2], vh0_[kk][3]}; \
                const bf16x8 b1_ = (bf16x8){vl1_[kk][0], vl1_[kk][1], vl1_[kk][2], vl1_[kk][3], vh1_[kk][0], vh1_[kk][1], vh1_[kk][2], vh1_[kk][3]}; \
                o0 = MFMA32(PAp[kk], b0_, o0); o1 = MFMA32(PAp[kk], b1_, o1); \
                if (kk + 2 < 4) A_VRD(kk + 2, vl0_[kk + 2], vh0_[kk + 2], vl1_[kk + 2], vh1_[kk + 2]); \
                __builtin_amdgcn_sched_barrier(0); } } } while (0)
    const bool teamed = (GSZ == 256);
    const int xcd = BID & 7, slot = BID >> 3, team = slot >> 3, mem = slot & 7;
#ifdef PROBE_AT
    unsigned long long pacc = 0, pt0 = 0;
#define PT_BEG(C) do { if (PROBE_AT == (C)) pt0 = __builtin_amdgcn_s_memtime(); } while (0)
#define PT_END(C) do { if (PROBE_AT == (C)) pacc += __builtin_amdgcn_s_memtime() - pt0; } while (0)
#else
#define PT_BEG(C) do {} while (0)
#define PT_END(C) do {} while (0)
#endif
    const int nit = teamed ? 8 : 8 * ((NB * NH - BID + GSZ - 1) / GSZ);
#define A_UNIT(i, BH, QB) do { if (teamed) { BH = (xcd * 4 + team) * 8 + (i); QB = (mem + (i)) & 7; } else { BH = BID + ((i) >> 3) * GSZ; QB = 7 - ((i) & 7); } } while (0)
    bf16x8 qr[NKS];
#define A_PREFETCH(i) do { int bh_, qb_; A_UNIT(i, bh_, qb_); const size_t rb_ = (size_t)(bh_ >> 4) * SEQ; const int h_ = bh_ & 15; \
        gcb* Kh = K + rb_ * QP + h_ * QKD; gcb* Vh = V + rb_ * DM + h_ * 64; gcb* Qu_ = Q + (rb_ + qb_ * 256 + wid * 32) * QP + h_ * QKD; \
        unsigned qgo_; { int lq = lane; asm volatile("" : "+v"(lq)); qgo_ = (unsigned)((lq & 31) * QP + (lq >> 5) * 8); } \
        _Pragma("unroll") for (int ks = 0; ks < NKS; ++ks) qr[ks] = *(const __attribute__((address_space(1))) bf16x8*)(Qu_ + qgo_ + ks * 16); \
        A_DMAK(0, 0); A_DMAV(0, 0); A_DMAK(1, 1); } while (0)
    if (nit > 0) A_PREFETCH(0);
    for (int it = 0; it < nit; ++it) {
        int bh, qb; A_UNIT(it, bh, qb);
        const int b = bh >> 4, h = bh & 15; const size_t rowbase = (size_t)b * SEQ;
        gcb* Kh = K + rowbase * QP + h * QKD; gcb* Vh = V + rowbase * DM + h * 64;
        {
            const int q0 = qb * 256; const int NT = 4 * qb + 4;
            PT_BEG('U');
            const int qabs = q0 + wid * 32 + r32; const int Tw = 4 * qb + (wid >> 1);
            A_DMAWAIT(); __syncthreads();
            f32x16 pc0, pc1, pn0, pn1, o0 = (f32x16)(0.0f), o1 = (f32x16)(0.0f);
            A_QK(pc0, pc1, 0, ((f32x16)(0.0f))); A_QK(pn0, pn1, 1, ((f32x16)(0.0f)));
            bf16x8 PAp[4], PAc[4]; float mrow, lrow = 0.f, fsc = 1.f; bool upd = false;
            { if (NT == 4) A_MASK(0);
              float rm_; A_ROWMAX(rm_); mrow = rm_;
#pragma unroll
              for (int i = 0; i < 16; ++i) { pc0[i] -= mrow; pc1[i] -= mrow; }
              A_EXPPACK(); }
#pragma unroll
            for (int k4 = 0; k4 < 4; ++k4) PAp[k4] = PAc[k4];
            pc0 = pn0; pc1 = pn1;
            __syncthreads();
            A_DMAK(2, 0);
            A_DMAWAIT(); __syncthreads();
            PT_END('U');
            for (int t = 1; t < NT; ++t) {
                if (t + 2 < NT) A_DMAK(t + 2, t & 1);
                A_DMAV(t, t & 1);
                const bool band = (t >= NT - 4);
                const bool doqk = (t + 1 <= Tw), dopv = (t - 1 <= Tw), dova = (t <= Tw);
                A_MFMA(t, doqk, dopv);
                if (dova) { A_VALU(t, band); } else { upd = false; }
                if (upd) {
                    if (hi == 0) wsf[r32] = fsc;
                    asm volatile("" ::: "memory");
#pragma unroll
                    for (int g4 = 0; g4 < 4; ++g4) { const f32x4 a = *(const LAS f32x4*)(wsf + 8 * g4 + 4 * hi);
#pragma unroll
                        for (int j = 0; j < 4; ++j) { o0[4 * g4 + j] *= a[j]; o1[4 * g4 + j] *= a[j]; } }
                    asm volatile("" ::: "memory");
                }
                A_DMAWAIT(); __syncthreads();
                pc0 = pn0; pc1 = pn1;
#pragma unroll
                for (int k4 = 0; k4 < 4; ++k4) PAp[k4] = PAc[k4];
            }
            PT_BEG('U');
            { const int inx = (it + 1 < nit) ? it + 1 : it; A_PREFETCH(inx); }
            if (NT - 1 <= Tw) { A_PV((NT - 1) & 1); }
            lrow = xor_sum<32>(lrow);
            { int le = lane; asm volatile("" : "+v"(le));
              const int r32e = le & 31, hie = le >> 5;
              if (hie == 0) wsf[r32e] = 1.0f / lrow;
              asm volatile("" ::: "memory");
              LAS bf16* st0 = stg + (4 * hie) * 64 + r32e;
#pragma unroll
              for (int g4 = 0; g4 < 4; ++g4) { const f32x4 a = *(const LAS f32x4*)(wsf + 8 * g4 + 4 * hie);
#pragma unroll
                  for (int j = 0; j < 4; ++j) { const int i = 4 * g4 + j;
                      st0[(8 * g4 + j) * 64] = (bf16)f2bf(o0[i] * a[j]); st0[(8 * g4 + j) * 64 + 32] = (bf16)f2bf(o1[i] * a[j]); } }
              asm volatile("s_waitcnt lgkmcnt(0)" ::: "memory");
              const unsigned lo_ = (unsigned)((le >> 3) * DM + (le & 7) * 8); const LAS bf16* sr0 = stg + (le >> 3) * 64 + (le & 7) * 8;
#pragma unroll
              for (int i = 0; i < 4; ++i) { gb* Ow = O + (rowbase + q0 + wid * 32 + i * 8) * DM + h * 64; const u32x4 v = *(const LAS u32x4*)(sr0 + i * 8 * 64); *(__attribute__((address_space(1))) u32x4*)(Ow + lo_) = v; } }
            A_DMAWAIT(); __syncthreads();
            PT_END('U');
        }
    }
#ifdef PROBE_AT
    { const unsigned long long w0 = __builtin_amdgcn_s_memtime(); while (__builtin_amdgcn_s_memtime() - w0 < pacc) __builtin_amdgcn_s_sleep(4); }
#endif
#undef PT_BEG
#undef PT_END
#undef A_GLDS
#undef A_UNIT
#undef A_PREFETCH
#undef A_DMAK
#undef A_DMAV
#undef A_DMAWAIT
#undef A_QK
#undef A_PV
#undef A_VRD
#undef A_MASK
#undef A_ROWMAX
#undef A_EXPPACK
#undef A_VALU
#undef A_MFMA
#undef A_KRD
}

#define XB_TMO      128
#define XB_XCNT(j)  (256  + 64 * (j))
#define XB_XSUB(j)  (1280 + 64 * (j))
#define XB_XGEN(j)  (2304 + 64 * (j))
#define XB_TOP      3328
#define XB_TOPGEN   3392
#define XCD_BAR_WORDS 3456
#define XB_SPIN_CAP (1u << 18)

__device__ __forceinline__ unsigned xb_ld(unsigned* p)              { return __hip_atomic_load(p, __ATOMIC_RELAXED, __HIP_MEMORY_SCOPE_AGENT); }
__device__ __forceinline__ unsigned xb_add(unsigned* p, unsigned v) { return __hip_atomic_fetch_add(p, v, __ATOMIC_RELAXED, __HIP_MEMORY_SCOPE_AGENT); }
__device__ __forceinline__ unsigned xb_xcc_id() { return (unsigned)__builtin_amdgcn_s_getreg((3 << 11) | 20) & 0xFu; }
#define XB_SPIN(cond, bar) do { unsigned _sp = 0; while (cond) { __builtin_amdgcn_s_sleep(1); \
    if ((++_sp & 255u) == 0u) { if (xb_ld(&(bar)[XB_TMO])) break; if (_sp > XB_SPIN_CAP) { atomicAdd(&(bar)[XB_TMO], 1u); break; } } } } while (0)

struct XcdBarrier {
    unsigned* bar; unsigned x;
    volatile LAS unsigned* st;
};

__device__ __forceinline__ XcdBarrier xcd_barrier_post(unsigned* bar, volatile LAS unsigned* st, const int wv_) {
    XcdBarrier b; b.bar = bar; b.x = xb_xcc_id(); b.st = st;
    if (otid(wv_) == 0) (void)xb_add(&bar[XB_XCNT(b.x)], 1u);
    return b;
}
__device__ __forceinline__ void xcd_barrier_complete(unsigned* bar, unsigned x, unsigned& nloc, unsigned& nx) {
    const unsigned G = gridDim.x * gridDim.y * gridDim.z;
    unsigned sum, cnt, mine, sp = 0u;
    for (;;) {
        sum = 0u; cnt = 0u; mine = 0u;
#pragma unroll
        for (unsigned j = 0; j < 16; ++j) { const unsigned c = xb_ld(&bar[XB_XCNT(j)]); sum += c; cnt += (c > 0u) ? 1u : 0u; mine = (j == x) ? c : mine; }
        if (sum == G) break;
        __builtin_amdgcn_s_sleep(1);
        if ((++sp & 255u) == 0u) { if (xb_ld(&bar[XB_TMO])) break; if (sp > XB_SPIN_CAP) { atomicAdd(&bar[XB_TMO], 1u); break; } }
    }
    nloc = mine > 0u ? mine : 1u; nx = cnt > 0u ? cnt : 1u;
}

__device__ __forceinline__ void xcd_barrier(const XcdBarrier& b, const int wv_) {
    asm volatile("s_waitcnt vmcnt(0)" ::: "memory");
    __syncthreads();
    if (otid(wv_) == 0) {
        unsigned* bar = b.bar;
        __builtin_amdgcn_s_waitcnt(0);
        unsigned nloc = b.st[0], nx = b.st[1];
        if (nloc == 0u) { xcd_barrier_complete(bar, b.x, nloc, nx); b.st[0] = nloc; b.st[1] = nx; }
        const unsigned old = xb_add(&bar[XB_XSUB(b.x)], 1u);
        const unsigned gen = old / nloc;
        if (old + 1u == (gen + 1u) * nloc) {
            __builtin_amdgcn_fence(__ATOMIC_RELEASE, "agent");
            asm volatile("s_waitcnt vmcnt(0)" ::: "memory");
            const unsigned og = xb_add(&bar[XB_TOP], 1u);
            const unsigned tg = og / nx;
            if (og + 1u == (tg + 1u) * nx) xb_add(&bar[XB_TOPGEN], 1u);
            else XB_SPIN(xb_ld(&bar[XB_TOPGEN]) == tg, bar);
            __builtin_amdgcn_fence(__ATOMIC_ACQUIRE, "agent");
            xb_add(&bar[XB_XGEN(b.x)], 1u);
            asm volatile("s_waitcnt vmcnt(0)" ::: "memory");
        } else {
            XB_SPIN(xb_ld(&bar[XB_XGEN(b.x)]) == gen, bar);
            __builtin_amdgcn_fence(__ATOMIC_ACQUIRE, "agent");
            asm volatile("s_waitcnt vmcnt(0)" ::: "memory");
        }
    }
    __syncthreads();
}

__device__ __forceinline__ const float* inptr(LAS unsigned char* lds, int i) {
    unsigned off = PTR_OFF + 8 * i; asm volatile("" : "+v"(off));
    const u32x2 v = *(const LAS u32x2*)(lds + off);
    const unsigned lo = __builtin_amdgcn_readfirstlane(v.x), hi = __builtin_amdgcn_readfirstlane(v.y);
    return (const float*)(((unsigned long long)hi << 32) | lo);
}
__global__ void __launch_bounds__(NTHR, 2) trunk_fwd(Params p) {
    extern __shared__ __attribute__((aligned(16))) unsigned char lds_raw[];
    LAS unsigned char* lds = (LAS unsigned char*)lds_raw;
    cg::grid_group grid = cg::this_grid();
    const int wv_ = __builtin_amdgcn_readfirstlane(threadIdx.x >> 6);
#ifdef PROBE_CAT
    const unsigned long long tp0_ = __builtin_amdgcn_s_memrealtime();
#endif
#ifndef NO_PRO
    prologue(p, lds, wv_);
#endif
#ifdef PROBE_CAT
    if (PROBE_CAT == 'P') { const unsigned long long d_ = __builtin_amdgcn_s_memrealtime() - tp0_; const unsigned long long w0_ = __builtin_amdgcn_s_memrealtime(); while (__builtin_amdgcn_s_memrealtime() - w0_ < d_) __builtin_amdgcn_s_sleep(8); }
#endif
    { const int t0 = otid(wv_); if (t0 < 22) { const unsigned long long v = (t0 < 20) ? (unsigned long long)p.in[t0 < 20 ? t0 : 0] : (t0 == 20 ? (unsigned long long)p.out : (unsigned long long)p.ws);
        ((LAS unsigned long long*)(lds + PTR_OFF))[t0] = v; }
      if (t0 < 2) ((volatile LAS unsigned*)(lds + PTR_OFF + 256))[t0] = 0u; }
    if (blockIdx.x == 0) { unsigned* bw = (unsigned*)(p.ws + WS_CTL); for (int i = otid(wv_); i < XCD_BAR_WORDS; i += NTHR) __hip_atomic_store(bw + i, 0u, __ATOMIC_RELAXED, __HIP_MEMORY_SCOPE_AGENT); }
    __syncthreads();
    grid.sync();
    const XcdBarrier bar = xcd_barrier_post((unsigned*)(p.ws + WS_CTL), (volatile LAS unsigned*)(lds + PTR_OFF + 256), wv_);
#ifdef PROBE_CAT
    unsigned long long tprev_ = __builtin_amdgcn_s_memrealtime();
#define GSYNC(C) do { if ((C) == PROBE_CAT) { const unsigned long long d_ = __builtin_amdgcn_s_memrealtime() - tprev_; const unsigned long long w0_ = __builtin_amdgcn_s_memrealtime(); \
        while (__builtin_amdgcn_s_memrealtime() - w0_ < d_) __builtin_amdgcn_s_sleep(8); } xcd_barrier(bar, wv_); tprev_ = __builtin_amdgcn_s_memrealtime(); } while (0)
#else
#define GSYNC(C) xcd_barrier(bar, wv_)
#endif
#define WSP ((unsigned char*)inptr(lds, 21))
#define XRES ((float*)inptr(lds, 20))
#pragma nounroll
    for (int l = 0; l < DEPTH; ++l) {
        const int j = l >> 1; const bool fox = (l & 1) == 0;
#ifndef NO_NORM
        { unsigned char* ws = WSP; const float* modl = (const float*)(ws + WS_MOD) + (size_t)l * 16 * 6144;
          if (fox) norm_phase<2, true>((l == 0) ? (const void*)inptr(lds, I_X) : (const void*)(ws + WS_XB), l != 0, inptr(lds, I_GMIX) + l * DM, modl + 0, modl + 1024, (bf16*)(ws + WS_H), inptr(lds, I_FWIN) + (size_t)j * DM * 3088, inptr(lds, I_FBF) + j * 16, (float*)(ws + WS_LF), lds, wv_);
          else norm_phase<4, false>((const void*)(ws + WS_XB), true, inptr(lds, I_GMIX) + l * DM, modl + 0, modl + 1024, (bf16*)(ws + WS_H), nullptr, nullptr, nullptr, lds, wv_); }
#endif
        GSYNC('N');
        if (fox) {
#ifndef NO_CUM
            { unsigned char* ws = WSP; fox_cumsum((const float*)(ws + WS_LF), (bf16*)(ws + WS_Q), (bf16*)(ws + WS_K), lds, wv_); }
#endif
#ifndef NO_G1F
            { unsigned char* ws = WSP; const bf16* WinT = (const bf16*)(ws + WS_W + W_FOX + (size_t)j * W_FOX_STRIDE);
              pg8::Gemm g{(const bf16*)(ws + WS_H), WinT, M, 3072, DM}; pg8::StaticOrder S; S.init(M, 3072, ogrid(), obid());
              pg8::EpiQkvFox E{ws, 0.125f * LOG2E};
              pg8::gemm_phase<pg8::EpiQkvFox, pg8::StaticOrder, true, true>(lds, g, S, E, wv_); }
#endif
            GSYNC('G');
#ifndef NO_ATT5
            { unsigned char* ws = WSP; attn_phase<5>(lds, (const bf16*)(ws + WS_Q), (const bf16*)(ws + WS_K), (const bf16*)(ws + WS_V), (bf16*)(ws + WS_H), wv_); }
#ifdef PROBE_ATT2
            { unsigned char* ws = WSP; attn_phase<5>(lds, (const bf16*)(ws + WS_Q), (const bf16*)(ws + WS_K), (const bf16*)(ws + WS_V), (bf16*)(ws + WS_H), wv_); }
#endif
#endif
            GSYNC('A');
        } else {
#ifndef NO_GD
            { unsigned char* ws = WSP; const bf16* WdT = (const bf16*)(ws + WS_W + W_MLA + (size_t)j * W_MLA_STRIDE);
              pg8::Gemm g{(const bf16*)(ws + WS_H), WdT, M, 512, DM}; pg8::StaticOrder S; S.init(M, 512, ogrid(), obid());
              pg8::EpiMlaDown E{ws};
              pg8::gemm_phase<pg8::EpiMlaDown, pg8::StaticOrder, true, true>(lds, g, S, E, wv_); }
#endif
            GSYNC('H');
#ifndef NO_GQ
            { unsigned char* ws = WSP; const bf16* WuqT = (const bf16*)(ws + WS_W + W_MLA + (size_t)j * W_MLA_STRIDE) + (size_t)512 * 1024;
              int Kq = 256; asm volatile("" : "+s"(Kq));
              pg8::Gemm g{(const bf16*)(ws + WS_CQ), WuqT, M, 1536, Kq}; pg8::StaticOrder S; S.init(M, 1536, ogrid(), obid());
              pg8::EpiMlaQ E{ws, 0.10206207261596575f * LOG2E};
              pg8::gemm_phase<pg8::EpiMlaQ, pg8::StaticOrder, true, true>(lds, g, S, E, wv_); }
#endif
#ifndef NO_GKV
            { unsigned char* ws = WSP; const bf16* WukvT = (const bf16*)(ws + WS_W + W_MLA + (size_t)j * W_MLA_STRIDE) + (size_t)512 * 1024 + (size_t)1536 * 256;
              int Kkv = 128; asm volatile("" : "+s"(Kkv));
              pg8::Gemm g{(const bf16*)(ws + WS_CKV), WukvT, M, 2048, Kkv}; pg8::StaticOrder S; S.init(M, 2048, ogrid(), obid());
              pg8::EpiMlaKv E{ws};
              pg8::gemm_phase<pg8::EpiMlaKv, pg8::StaticOrder, true, true>(lds, g, S, E, wv_); }
#endif
            GSYNC('Q');
#ifndef NO_ATT6
            { unsigned char* ws = WSP; attn_phase<6>(lds, (const bf16*)(ws + WS_Q), (const bf16*)(ws + WS_K), (const bf16*)(ws + WS_V), (bf16*)(ws + WS_H), wv_); }
#ifdef PROBE_ATT2
            { unsigned char* ws = WSP; attn_phase<6>(lds, (const bf16*)(ws + WS_Q), (const bf16*)(ws + WS_K), (const bf16*)(ws + WS_V), (bf16*)(ws + WS_H), wv_); }
#endif
#endif
            GSYNC('B');
        }
#ifndef NO_GO
        { unsigned char* ws = WSP; const float* modl = (const float*)(ws + WS_MOD) + (size_t)l * 16 * 6144;
          const bf16* WoutT = fox ? (const bf16*)(ws + WS_W + W_FOX + (size_t)j * W_FOX_STRIDE) + (size_t)3072 * DM : (const bf16*)(ws + WS_W + W_MLA + (size_t)j * W_MLA_STRIDE + 3 * MiB);
          pg8::Gemm g{(const bf16*)(ws + WS_H), WoutT, M, DM, DM}; pg8::StaticOrder S; S.init(M, DM, ogrid(), obid());
          pg8::EpiResid E{(l == 0) ? inptr(lds, I_X) : (const float*)nullptr, (bf16*)(ws + WS_XB), modl + 2048};
          pg8::gemm_phase<pg8::EpiResid, pg8::StaticOrder, true, true>(lds, g, S, E, wv_); }
#endif
        GSYNC('O');
#ifndef NO_NORM2
        { unsigned char* ws = WSP; const float* modl = (const float*)(ws + WS_MOD) + (size_t)l * 16 * 6144;
          norm_phase<4, false>((const void*)(ws + WS_XB), true, inptr(lds, I_GMLP) + l * DM, modl + 3072, modl + 4096, (bf16*)(ws + WS_H), nullptr, nullptr, nullptr, lds, wv_); }
#endif
        GSYNC('M');
#ifndef NO_GU
        { unsigned char* ws = WSP; const bf16* W1T = (const bf16*)(ws + WS_W + W_MLP + (size_t)l * W_MLP_STRIDE);
          pg8::Gemm g{(const bf16*)(ws + WS_H), W1T, M, FF, DM}; pg8::StaticOrder S; S.init(M, FF, ogrid(), obid());
          pg8::EpiRelu2 E{ws};
          pg8::gemm_phase<pg8::EpiRelu2, pg8::StaticOrder, true, true>(lds, g, S, E, wv_); }
#endif
        GSYNC('U');
#ifndef NO_GDN
        { unsigned char* ws = WSP; const float* modl = (const float*)(ws + WS_MOD) + (size_t)l * 16 * 6144;
          const bf16* W2T = (const bf16*)(ws + WS_W + W_MLP + (size_t)l * W_MLP_STRIDE) + (size_t)FF * DM;
          pg8::Gemm g{(const bf16*)(ws + WS_BIG), W2T, M, DM, FF}; pg8::StaticOrder S; S.init(M, DM, ogrid(), obid());
          pg8::EpiResid E{(const float*)nullptr, (bf16*)(ws + WS_XB), modl + 5120};
          pg8::gemm_phase<pg8::EpiResid, pg8::StaticOrder, true, true>(lds, g, S, E, wv_); }
#endif
        GSYNC('D');
    }
    final_norm((const bf16*)(WSP + WS_XB), XRES, inptr(lds, I_GFIN), wv_);
#ifdef PROBE_CAT
    if (PROBE_CAT == 'F') { const unsigned long long d_ = __builtin_amdgcn_s_memrealtime() - tprev_; const unsigned long long w0_ = __builtin_amdgcn_s_memrealtime(); while (__builtin_amdgcn_s_memrealtime() - w0_ < d_) __builtin_amdgcn_s_sleep(8); }
#endif
}

extern "C" void kernel_launch(void* const* d_in, const int* in_sizes, int n_in, void* d_out, int out_size, void* d_ws, size_t ws_size, hipStream_t stream) {
    static int grid = 0;
    if (grid == 0) {
        if (n_in != 20 || in_sizes[0] != M * DM || out_size != M * DM || ws_size < WS_END) { fprintf(stderr, "kernel_launch: unexpected shapes (n_in %d, in0 %d, out %d, ws %zu)\n", n_in, n_in > 0 ? in_sizes[0] : -1, out_size, ws_size); grid = -1; return; }
        int dev = 0, cus = 0, per_cu = 0;
        if (hipGetDevice(&dev) != hipSuccess || hipDeviceGetAttribute(&cus, hipDeviceAttributeMultiprocessorCount, dev) != hipSuccess) { fprintf(stderr, "kernel_launch: device query failed\n"); grid = -1; return; }
        if (hipFuncSetAttribute((const void*)trunk_fwd, hipFuncAttributeMaxDynamicSharedMemorySize, LDS_BYTES) != hipSuccess) { fprintf(stderr, "kernel_launch: hipFuncSetAttribute failed\n"); grid = -1; return; }
        if (hipOccupancyMaxActiveBlocksPerMultiprocessor(&per_cu, (const void*)trunk_fwd, NTHR, LDS_BYTES) != hipSuccess || per_cu < 1) { fprintf(stderr, "kernel_launch: occupancy query gave %d\n", per_cu); per_cu = 1; }
        (void)hipGetLastError();
        grid = cus * per_cu;
    }
    if (grid < 0) return;
    Params prm{};
    for (int i = 0; i < 20; ++i) prm.in[i] = (const float*)d_in[i];
    prm.out = (float*)d_out; prm.ws = (unsigned char*)d_ws;
    void* args[] = {&prm};
    hipError_t e = hipLaunchCooperativeKernel((const void*)trunk_fwd, dim3(grid), dim3(NTHR), args, LDS_BYTES, stream);
    if (e != hipSuccess) fprintf(stderr, "kernel_launch: cooperative launch failed: %s (grid %d)\n", hipGetErrorString(e), grid);
}
```

```cpp
#include <hip/hip_runtime.h>
#include <hip/hip_cooperative_groups.h>
#include <cstdio>
#include <cstdint>
namespace cg = cooperative_groups;
#define LAS __attribute__((address_space(3)))
typedef unsigned short bf16;
typedef short bf16x8 __attribute__((ext_vector_type(8)));
typedef short s16x4 __attribute__((ext_vector_type(4)));
typedef float f32x16 __attribute__((ext_vector_type(16)));
typedef float f32x4 __attribute__((ext_vector_type(4)));
typedef float f32x2 __attribute__((ext_vector_type(2)));
typedef unsigned u32x4 __attribute__((ext_vector_type(4)));
typedef unsigned u32x2 __attribute__((ext_vector_type(2)));

constexpr int NB = 16, SEQ = 2048, DM = 1024, NH = 16, FF = 4096, DEPTH = 4;
constexpr int M = NB * SEQ;
constexpr int NTHR = 512, NWAVE = 8;
constexpr float EPS = 1e-6f, LOG2E = 1.4426950408889634f;
constexpr size_t MiB = 1u << 20;
constexpr size_t WS_BIG = 0;
constexpr size_t WS_Q = 0, WS_K = 96 * MiB, WS_V = 192 * MiB;
constexpr size_t WS_H = 256 * MiB;
constexpr size_t WS_CQ = 320 * MiB, WS_CKV = 336 * MiB;
constexpr size_t WS_W = 344 * MiB;
constexpr size_t W_FOX = 0, W_FOX_STRIDE = 8 * MiB;
constexpr size_t W_MLA = 16 * MiB, W_MLA_STRIDE = 5 * MiB;
constexpr size_t W_MLP = 26 * MiB, W_MLP_STRIDE = 16 * MiB;
constexpr size_t WS_MOD = 436 * MiB;
constexpr size_t WS_CS = 438 * MiB;
constexpr size_t WS_LF = 442 * MiB;
constexpr size_t WS_SSQQ = 444 * MiB, WS_SSQKV = 445 * MiB;
constexpr size_t WS_CTL = 446 * MiB;
constexpr size_t WS_XB = 447 * MiB;
constexpr size_t WS_END = 511 * MiB;
static_assert(WS_W + W_MLP + 4 * W_MLP_STRIDE <= WS_MOD, "weights fit");
constexpr int LDS_BYTES = 135168;

template <int MASK> __device__ __forceinline__ float xor_sum(float v) {
    if constexpr (MASK == 32) return v + __shfl_xor(v, 32);
    else return v + __builtin_bit_cast(float, __builtin_amdgcn_ds_swizzle(__builtin_bit_cast(int, v), (MASK << 10) | 0x1F));
}
template <int MASK> __device__ __forceinline__ float xor_get(float v, bool upper) {
    if constexpr (MASK == 32) return __shfl_xor(v, 32);
    else return __builtin_bit_cast(float, __builtin_amdgcn_ds_swizzle(__builtin_bit_cast(int, v), (MASK << 10) | 0x1F));
}
__device__ __forceinline__ float wave_sum(float v) { v = xor_sum<1>(v); v = xor_sum<2>(v); v = xor_sum<4>(v); v = xor_sum<8>(v); v = xor_sum<16>(v); v = xor_sum<32>(v); return v; }
namespace pg8 {
#define PG8_LAS __attribute__((address_space(3)))
typedef unsigned short bf16_t;
typedef short bf16x8 __attribute__((ext_vector_type(8)));
typedef float f32x4 __attribute__((ext_vector_type(4)));
typedef unsigned u32x4 __attribute__((ext_vector_type(4)));
constexpr int BM = 256, BK = 64, HALF = 128, HTB = HALF * BK * 2  , STAGE_BYTES = 8 * HTB, NXCD = 8, WGM = 8;

__host__ __device__ __forceinline__ int lds_byte(int r, int c) { const int st = (r >> 4) * 2 + (c >> 5), rr = r & 15, cc = c & 31, ob = rr * 64 + cc * 2; return st * 1024 + (ob ^ (((ob >> 9) & 1) << 5)); }
__host__ __device__ __forceinline__ void stage_rc(int b, int& R, int& C) { const int st = b / 1024, sb = b % 1024, swz = sb ^ (((sb >> 9) & 1) << 5); R = (st >> 1) * 16 + swz / 64; C = (st & 1) * 32 + (swz % 64) / 2; }
__host__ __device__ __forceinline__ int perm32(int rho) { const int n = rho >> 4, i = rho & 15; return 8 * (i >> 2) + 4 * n + (i & 3); }

struct Unit { int pm, pn; };
struct Gemm { const bf16_t* A; const bf16_t* Bt; int M, N, K; };

struct StaticOrder {
    int nM, nN, nwg, G, c;
    __host__ __device__ void init(int M, int N, int G_, int c_) { nM = M / BM; nN = N / BM; nwg = nM * nN; G = G_; c = c_; }
    __host__ __device__ bool next(int i, Unit& u) const {
        const long L = (long)i * G + c; if (L >= nwg) return false;
        int wgid = (int)L; { const int q = nwg / NXCD, r = nwg % NXCD, xcd = wgid % NXCD, off = wgid / NXCD; wgid = (xcd < r ? xcd * (q + 1) : r * (q + 1) + (xcd - r) * q) + off; }
        const int nig = WGM * nN, gid = wgid / nig, fm = gid * WGM, gsz = (nM - fm) < WGM ? (nM - fm) : WGM;
        u.pm = fm + ((wgid % nig) % gsz); u.pn = (wgid % nig) / gsz; return true;
    }
    __device__ __forceinline__ void a_ready(const Unit&) const {}
    __device__ __forceinline__ void done(const Unit&) const {}
};

__device__ __forceinline__ unsigned cvt_pk_bf16(float lo, float hi) { unsigned r; asm volatile("v_cvt_pk_bf16_f32 %0, %1, %2" : "=v"(r) : "v"(lo), "v"(hi)); return r; }
typedef float f32x2 __attribute__((ext_vector_type(2)));
typedef unsigned u32x2 __attribute__((ext_vector_type(2)));
#define GAS __attribute__((address_space(1)))
typedef GAS bf16_t gbf16; typedef GAS float gf32; typedef GAS unsigned char gu8;
constexpr float RMS_EPS = 1e-6f;
__device__ __forceinline__ u32x4 pack8(const f32x4& v0, const f32x4& v1) { u32x4 w; w.x = cvt_pk_bf16(v0[0], v0[1]); w.y = cvt_pk_bf16(v0[2], v0[3]); w.z = cvt_pk_bf16(v1[0], v1[1]); w.w = cvt_pk_bf16(v1[2], v1[3]); return w; }
__device__ __forceinline__ u32x2 pack4(const f32x4& v) { u32x2 w; w.x = cvt_pk_bf16(v[0], v[1]); w.y = cvt_pk_bf16(v[2], v[3]); return w; }

struct EpiQkvFox {
    static constexpr bool PERM = true, AFTER_DRAIN = false;
    unsigned char* ws; float qscale;
    __device__ __forceinline__ void operator()(const f32x4 (&acc)[2][2][4][2], const Unit& u, int wr, int wc, int fr, int fq) const {
        gbf16* Q = (gbf16*)((gu8*)ws + WS_Q); gbf16* Kp = (gbf16*)((gu8*)ws + WS_K); gbf16* V = (gbf16*)((gu8*)ws + WS_V);
        const int row0 = u.pm * BM + wr * 64 + fr;
        const int t = u.pn >> 2;
        const int cin0 = (u.pn & 3) * BM + wc * 32 + 8 * fq;
        const float sc = (t == 0) ? qscale : 1.f;
#pragma unroll
        for (int ai = 0; ai < 2; ++ai)
#pragma unroll
            for (int m = 0; m < 4; ++m) { const unsigned row = (unsigned)(row0 + ai * HALF + m * 16);
#pragma unroll
                for (int bj = 0; bj < 2; ++bj) { const int cin = cin0 + bj * HALF;
                    gbf16* dst = (t == 2) ? (V + row * 1024 + cin) : ((t == 0 ? Q : Kp) + row * 1280 + (cin >> 6) * 80 + (cin & 63));
                    *(GAS u32x4*)dst = pack8(acc[ai][bj][m][0] * sc, acc[ai][bj][m][1] * sc); } }
    }
};
struct EpiRelu2 {
    static constexpr bool PERM = true, AFTER_DRAIN = false;
    unsigned char* ws;
    __device__ __forceinline__ void operator()(const f32x4 (&acc)[2][2][4][2], const Unit& u, int wr, int wc, int fr, int fq) const {
        gbf16* H = (gbf16*)((gu8*)ws + WS_BIG);
        const int row0 = u.pm * BM + wr * 64 + fr; const int col0 = u.pn * BM + wc * 32 + 8 * fq;
#pragma unroll
        for (int ai = 0; ai < 2; ++ai)
#pragma unroll
            for (int m = 0; m < 4; ++m) { gbf16* rowp = H + (unsigned)(row0 + ai * HALF + m * 16) * 4096u + (unsigned)col0;
#pragma unroll
                for (int bj = 0; bj < 2; ++bj) { f32x4 v0 = acc[ai][bj][m][0], v1 = acc[ai][bj][m][1];
#pragma unroll
                    for (int j = 0; j < 4; ++j) { const float a = fmaxf(v0[j], 0.f), b = fmaxf(v1[j], 0.f); v0[j] = a * a; v1[j] = b * b; }
                    *(GAS u32x4*)(rowp + bj * HALF) = pack8(v0, v1); } }
    }
};
struct EpiResid {
    static constexpr bool PERM = true, AFTER_DRAIN = false;
    const float* base32_; bf16_t* xb_; const float* gate_;
    __device__ __forceinline__ void operator()(const f32x4 (&acc)[2][2][4][2], const Unit& u, int wr, int wc, int fr, int fq) const {
        const gf32* base32 = (const gf32*)base32_; gbf16* xb = (gbf16*)xb_; const gf32* gate = (const gf32*)gate_;
        const int row0 = u.pm * BM + wr * 64 + fr; const int col0 = u.pn * BM + wc * 32 + 8 * fq;
        const gf32* gp = gate + (size_t)(u.pm >> 3) * 6144 + col0;
        f32x4 gv[2][2];
#pragma unroll
        for (int bj = 0; bj < 2; ++bj)
#pragma unroll
            for (int n = 0; n < 2; ++n) gv[bj][n] = *(const GAS f32x4*)(gp + bj * HALF + n * 4);
#pragma unroll
        for (int ai = 0; ai < 2; ++ai)
#pragma unroll
            for (int m = 0; m < 4; ++m) { const unsigned off = (unsigned)(row0 + ai * HALF + m * 16) * 1024u + (unsigned)col0;
#pragma unroll
                for (int bj = 0; bj < 2; ++bj) { f32x4 b0, b1;
                    if (base32_) { b0 = *(const GAS f32x4*)(base32 + off + bj * HALF); b1 = *(const GAS f32x4*)(base32 + off + bj * HALF + 4); }
                    else { const u32x4 w = *(const GAS u32x4*)(xb + off + bj * HALF);
                        b0 = (f32x4){__builtin_bit_cast(float, w.x << 16), __builtin_bit_cast(float, w.x & 0xffff0000u), __builtin_bit_cast(float, w.y << 16), __builtin_bit_cast(float, w.y & 0xffff0000u)};
                        b1 = (f32x4){__builtin_bit_cast(float, w.z << 16), __builtin_bit_cast(float, w.z & 0xffff0000u), __builtin_bit_cast(float, w.w << 16), __builtin_bit_cast(float, w.w & 0xffff0000u)}; }
                    *(GAS u32x4*)(xb + off + bj * HALF) = pack8(b0 + gv[bj][0] * acc[ai][bj][m][0], b1 + gv[bj][1] * acc[ai][bj][m][1]); } }
    }
};
struct EpiMlaKv {
    static constexpr bool PERM = true, AFTER_DRAIN = false;
    unsigned char* ws;
    __device__ __forceinline__ void operator()(const f32x4 (&acc)[2][2][4][2], const Unit& u, int wr, int wc, int fr, int fq) const {
        const gf32* ssq = (const gf32*)((gu8*)ws + WS_SSQKV); gbf16* Kp = (gbf16*)((gu8*)ws + WS_K); gbf16* V = (gbf16*)((gu8*)ws + WS_V);
        const int row0 = u.pm * BM + wr * 64 + fr;
        const int t = u.pn >> 2; const int cin0 = (u.pn & 3) * BM + wc * 32 + 8 * fq;
#pragma unroll
        for (int ai = 0; ai < 2; ++ai)
#pragma unroll
            for (int m = 0; m < 4; ++m) { const unsigned row = (unsigned)(row0 + ai * HALF + m * 16);
                const f32x4 s4 = *(const GAS f32x4*)(ssq + row * 4);
                const float rs = __builtin_amdgcn_rsqf(((s4[0] + s4[1]) + (s4[2] + s4[3])) * (1.0f / 128.0f) + RMS_EPS);
#pragma unroll
                for (int bj = 0; bj < 2; ++bj) { const int cin = cin0 + bj * HALF;
                    gbf16* dst = t ? (V + row * 1024 + cin) : (Kp + row * 1536 + (cin >> 6) * 96 + (cin & 63));
                    *(GAS u32x4*)dst = pack8(acc[ai][bj][m][0] * rs, acc[ai][bj][m][1] * rs); }
                asm volatile("" ::: "memory"); }
    }
};
struct EpiMlaQ {
    static constexpr bool PERM = false, AFTER_DRAIN = false;
    unsigned char* ws; float qscale;
    __device__ __forceinline__ void operator()(const f32x4 (&acc)[2][2][4][2], const Unit& u, int wr, int wc, int fr, int fq) const {
        const gf32* ssq = (const gf32*)((gu8*)ws + WS_SSQQ); const gf32* cst = (const gf32*)((gu8*)ws + WS_CS); gbf16* Q = (gbf16*)((gu8*)ws + WS_Q);
        const int row0 = u.pm * BM + wr * 64 + fr;
#pragma unroll
        for (int ai = 0; ai < 2; ++ai)
#pragma unroll
            for (int m = 0; m < 4; ++m) { const unsigned row = (unsigned)(row0 + ai * HALF + m * 16);
                const f32x4 s4 = *(const GAS f32x4*)(ssq + row * 4);
                const float rs = qscale * __builtin_amdgcn_rsqf(((s4[0] + s4[1]) + (s4[2] + s4[3])) * (1.0f / 256.0f) + RMS_EPS);
                if (u.pn < 4) {
#pragma unroll
                    for (int bj = 0; bj < 2; ++bj)
#pragma unroll
                        for (int n = 0; n < 2; ++n) { const int cin = u.pn * BM + bj * HALF + wc * 32 + n * 16 + 4 * fq;
                            *(GAS u32x2*)(Q + row * 1536 + (cin >> 6) * 96 + (cin & 63)) = pack4(acc[ai][bj][m][n] * rs); }
                } else {
                    const f32x4 cs = *(const GAS f32x4*)(cst + row * 32 + 4 * fq), sn = *(const GAS f32x4*)(cst + row * 32 + 16 + 4 * fq);
#pragma unroll
                    for (int bj = 0; bj < 2; ++bj) { const int head = ((u.pn - 4) * BM + bj * HALF + wc * 32) >> 5;
                        const f32x4 x1 = acc[ai][bj][m][0] * rs, x2 = acc[ai][bj][m][1] * rs;
                        gbf16* dst = Q + row * 1536 + head * 96 + 64 + 4 * fq;
                        *(GAS u32x2*)dst = pack4(x1 * cs - x2 * sn); *(GAS u32x2*)(dst + 16) = pack4(x2 * cs + x1 * sn); }
                }
                asm volatile("" ::: "memory");
            }
    }
};
struct EpiMlaDown {
    static constexpr bool PERM = false, AFTER_DRAIN = false;
    unsigned char* ws;
    __device__ __forceinline__ void operator()(const f32x4 (&acc)[2][2][4][2], const Unit& u, int wr, int wc, int fr, int fq) const {
        gbf16* cq = (gbf16*)((gu8*)ws + WS_CQ); gbf16* ckv = (gbf16*)((gu8*)ws + WS_CKV); gf32* ssqq = (gf32*)((gu8*)ws + WS_SSQQ); gf32* ssqkv = (gf32*)((gu8*)ws + WS_SSQKV); const gf32* cst = (const gf32*)((gu8*)ws + WS_CS); gbf16* Kp = (gbf16*)((gu8*)ws + WS_K);
        const int row0 = u.pm * BM + wr * 64 + fr;
#pragma unroll
        for (int ai = 0; ai < 2; ++ai)
#pragma unroll
            for (int m = 0; m < 4; ++m) { const unsigned row = (unsigned)(row0 + ai * HALF + m * 16);
                if (u.pn == 0) {
                    float ss = 0.f;
#pragma unroll
                    for (int bj = 0; bj < 2; ++bj)
#pragma unroll
                        for (int n = 0; n < 2; ++n) { const f32x4 v = acc[ai][bj][m][n]; ss += (v[0] * v[0] + v[1] * v[1]) + (v[2] * v[2] + v[3] * v[3]);
                            *(GAS u32x2*)(cq + row * 256 + bj * HALF + wc * 32 + n * 16 + 4 * fq) = pack4(v); }
                    ss = xor_sum<16>(ss); ss = xor_sum<32>(ss);
                    if (fq == 0) ssqq[row * 4 + wc] = ss;
                } else {
                    float ss = 0.f;
#pragma unroll
                    for (int n = 0; n < 2; ++n) { const f32x4 v = acc[ai][0][m][n]; ss += (v[0] * v[0] + v[1] * v[1]) + (v[2] * v[2] + v[3] * v[3]);
                        *(GAS u32x2*)(ckv + row * 128 + wc * 32 + n * 16 + 4 * fq) = pack4(v); }
                    ss = xor_sum<16>(ss); ss = xor_sum<32>(ss);
                    if (fq == 0) ssqkv[row * 4 + wc] = ss;
                    if (wc == 0) {
                        const f32x4 cs = *(const GAS f32x4*)(cst + row * 32 + 4 * fq), sn = *(const GAS f32x4*)(cst + row * 32 + 16 + 4 * fq);
                        const f32x4 x1 = acc[ai][1][m][0], x2 = acc[ai][1][m][1];
                        const u32x2 o1 = pack4(x1 * cs - x2 * sn), o2 = pack4(x2 * cs + x1 * sn);
                        gbf16* dst = Kp + row * 1536 + 64 + 4 * fq;
#pragma unroll
                        for (int hd = 0; hd < 16; ++hd) { *(GAS u32x2*)(dst + hd * 96) = o1; *(GAS u32x2*)(dst + hd * 96 + 16) = o2; }
                    }
                }
            }
    }
};

template <class Epi, class Sched, bool ALIGN_EPI = false, bool SP2 = false>
__device__ __forceinline__ void gemm_phase(PG8_LAS unsigned char* lds, const Gemm g, const Sched& S, const Epi& E, const int wv_) {
    int tid_; asm volatile("v_mbcnt_lo_u32_b32 %0, -1, 0\n\tv_mbcnt_hi_u32_b32 %0, -1, %0" : "=v"(tid_)); tid_ += wv_ * 64;
    const int tid = tid_, wid = __builtin_amdgcn_readfirstlane(tid >> 6), lane = tid & 63, wr = wid >> 2, wc = wid & 3, fr = lane & 15, fq = lane >> 4;
    const int K = g.K, nt = K / BK;
    unsigned voffA[2], voffB[2];
#pragma unroll
    for (int i = 0; i < 2; ++i) { int R, C; stage_rc(tid * 16 + i * 8192, R, C); const int Rb = Epi::PERM ? ((R & ~31) + perm32(R & 31)) : R;
        voffA[i] = (unsigned)(R * K + C) * 2u; voffB[i] = (unsigned)(Rb * K + C) * 2u; }
    const size_t kstep = (size_t)(BK * 2);
    const size_t hstep = (size_t)HALF * K * 2;
    const size_t tstep = 2 * hstep;
    const unsigned ldsw = (unsigned)wid * 1024u;
    const int aoff = lds_byte(wr * 64 + fr, fq * 8), boff = lds_byte(wc * 32 + fr, fq * 8);
#define PG8_SA(b, h) (((b) * 2 + (h)) * HTB)
#define PG8_SB(b, h) ((4 + (b) * 2 + (h)) * HTB)
#define PG8_STAGE(bufoff, gbase, voff) do { _Pragma("unroll") for (int _i = 0; _i < 2; ++_i) \
        __builtin_amdgcn_global_load_lds((const unsigned*)((const char*)(gbase) + (voff)[_i]), (PG8_LAS unsigned*)(lds + (bufoff) + ldsw + _i * 8192), 16, 0, 0); } while (0)
#define PG8_LDA(dst, b, h) do { _Pragma("unroll") for (int m = 0; m < 4; ++m) _Pragma("unroll") for (int k = 0; k < 2; ++k) dst[m][k] = *(const PG8_LAS bf16x8*)(lds + PG8_SA(b, h) + aoff + m * 2048 + k * 1024); } while (0)
#define PG8_LDB(dst, b, h) do { _Pragma("unroll") for (int n = 0; n < 2; ++n) _Pragma("unroll") for (int k = 0; k < 2; ++k) dst[n][k] = *(const PG8_LAS bf16x8*)(lds + PG8_SB(b, h) + boff + n * 2048 + k * 1024); } while (0)
#define PG8_MMA(ai, bj, At, Bt) do { __builtin_amdgcn_s_setprio(1); _Pragma("unroll") for (int m = 0; m < 4; ++m) _Pragma("unroll") for (int n = 0; n < 2; ++n) _Pragma("unroll") for (int k = 0; k < 2; ++k) \
        acc[ai][bj][m][n] = __builtin_amdgcn_mfma_f32_16x16x32_bf16(Bt[n][k], At[m][k], acc[ai][bj][m][n], 0, 0, 0); __builtin_amdgcn_s_setprio(0); } while (0)
#define PG8_WAIT_V(n) asm volatile("s_waitcnt vmcnt(" #n ")" ::: "memory")
#define PG8_WAIT_L(n) asm volatile("s_waitcnt lgkmcnt(" #n ")" ::: "memory")
#define PG8_BAR __builtin_amdgcn_s_barrier()
#define PG8_SCHED __builtin_amdgcn_sched_barrier(0)
    Unit cur, nxt; int ui = 0;
    if (!S.next(0, cur)) return;
    f32x4 acc[2][2][4][2];
#pragma unroll
    for (int a = 0; a < 2; ++a)
#pragma unroll
        for (int b = 0; b < 2; ++b)
#pragma unroll
            for (int m = 0; m < 4; ++m)
#pragma unroll
                for (int n = 0; n < 2; ++n) acc[a][b][m][n] = (f32x4){0.f, 0.f, 0.f, 0.f};
    bf16x8 At[4][2], B0[2][2], B1[2][2];
    const char* cA = (const char*)g.A + (size_t)cur.pm * tstep; const char* cB = (const char*)g.Bt + (size_t)cur.pn * tstep;
    S.a_ready(cur);
    if constexpr (SP2) {
        PG8_STAGE(PG8_SB(0, 0), cB, voffB); PG8_STAGE(PG8_SB(0, 1), cB + hstep, voffB); PG8_STAGE(PG8_SA(0, 0), cA, voffA); PG8_STAGE(PG8_SA(0, 1), cA + hstep, voffA);
        if (wr == 1) PG8_BAR;
        PG8_WAIT_V(2); PG8_BAR;
        PG8_STAGE(PG8_SB(1, 0), cB + kstep, voffB); PG8_STAGE(PG8_SA(1, 0), cA + kstep, voffA); PG8_STAGE(PG8_SB(1, 1), cB + hstep + kstep, voffB);
        PG8_WAIT_V(6); PG8_BAR;
    } else {
        PG8_STAGE(PG8_SB(0, 0), cB, voffB); PG8_STAGE(PG8_SA(0, 0), cA, voffA); PG8_STAGE(PG8_SB(0, 1), cB + hstep, voffB); PG8_STAGE(PG8_SA(0, 1), cA + hstep, voffA);
        if (wr == 1) PG8_BAR;
        PG8_WAIT_V(4); PG8_BAR;
        PG8_STAGE(PG8_SB(1, 0), cB + kstep, voffB); PG8_STAGE(PG8_SA(1, 0), cA + kstep, voffA); PG8_STAGE(PG8_SB(1, 1), cB + hstep + kstep, voffB);
        PG8_WAIT_V(6); PG8_BAR;
    }
    for (;;) {
        const bool has_next = S.next(ui + 1, nxt);
        const char* nA = has_next ? (const char*)g.A + (size_t)nxt.pm * tstep : cA; const char* nB = has_next ? (const char*)g.Bt + (size_t)nxt.pn * tstep : cB;
        for (int t = 0; t < nt; t += 2) {
            const bool last = (t == nt - 2);
            const char* a1 = cA + (size_t)(t + 1) * kstep;
            const char* a2 = last ? nA : cA + (size_t)(t + 2) * kstep; const char* b2 = last ? nB : cB + (size_t)(t + 2) * kstep;
            const char* a3 = a2 + kstep; const char* b3 = b2 + kstep;
            if (last && has_next) S.a_ready(nxt);
            if constexpr (SP2) {
            PG8_LDB(B0, 0, 0); PG8_LDB(B1, 0, 1); PG8_SCHED; PG8_LDA(At, 0, 0); PG8_STAGE(PG8_SA(1, 1), a1 + hstep, voffA);
            PG8_WAIT_V(8); PG8_WAIT_L(0); PG8_BAR; PG8_MMA(0, 0, At, B0); PG8_MMA(0, 1, At, B1); PG8_BAR; PG8_SCHED;
            PG8_LDA(At, 0, 1); PG8_STAGE(PG8_SB(0, 0), b2, voffB); PG8_STAGE(PG8_SB(0, 1), b2 + hstep, voffB); PG8_STAGE(PG8_SA(0, 0), a2, voffA);
            PG8_WAIT_V(8); PG8_WAIT_L(0); PG8_BAR; PG8_MMA(1, 0, At, B0); PG8_MMA(1, 1, At, B1); PG8_BAR; PG8_SCHED;
            PG8_LDB(B0, 1, 0); PG8_LDB(B1, 1, 1); PG8_SCHED; PG8_LDA(At, 1, 0); PG8_STAGE(PG8_SA(0, 1), a2 + hstep, voffA);
            PG8_WAIT_V(8); PG8_WAIT_L(0); PG8_BAR; PG8_MMA(0, 0, At, B0); PG8_MMA(0, 1, At, B1); PG8_BAR; PG8_SCHED;
            PG8_LDA(At, 1, 1); PG8_STAGE(PG8_SB(1, 0), b3, voffB); PG8_STAGE(PG8_SB(1, 1), b3 + hstep, voffB); PG8_STAGE(PG8_SA(1, 0), a3, voffA);
            PG8_WAIT_V(8); PG8_WAIT_L(0); PG8_BAR; PG8_MMA(1, 0, At, B0); PG8_MMA(1, 1, At, B1); PG8_BAR; PG8_SCHED;
            } else {
            PG8_LDB(B0, 0, 0); PG8_SCHED; PG8_LDA(At, 0, 0); PG8_STAGE(PG8_SA(1, 1), a1 + hstep, voffA);
            PG8_WAIT_L(8); PG8_BAR; PG8_WAIT_L(0); PG8_MMA(0, 0, At, B0); PG8_BAR; PG8_SCHED;
            PG8_LDB(B1, 0, 1); PG8_STAGE(PG8_SB(0, 0), b2, voffB);
            PG8_BAR; PG8_WAIT_L(0); PG8_MMA(0, 1, At, B1); PG8_BAR;
            PG8_LDA(At, 0, 1); PG8_STAGE(PG8_SA(0, 0), a2, voffA);
            PG8_BAR; PG8_WAIT_L(0); PG8_MMA(1, 0, At, B0); PG8_BAR; PG8_SCHED;
            PG8_STAGE(PG8_SB(0, 1), b2 + hstep, voffB);
            PG8_WAIT_V(6); PG8_BAR; PG8_MMA(1, 1, At, B1); PG8_BAR;
            PG8_LDB(B0, 1, 0); PG8_SCHED; PG8_LDA(At, 1, 0); PG8_STAGE(PG8_SA(0, 1), a2 + hstep, voffA);
            PG8_WAIT_L(8); PG8_BAR; PG8_WAIT_L(0); PG8_MMA(0, 0, At, B0); PG8_BAR; PG8_SCHED;
            PG8_LDB(B1, 1, 1); PG8_STAGE(PG8_SB(1, 0), b3, voffB);
            PG8_BAR; PG8_WAIT_L(0); PG8_MMA(0, 1, At, B1); PG8_BAR;
            PG8_LDA(At, 1, 1); PG8_STAGE(PG8_SA(1, 0), a3, voffA);
            PG8_BAR; PG8_WAIT_L(0); PG8_MMA(1, 0, At, B0); PG8_BAR; PG8_SCHED;
            PG8_STAGE(PG8_SB(1, 1), b3 + hstep, voffB);
            PG8_WAIT_V(6); PG8_BAR; PG8_MMA(1, 1, At, B1); PG8_BAR;
            }
        }
        if constexpr (ALIGN_EPI) { if (wr == 0) PG8_BAR; }
        if constexpr (!Epi::AFTER_DRAIN) { E(acc, cur, wr, wc, fr, fq); S.done(cur); }
        if (!has_next) break;
#pragma unroll
        for (int a = 0; a < 2; ++a)
#pragma unroll
            for (int b = 0; b < 2; ++b)
#pragma unroll
                for (int m = 0; m < 4; ++m)
#pragma unroll
                    for (int n = 0; n < 2; ++n) acc[a][b][m][n] = (f32x4){0.f, 0.f, 0.f, 0.f};
        cur = nxt; cA = nA; cB = nB; ++ui;
        if constexpr (ALIGN_EPI) { if (wr == 1) PG8_BAR; }
    }
    PG8_WAIT_V(0);
    if constexpr (!ALIGN_EPI) { if (wr == 0) PG8_BAR; }
    PG8_BAR;
    if constexpr (Epi::AFTER_DRAIN) { E.fused(acc, cur, wr, wc, fr, fq, lds, wid, lane); S.done(cur); }
#undef PG8_SA
#undef PG8_SB
#undef PG8_STAGE
#undef PG8_LDA
#undef PG8_LDB
#undef PG8_MMA
#undef PG8_WAIT_V
#undef PG8_WAIT_L
#undef PG8_BAR
#undef PG8_SCHED
}
}

__device__ __forceinline__ int olane() { int l; asm volatile("v_mbcnt_lo_u32_b32 %0, -1, 0\n\tv_mbcnt_hi_u32_b32 %0, -1, %0" : "=v"(l)); return l; }
__device__ __forceinline__ int otid(int wv) { return wv * 64 + olane(); }
__device__ __forceinline__ int obid() { int b = blockIdx.x; asm volatile("" : "+s"(b)); return b; }
__device__ __forceinline__ int ogrid() { int g = gridDim.x; asm volatile("" : "+s"(g)); return g; }
__device__ __forceinline__ unsigned f2bf(float f) { unsigned u = __builtin_bit_cast(unsigned, f); return (u + 0x7fffu + ((u >> 16) & 1u)) >> 16; }
__device__ __forceinline__ unsigned pk2(float lo, float hi) { return f2bf(lo) | (f2bf(hi) << 16); }
__device__ __forceinline__ float bf2f(unsigned b) { return __builtin_bit_cast(float, b << 16); }

__device__ __forceinline__ void transpose_item(const float* W, int ld, int K, int N, bf16* WT, int map, int drow0, const float* gk, LAS float* scr, int item, int lane) {
    const int nblk = N / 32, kb = item / nblk, nb = item % nblk, k0 = 64 * kb, n0 = 32 * nb;
    int drow;
    if (map == 1) { const int hd = n0 / 96, d = n0 % 96; drow = (d < 64) ? hd * 64 + d : 1024 + hd * 32 + (d - 64); }
    else if (map == 2) { const int hd = n0 / 128, d = n0 % 128; drow = (d < 64) ? hd * 64 + d : 1024 + hd * 64 + (d - 64); }
    else drow = drow0 + n0;
    { const int kr = lane >> 3, c4 = lane & 7; f32x4 t[8];
#pragma unroll
      for (int i = 0; i < 8; ++i) t[i] = *(const f32x4*)(W + (size_t)(k0 + 8 * i + kr) * ld + n0 + 4 * c4);
#pragma unroll
      for (int i = 0; i < 8; ++i) { const int kk = 8 * i + kr; f32x4 v = t[i]; if (gk) v = v * gk[k0 + kk];
          LAS float* d = scr + kk * 33 + 4 * c4; d[0] = v[0]; d[1] = v[1]; d[2] = v[2]; d[3] = v[3]; } }
    asm volatile("s_waitcnt lgkmcnt(0)" ::: "memory");
    const int c = lane & 7;
#pragma unroll
    for (int j = 0; j < 4; ++j) { const int n = (lane >> 3) + 8 * j; const LAS float* s = scr + (8 * c) * 33 + n;
        u32x4 o; o.x = pk2(s[0 * 33], s[1 * 33]); o.y = pk2(s[2 * 33], s[3 * 33]); o.z = pk2(s[4 * 33], s[5 * 33]); o.w = pk2(s[6 * 33], s[7 * 33]);
        *(u32x4*)(WT + (size_t)(drow + n) * K + k0 + 8 * c) = o; }
    asm volatile("s_waitcnt lgkmcnt(0)" ::: "memory");
}

struct Params { const float* in[20]; float* out; unsigned char* ws; };
enum { I_X = 0, I_C, I_POS, I_ADAW, I_ADAB, I_GMIX, I_GMLP, I_FWIN, I_FBF, I_FWOUT, I_MDQ, I_MQG, I_MUQ, I_MDKV, I_MKVG, I_MUKV, I_MOUT, I_W1, I_W2, I_GFIN };

__device__ __forceinline__ void prologue(const Params& p, LAS unsigned char* lds, const int wv_) {
    const int BID = obid(), GSZ = ogrid(); const int tid_ = otid(wv_);
    const int tid = tid_, lane = tid & 63, wave = __builtin_amdgcn_readfirstlane(tid >> 6);
    unsigned char* ws = p.ws;
    {
        LAS float* cact = (LAS float*)lds;
        LAS float* part = (LAS float*)(lds + 65536);
        const float* c = p.in[I_C];
        for (int idx = tid; idx < NB * DM; idx += NTHR) { const int b = idx >> 10, k = idx & 1023; const float v = c[idx]; cact[k * 16 + b] = v / (1.0f + __expf(-v)); }
        __syncthreads();
        float* mod = (float*)(ws + WS_MOD);
        for (int item = BID; item < 4 * 48; item += GSZ) {
            const int l = item / 48, n0 = (item % 48) * 128, col = tid & 127, ks = tid >> 7;
            float acc[16];
#pragma unroll
            for (int b = 0; b < 16; ++b) acc[b] = 0.f;
            const float* wp = p.in[I_ADAW] + ((size_t)l * DM + ks * 256) * 6144 + n0 + col;
            const LAS f32x4* cp = (const LAS f32x4*)(cact + ks * 256 * 16);
#pragma unroll 8
            for (int k = 0; k < 256; ++k) { const float w = wp[(size_t)k * 6144];
                const f32x4 c0 = cp[k * 4 + 0], c1 = cp[k * 4 + 1], c2 = cp[k * 4 + 2], c3 = cp[k * 4 + 3];
                acc[0] += w * c0[0]; acc[1] += w * c0[1]; acc[2] += w * c0[2]; acc[3] += w * c0[3];
                acc[4] += w * c1[0]; acc[5] += w * c1[1]; acc[6] += w * c1[2]; acc[7] += w * c1[3];
                acc[8] += w * c2[0]; acc[9] += w * c2[1]; acc[10] += w * c2[2]; acc[11] += w * c2[3];
                acc[12] += w * c3[0]; acc[13] += w * c3[1]; acc[14] += w * c3[2]; acc[15] += w * c3[3]; }
#pragma unroll
            for (int b = 0; b < 16; ++b) part[(ks * 16 + b) * 128 + col] = acc[b];
            __syncthreads();
            for (int o = tid; o < 2048; o += NTHR) { const int b = o >> 7, cc = o & 127;
                const float s = (part[(0 * 16 + b) * 128 + cc] + part[(1 * 16 + b) * 128 + cc]) + (part[(2 * 16 + b) * 128 + cc] + part[(3 * 16 + b) * 128 + cc]);
                mod[((size_t)l * 16 + b) * 6144 + n0 + cc] = s + p.in[I_ADAB][(size_t)l * 6144 + n0 + cc]; }
            __syncthreads();
        }
    }
    __syncthreads();
    {
        const int* pos = (const int*)p.in[I_POS]; float* cst = (float*)(ws + WS_CS);
        for (size_t idx = (size_t)BID * NTHR + tid; idx < (size_t)M * 16; idx += (size_t)GSZ * NTHR) {
            const int tok = (int)(idx >> 4), i = (int)(idx & 15);
            const float invf = exp2f(-(float)i * (13.287712379549449f / 16.0f));
            const float ang = (float)pos[tok] * invf;
            double rev = (double)ang * 0.15915494309189535; rev -= __builtin_rint(rev);
            const float rf = (float)rev;
            cst[(size_t)tok * 32 + i] = __builtin_amdgcn_cosf(rf); cst[(size_t)tok * 32 + 16 + i] = __builtin_amdgcn_sinf(rf);
        }
    }
    for (int j = 0; j < 2; ++j) { u32x4* z = (u32x4*)(ws + WS_W + W_MLA + j * W_MLA_STRIDE + (size_t)416 * 1024 * 2);
        for (int idx = BID * NTHR + tid; idx < 96 * 1024 * 2 / 16; idx += GSZ * NTHR) z[idx] = (u32x4){0u, 0u, 0u, 0u}; }
    {
        LAS float* scr = (LAS float*)(lds + wave * 16384);
        const int gw = BID * NWAVE + wave, NGW = GSZ * NWAVE;
        constexpr int N_MLP = 4 * 4096, N_FOX = 2 * 2048, N_MLA = 2 * 1040;
        for (int it = gw; it < N_MLP + N_FOX + N_MLA; it += NGW) {
            int r = it;
            if (r < N_MLP) { const int l = r >> 12, rr = r & 4095; bf16* wb = (bf16*)(ws + WS_W + W_MLP + (size_t)l * W_MLP_STRIDE);
                if (rr < 2048) transpose_item(p.in[I_W1] + (size_t)l * DM * FF, FF, DM, FF, wb, 0, 0, nullptr, scr, rr, lane);
                else transpose_item(p.in[I_W2] + (size_t)l * DM * FF, DM, FF, DM, wb + (size_t)FF * DM, 0, 0, nullptr, scr, rr - 2048, lane);
                continue; }
            r -= N_MLP;
            if (r < N_FOX) { const int j = r >> 11, rr = r & 2047; bf16* wb = (bf16*)(ws + WS_W + W_FOX + (size_t)j * W_FOX_STRIDE);
                if (rr < 1536) transpose_item(p.in[I_FWIN] + (size_t)j * DM * 3088, 3088, DM, 3072, wb, 0, 0, nullptr, scr, rr, lane);
                else transpose_item(p.in[I_FWOUT] + (size_t)j * DM * DM, DM, DM, DM, wb + (size_t)3072 * DM, 0, 0, nullptr, scr, rr - 1536, lane);
                continue; }
            r -= N_FOX;
            { const int j = r / 1040, rr = r % 1040; bf16* wb = (bf16*)(ws + WS_W + W_MLA + (size_t)j * W_MLA_STRIDE);
                if (rr < 128) transpose_item(p.in[I_MDQ] + (size_t)j * DM * 256, 256, DM, 256, wb, 0, 0, nullptr, scr, rr, lane);
                else if (rr < 208) transpose_item(p.in[I_MDKV] + (size_t)j * DM * 160, 160, DM, 160, wb, 0, 256, nullptr, scr, rr - 128, lane);
                else if (rr < 400) transpose_item(p.in[I_MUQ] + (size_t)j * 256 * 1536, 1536, 256, 1536, wb + (size_t)512 * 1024, 1, 0, p.in[I_MQG] + j * 256, scr, rr - 208, lane);
                else if (rr < 528) transpose_item(p.in[I_MUKV] + (size_t)j * 128 * 2048, 2048, 128, 2048, wb + (size_t)512 * 1024 + (size_t)1536 * 256, 2, 0, p.in[I_MKVG] + j * 128, scr, rr - 400, lane);
                else transpose_item(p.in[I_MOUT] + (size_t)j * DM * DM, DM, DM, DM, (bf16*)((unsigned char*)wb + 3 * MiB), 0, 0, nullptr, scr, rr - 528, lane);
            }
        }
    }
}

template <int NR, bool gates>
__device__ __forceinline__ void norm_phase(const void* xv, const bool xbf, const float* g, const float* sh0, const float* sc0, bf16* hout, const float* wfsrc, const float* bfv, float* lf, LAS unsigned char* lds, const int wv_) {
    const int BID = obid(), GSZ = ogrid(); const int tid_ = otid(wv_);
    const int tid = tid_, lane = tid & 63, wave = __builtin_amdgcn_readfirstlane(tid >> 6);
    LAS float* wfs = (LAS float*)lds;
    if constexpr (gates) {
        for (int idx = tid; idx < 16 * 1024; idx += NTHR) { const int k = idx >> 4, j = idx & 15; wfs[j * 1024 + k] = wfsrc[(size_t)k * 3088 + 3072 + j]; }
        __syncthreads();
    }
    const int gw = BID * NWAVE + wave, NGW = GSZ * NWAVE;
    for (int row0 = gw * NR; row0 < M; row0 += NGW * NR) {
        const int b = row0 >> 11;
        f32x4 v[NR][4]; float ss[NR];
        if (xbf) {
#pragma unroll
            for (int r = 0; r < NR; ++r) { const u32x2* xr = (const u32x2*)((const bf16*)xv + (size_t)(row0 + r) * DM) + lane;
#pragma unroll
                for (int j = 0; j < 4; ++j) { const u32x2 w = xr[64 * j];
                    v[r][j] = (f32x4){__builtin_bit_cast(float, w.x << 16), __builtin_bit_cast(float, w.x & 0xffff0000u), __builtin_bit_cast(float, w.y << 16), __builtin_bit_cast(float, w.y & 0xffff0000u)}; } }
        } else {
#pragma unroll
            for (int r = 0; r < NR; ++r) { const f32x4* xr = (const f32x4*)((const float*)xv + (size_t)(row0 + r) * DM) + lane;
#pragma unroll
                for (int j = 0; j < 4; ++j) v[r][j] = xr[64 * j]; }
        }
#pragma unroll
        for (int r = 0; r < NR; ++r) { float s = 0.f;
#pragma unroll
            for (int j = 0; j < 4; ++j) s += (v[r][j][0] * v[r][j][0] + v[r][j][1] * v[r][j][1]) + (v[r][j][2] * v[r][j][2] + v[r][j][3] * v[r][j][3]);
            ss[r] = s; }
#pragma unroll
        for (int r = 0; r < NR; ++r) ss[r] = wave_sum(ss[r]);
        const f32x4* gp = (const f32x4*)g + lane; const f32x4* shp = (const f32x4*)(sh0 + (size_t)b * 6144) + lane; const f32x4* scp = (const f32x4*)(sc0 + (size_t)b * 6144) + lane;
#pragma unroll
        for (int j = 0; j < 4; ++j) { const f32x4 aa = gp[64 * j] * (scp[64 * j] + 1.0f), sh = shp[64 * j];
#pragma unroll
            for (int r = 0; r < NR; ++r) { const float rstd = __builtin_amdgcn_rsqf(ss[r] * (1.0f / DM) + EPS);
                v[r][j] = (v[r][j] * rstd) * aa + sh;
                u32x2 w; w.x = pk2(v[r][j][0], v[r][j][1]); w.y = pk2(v[r][j][2], v[r][j][3]); ((u32x2*)(hout + (size_t)(row0 + r) * DM) + lane)[64 * j] = w; } }
        if constexpr (gates) {
            static_assert(NR == 2, "the gate path pairs two rows in f32x2");
            f32x2 vv[4][4], z[16];
#pragma unroll
            for (int jj = 0; jj < 4; ++jj)
#pragma unroll
                for (int e = 0; e < 4; ++e) vv[jj][e] = (f32x2){v[0][jj][e], v[1][jj][e]};
#pragma unroll
            for (int jg = 0; jg < 16; ++jg) {
                f32x2 acc = (f32x2){0.f, 0.f};
#pragma unroll
                for (int jj = 0; jj < 4; ++jj) { const f32x4 w = *(const LAS f32x4*)(wfs + jg * 1024 + 256 * jj + 4 * lane);
                    acc += (vv[jj][0] * w[0] + vv[jj][1] * w[1]) + (vv[jj][2] * w[2] + vv[jj][3] * w[3]); }
                z[jg] = acc;
                if (jg & 1) asm volatile("" ::: "memory"); }
            const bool b5 = (lane & 32) != 0, b4 = (lane & 16) != 0, b3 = (lane & 8) != 0, b2 = (lane & 4) != 0;
            f32x2 a8[8], a4[4], a2[2], a1;
#pragma unroll
            for (int i = 0; i < 8; ++i) { const f32x2 send = b5 ? z[i] : z[i + 8], keep = b5 ? z[i + 8] : z[i]; a8[i] = keep + (f32x2){xor_get<32>(send[0], b5), xor_get<32>(send[1], b5)}; }
#pragma unroll
            for (int i = 0; i < 4; ++i) { const f32x2 send = b4 ? a8[i] : a8[i + 4], keep = b4 ? a8[i + 4] : a8[i]; a4[i] = keep + (f32x2){xor_get<16>(send[0], b4), xor_get<16>(send[1], b4)}; }
#pragma unroll
            for (int i = 0; i < 2; ++i) { const f32x2 send = b3 ? a4[i] : a4[i + 2], keep = b3 ? a4[i + 2] : a4[i]; a2[i] = keep + (f32x2){xor_get<8>(send[0], b3), xor_get<8>(send[1], b3)}; }
            { const f32x2 send = b2 ? a2[0] : a2[1], keep = b2 ? a2[1] : a2[0]; a1 = keep + (f32x2){xor_get<4>(send[0], b2), xor_get<4>(send[1], b2)}; }
            a1 = (f32x2){xor_sum<2>(a1[0]), xor_sum<2>(a1[1])}; a1 = (f32x2){xor_sum<1>(a1[0]), xor_sum<1>(a1[1])};
            const int gate = (b5 ? 8 : 0) + (b4 ? 4 : 0) + (b3 ? 2 : 0) + (b2 ? 1 : 0);
            if ((lane & 3) == 0) { const float bb = bfv[gate];
#pragma unroll
                for (int r = 0; r < NR; ++r) { const float zz = a1[r] + bb; lf[(size_t)(row0 + r) * 16 + gate] = fminf(zz, 0.f) - __logf(1.0f + __expf(-fabsf(zz))); } }
        }
    }
}

__device__ __forceinline__ void final_norm(const bf16* xb, float* out, const float* g, const int wv_) {
    constexpr int NR = 4;
    const int BID = obid(), GSZ = ogrid(); const int tid_ = otid(wv_);
    const int tid = tid_, lane = tid & 63, wave = __builtin_amdgcn_readfirstlane(tid >> 6);
    const int gw = BID * NWAVE + wave, NGW = GSZ * NWAVE;
    for (int row0 = gw * NR; row0 < M; row0 += NGW * NR) {
        f32x4 v[NR][4]; float ss[NR];
#pragma unroll
        for (int r = 0; r < NR; ++r) { const u32x2* xr = (const u32x2*)(xb + (size_t)(row0 + r) * DM) + lane;
#pragma unroll
            for (int j = 0; j < 4; ++j) { const u32x2 w = xr[64 * j];
                v[r][j] = (f32x4){__builtin_bit_cast(float, w.x << 16), __builtin_bit_cast(float, w.x & 0xffff0000u), __builtin_bit_cast(float, w.y << 16), __builtin_bit_cast(float, w.y & 0xffff0000u)}; } }
#pragma unroll
        for (int r = 0; r < NR; ++r) { float s = 0.f;
#pragma unroll
            for (int j = 0; j < 4; ++j) s += (v[r][j][0] * v[r][j][0] + v[r][j][1] * v[r][j][1]) + (v[r][j][2] * v[r][j][2] + v[r][j][3] * v[r][j][3]);
            ss[r] = wave_sum(s); }
        const f32x4* gp = (const f32x4*)g + lane;
#pragma unroll
        for (int j = 0; j < 4; ++j) { const f32x4 gg = gp[64 * j];
#pragma unroll
            for (int r = 0; r < NR; ++r) { const float rstd = __builtin_amdgcn_rsqf(ss[r] * (1.0f / DM) + EPS); ((f32x4*)(out + (size_t)(row0 + r) * DM) + lane)[64 * j] = (v[r][j] * rstd) * gg; } }
    }
}

__device__ __forceinline__ void fox_cumsum(const float* lf, bf16* Qb, bf16* Kb, LAS unsigned char* lds, const int wv_) {
    const int BID = obid(), GSZ = ogrid(); const int tid_ = otid(wv_);
    const int tid = tid_, lane = tid & 63, wave = __builtin_amdgcn_readfirstlane(tid >> 6);
    LAS float* wtot = (LAS float*)lds;
    for (int bh = BID; bh < NB * NH; bh += GSZ) {
        const int b = bh >> 4, h = bh & 15; const int s0 = 4 * tid;
        float a[4];
#pragma unroll
        for (int i = 0; i < 4; ++i) a[i] = lf[((size_t)(b * SEQ + s0 + i)) * 16 + h];
        a[1] += a[0]; a[2] += a[1]; a[3] += a[2];
        float xs = a[3];
#pragma unroll
        for (int off = 1; off < 64; off <<= 1) { const float t = __shfl_up(xs, off); if (lane >= off) xs += t; }
        if (lane == 63) wtot[wave] = xs;
        __syncthreads();
        float base = 0.f;
#pragma unroll
        for (int w = 0; w < NWAVE; ++w) { const float t = wtot[w]; if (w < wave) base += t; }
        const float excl = xs - a[3] + base;
#pragma unroll
        for (int i = 0; i < 4; ++i) {
            const float F = (a[i] + excl) * LOG2E;
            const unsigned fh = f2bf(F); const float r1 = F - bf2f(fh); const unsigned fm = f2bf(r1); const float r2 = r1 - bf2f(fm); const unsigned fl = f2bf(r2);
            const size_t tok = (size_t)(b * SEQ + s0 + i);
            u32x4* qd = (u32x4*)(Qb + tok * 1280 + h * 80 + 64); u32x4* kd = (u32x4*)(Kb + tok * 1280 + h * 80 + 64);
            unsigned zz = 0u; asm volatile("" : "+v"(zz));
            qd[0] = (u32x4){0x3F803F80u, 0x3F80u | (fh << 16), fm | (fl << 16), zz}; qd[1] = (u32x4){zz, zz, zz, zz};
            kd[0] = (u32x4){(fh ^ 0x8000u) | ((fm ^ 0x8000u) << 16), (fl ^ 0x8000u) | (0x3F80u << 16), 0x3F803F80u, zz}; kd[1] = (u32x4){zz, zz, zz, zz};
        }
        __syncthreads();
    }
}

constexpr int PTR_OFF = 131072;
__device__ __forceinline__ int crow(int r, int hi) { return (r & 3) + 8 * (r >> 2) + 4 * hi; }
__device__ __forceinline__ unsigned cvtpk(float lo, float hi) { typedef __bf16 bf16x2_t __attribute__((ext_vector_type(2))); f32x2 v = {lo, hi}; bf16x2_t b = __builtin_convertvector(v, bf16x2_t); return __builtin_bit_cast(unsigned, b); }
typedef short v4i16_t __attribute__((ext_vector_type(4)));
__device__ __forceinline__ s16x4 vtr(const LAS unsigned char* p) { return __builtin_bit_cast(s16x4, __builtin_amdgcn_ds_read_tr16_b64_v4i16((LAS v4i16_t*)p)); }
#define MFMA32(a, b, c) __builtin_amdgcn_mfma_f32_32x32x16_bf16((a), (b), (c), 0, 0, 0)

template <int NKS>
__device__ __forceinline__ void attn_phase(LAS unsigned char* lds, const bf16* Q_, const bf16* K_, const bf16* V_, bf16* O_, const int wv_) {
    constexpr int QKD = 16 * NKS, QP = 16 * QKD, RS = QKD * 2 + 16, KCH = QKD / 8, NKC = 64 * KCH;
    constexpr int KB_BYTES = 64 * RS, L_K = 0, L_V = 2 * KB_BYTES, L_WS = L_V + 2 * 8192, L_ST = L_WS + NWAVE * 128;
    constexpr float THR = 20.0f;
    static_assert(L_ST + NWAVE * 4096 <= PTR_OFF, "attention LDS");
    typedef __attribute__((address_space(1))) const bf16 gcb; typedef __attribute__((address_space(1))) bf16 gb;
    gcb* Q = (gcb*)Q_; gcb* K = (gcb*)K_; gcb* V = (gcb*)V_; gb* O = (gb*)O_;
    const int BID = obid(), GSZ = ogrid(); const int tid_ = otid(wv_);
    const int tid = tid_, lane = tid & 63, r32 = lane & 31, hi = lane >> 5; const int wid = __builtin_amdgcn_readfirstlane(tid >> 6);
    LAS float* wsf = (LAS float*)(lds + L_WS) + wid * 32;
    LAS bf16* stg = (LAS bf16*)(lds + L_ST) + wid * 2048;
    constexpr int KCP = KCH + 1, NCHK = 64 * KCP; static_assert(NCHK % 64 == 0 && NCHK <= 1024, "K image is a whole number of 1 KiB pieces");
    const bool has1 = (wid + 8) * 64 < NCHK;
    const int ca = wid * 64 + lane, cb = has1 ? ca + 512 : ca;
    const unsigned kgo0 = (unsigned)((ca / KCP) * QP + ((ca % KCP) < KCH ? (ca % KCP) : 0) * 8), kgo1 = (unsigned)((cb / KCP) * QP + ((cb % KCP) < KCH ? (cb % KCP) : 0) * 8);
    const int vr = ca >> 3, vp = ca & 7; const unsigned vgo = (unsigned)(vr * DM + ((((vp >> 2) ^ ((vr >> 1) & 1)) << 2) | (vp & 3)) * 8);
    const int kd0 = wid * 1024, kd1 = (wid + 8) * 1024, vd = wid * 1024;
    const int kfb = r32 * RS + hi * 16;
    const int i16 = lane & 15, qq = i16 >> 2, pp = i16 & 3, blk = (lane >> 4) & 1, swz = (qq >> 1) & 1;
    const int vfb0 = (4 * hi + qq) * 128 + 32 * blk + 8 * pp + swz * 64, vfb1 = (4 * hi + qq) * 128 + 32 * blk + 8 * pp + (swz ^ 1) * 64;
#define A_GLDS(GP, LOFF) do { unsigned keep_; const unsigned ldst_ = (unsigned)__builtin_amdgcn_readfirstlane((int)(unsigned)(size_t)(lds + (LOFF))); \
        asm volatile("s_mov_b32 %0, m0\n\ts_mov_b32 m0, %2\n\ts_nop 0\n\tglobal_load_lds_dwordx4 %1, off\n\ts_mov_b32 m0, %0" : "=&s"(keep_) : "v"(GP), "s"(ldst_) : "memory"); } while (0)
#define A_DMAK(t, buf) do { gcb* Kt_ = Kh + (size_t)((unsigned)(t) * 64u) * QP; asm volatile("" : "+s"(Kt_)); A_GLDS(Kt_ + kgo0, L_K + (buf) * KB_BYTES + kd0); \
        if (has1) A_GLDS(Kt_ + kgo1, L_K + (buf) * KB_BYTES + kd1); } while (0)
#define A_DMAV(t, buf) do { gcb* Vt_ = Vh + (size_t)((unsigned)(t) * 64u) * DM; asm volatile("" : "+s"(Vt_)); A_GLDS(Vt_ + vgo, L_V + (buf) * 8192 + vd); } while (0)
#define A_DMAWAIT() asm volatile("s_waitcnt vmcnt(0)" ::: "memory")
#define A_QK(P0, P1, buf, CINIT) do { const LAS unsigned char* Kl_ = lds + L_K + (buf) * KB_BYTES + kfb; \
        bf16x8 a0_ = *(const LAS bf16x8*)(Kl_), a1_ = *(const LAS bf16x8*)(Kl_ + 32 * RS); \
        _Pragma("unroll") for (int ks = 0; ks < NKS; ++ks) { bf16x8 n0_ = a0_, n1_ = a1_; \
            if (ks + 1 < NKS) { n0_ = *(const LAS bf16x8*)(Kl_ + (ks + 1) * 32); n1_ = *(const LAS bf16x8*)(Kl_ + 32 * RS + (ks + 1) * 32); } \
            if (ks == 0) { P0 = MFMA32(a0_, qr[0], CINIT); P1 = MFMA32(a1_, qr[0], CINIT); } else { P0 = MFMA32(a0_, qr[ks], P0); P1 = MFMA32(a1_, qr[ks], P1); } \
            a0_ = n0_; a1_ = n1_; } } while (0)
#define A_VRD(kk, L0, H0, L1, H1) do { L0 = vtr(Vl_ + vfb0 + (kk) * 2048); H0 = vtr(Vl_ + vfb0 + (kk) * 2048 + 1024); L1 = vtr(Vl_ + vfb1 + (kk) * 2048); H1 = vtr(Vl_ + vfb1 + (kk) * 2048 + 1024); } while (0)
#define A_PV(buf) do { const LAS unsigned char* Vl_ = lds + L_V + (buf) * 8192; s16x4 l0_, h0_, l1_, h1_; A_VRD(0, l0_, h0_, l1_, h1_); \
        _Pragma("unroll") for (int kk = 0; kk < 4; ++kk) { s16x4 nl0_ = l0_, nh0_ = h0_, nl1_ = l1_, nh1_ = h1_; \
            if (kk + 1 < 4) A_VRD(kk + 1, nl0_, nh0_, nl1_, nh1_); \
            const bf16x8 b0_ = (bf16x8){l0_[0], l0_[1], l0_[2], l0_[3], h0_[0], h0_[1], h0_[2], h0_[3]}, b1_ = (bf16x8){l1_[0], l1_[1], l1_[2], l1_[3], h1_[0], h1_[1], h1_[2], h1_[3]}; \
            o0 = MFMA32(PAp[kk], b0_, o0); o1 = MFMA32(PAp[kk], b1_, o1); \
            l0_ = nl0_; h0_ = nh0_; l1_ = nl1_; h1_ = nh1_; } } while (0)
#define A_MASK(t) do { const int kb0_ = 64 * (t) + 4 * hi; \
        _Pragma("unroll") for (int i = 0; i < 16; ++i) { const int kv_ = kb0_ + (i & 3) + 8 * (i >> 2); if (kv_ > qabs) pc0[i] = -INFINITY; if (kv_ + 32 > qabs) pc1[i] = -INFINITY; } } while (0)
#define A_ROWMAX(RM) do { float a_ = __builtin_fmaxf(__builtin_fmaxf(pc0[0], pc0[1]), pc1[0]), b_ = __builtin_fmaxf(__builtin_fmaxf(pc0[2], pc0[3]), pc1[1]); a_ = __builtin_fmaxf(__builtin_fmaxf(a_, pc1[2]), pc1[3]); \
        _Pragma("unroll") for (int r = 4; r < 16; r += 4) { a_ = __builtin_fmaxf(__builtin_fmaxf(a_, pc0[r]), pc0[r + 1]); b_ = __builtin_fmaxf(__builtin_fmaxf(b_, pc0[r + 2]), pc0[r + 3]); \
            a_ = __builtin_fmaxf(__builtin_fmaxf(a_, pc1[r]), pc1[r + 1]); b_ = __builtin_fmaxf(__builtin_fmaxf(b_, pc1[r + 2]), pc1[r + 3]); } \
        RM = __builtin_fmaxf(a_, b_); { auto rr_ = __builtin_amdgcn_permlane32_swap(__float_as_uint(RM), __float_as_uint(RM), false, false); RM = __builtin_fmaxf(__uint_as_float(rr_[0]), __uint_as_float(rr_[1])); } } while (0)
#define A_EXPPACK() do { float ls_ = 0.f; \
        _Pragma("unroll") for (int i = 0; i < 16; ++i) { pc0[i] = __builtin_amdgcn_exp2f(pc0[i]); pc1[i] = __builtin_amdgcn_exp2f(pc1[i]); ls_ += pc0[i] + pc1[i]; } \
        lrow += ls_; u32x4 w_; \
        w_ = (u32x4){cvtpk(pc0[0], pc0[1]), cvtpk(pc0[2], pc0[3]), cvtpk(pc0[4], pc0[5]), cvtpk(pc0[6], pc0[7])}; PAc[0] = __builtin_bit_cast(bf16x8, w_); \
        w_ = (u32x4){cvtpk(pc0[8], pc0[9]), cvtpk(pc0[10], pc0[11]), cvtpk(pc0[12], pc0[13]), cvtpk(pc0[14], pc0[15])}; PAc[1] = __builtin_bit_cast(bf16x8, w_); \
        w_ = (u32x4){cvtpk(pc1[0], pc1[1]), cvtpk(pc1[2], pc1[3]), cvtpk(pc1[4], pc1[5]), cvtpk(pc1[6], pc1[7])}; PAc[2] = __builtin_bit_cast(bf16x8, w_); \
        w_ = (u32x4){cvtpk(pc1[8], pc1[9]), cvtpk(pc1[10], pc1[11]), cvtpk(pc1[12], pc1[13]), cvtpk(pc1[14], pc1[15])}; PAc[3] = __builtin_bit_cast(bf16x8, w_); } while (0)
#define A_VALU(t, BAND) do { if (BAND) A_MASK(t); float rm_; A_ROWMAX(rm_); rm_ -= mrow; upd = __any(rm_ > THR); \
        if (upd) { const float dl_ = __builtin_fmaxf(rm_, 0.f); mrow += dl_; \
            fsc = __builtin_amdgcn_exp2f(-dl_); lrow *= fsc; } \
        _Pragma("unroll") for (int i = 0; i < 16; ++i) { pc0[i] -= mrow; pc1[i] -= mrow; } \
        A_EXPPACK(); } while (0)
#define A_KRD(ks) do { kf_[2 * (ks)] = *(const LAS bf16x8*)(Kl_ + (ks) * 32); kf_[2 * (ks) + 1] = *(const LAS bf16x8*)(Kl_ + 32 * RS + (ks) * 32); } while (0)
#define A_MFMA(t, DOQK, DOPV) do { const LAS unsigned char* Kl_ = lds + L_K + (((t) + 1) & 1) * KB_BYTES + kfb; const LAS unsigned char* Vl_ = lds + L_V + (((t) - 1) & 1) * 8192; \
        s16x4 vl0_[4], vh0_[4], vl1_[4], vh1_[4]; \
        if (DOQK) { bf16x8 kf_[2 * NKS]; \
            A_KRD(0); A_KRD(1); \
            __builtin_amdgcn_sched_barrier(0); \
            _Pragma("unroll") for (int ks = 0; ks < NKS; ++ks) { \
                if (ks == 0) { pn0 = MFMA32(kf_[0], qr[0], ((f32x16)(0.0f))); pn1 = MFMA32(kf_[1], qr[0], ((f32x16)(0.0f))); } \
                else { pn0 = MFMA32(kf_[2 * ks], qr[ks], pn0); pn1 = MFMA32(kf_[2 * ks + 1], qr[ks], pn1); } \
                if (ks + 2 < NKS) A_KRD(ks + 2); \
                if (ks >= NKS - 2) A_VRD(ks - (NKS - 2), vl0_[ks - (NKS - 2)], vh0_[ks - (NKS - 2)], vl1_[ks - (NKS - 2)], vh1_[ks - (NKS - 2)]); \
                __builtin_amdgcn_sched_barrier(0); } } \
        else if (DOPV) { A_VRD(0, vl0_[0], vh0_[0], vl1_[0], vh1_[0]); A_VRD(1, vl0_[1], vh0_[1], vl1_[1], vh1_[1]); } \
        if (DOPV) { \
            _Pragma("unroll") for (int kk = 0; kk < 4; ++kk) { \
                const bf16x8 b0_ = (bf16x8){vl0_[kk][0], vl0_[kk][1], vl0_[kk][2], vl0_[kk][3], vh0_[kk][0], vh0_[kk][1], vh0_[kk][2], vh0_[kk][3]}; \
                const bf16x8 b1_ = (bf16x8){vl1_[kk][0], vl1_[kk][1], vl1_[kk][2], vl1_[kk][3], vh1_[kk][0], vh1_[kk][1], vh1_[kk][2], vh1_[kk][3]}; \
                o0 = MFMA32(PAp[kk], b0_, o0); o1 = MFMA32(PAp[kk], b1_, o1); \
                if (kk + 2 < 4) A_VRD(kk + 2, vl0_[kk + 2], vh0_[kk + 2], vl1_[kk + 2], vh1_[kk + 2]); \
                __builtin_amdgcn_sched_barrier(0); } } } while (0)
    const bool teamed = (GSZ == 256);
    const int xcd = BID & 7, slot = BID >> 3, team = slot >> 3, mem = slot & 7;
#ifdef PROBE_AT
    unsigned long long pacc = 0, pt0 = 0;
#define PT_BEG(C) do { if (PROBE_AT == (C)) pt0 = __builtin_amdgcn_s_memtime(); } while (0)
#define PT_END(C) do { if (PROBE_AT == (C)) pacc += __builtin_amdgcn_s_memtime() - pt0; } while (0)
#else
#define PT_BEG(C) do {} while (0)
#define PT_END(C) do {} while (0)
#endif
    const int nit = teamed ? 8 : 8 * ((NB * NH - BID + GSZ - 1) / GSZ);
#define A_UNIT(i, BH, QB) do { if (teamed) { BH = (xcd * 4 + team) * 8 + (i); QB = (mem + (i)) & 7; } else { BH = BID + ((i) >> 3) * GSZ; QB = 7 - ((i) & 7); } } while (0)
    bf16x8 qr[NKS];
#define A_PREFETCH(i) do { int bh_, qb_; A_UNIT(i, bh_, qb_); const size_t rb_ = (size_t)(bh_ >> 4) * SEQ; const int h_ = bh_ & 15; \
        gcb* Kh = K + rb_ * QP + h_ * QKD; gcb* Vh = V + rb_ * DM + h_ * 64; gcb* Qu_ = Q + (rb_ + qb_ * 256 + wid * 32) * QP + h_ * QKD; \
        unsigned qgo_; { int lq = lane; asm volatile("" : "+v"(lq)); qgo_ = (unsigned)((lq & 31) * QP + (lq >> 5) * 8); } \
        _Pragma("unroll") for (int ks = 0; ks < NKS; ++ks) qr[ks] = *(const __attribute__((address_space(1))) bf16x8*)(Qu_ + qgo_ + ks * 16); \
        A_DMAK(0, 0); A_DMAV(0, 0); A_DMAK(1, 1); } while (0)
    if (nit > 0) A_PREFETCH(0);
    for (int it = 0; it < nit; ++it) {
        int bh, qb; A_UNIT(it, bh, qb);
        const int b = bh >> 4, h = bh & 15; const size_t rowbase = (size_t)b * SEQ;
        gcb* Kh = K + rowbase * QP + h * QKD; gcb* Vh = V + rowbase * DM + h * 64;
        {
            const int q0 = qb * 256; const int NT = 4 * qb + 4;
            PT_BEG('U');
            const int qabs = q0 + wid * 32 + r32; const int Tw = 4 * qb + (wid >> 1);
            A_DMAWAIT(); __syncthreads();
            f32x16 pc0, pc1, pn0, pn1, o0 = (f32x16)(0.0f), o1 = (f32x16)(0.0f);
            A_QK(pc0, pc1, 0, ((f32x16)(0.0f))); A_QK(pn0, pn1, 1, ((f32x16)(0.0f)));
            bf16x8 PAp[4], PAc[4]; float mrow, lrow = 0.f, fsc = 1.f; bool upd = false;
            { if (NT == 4) A_MASK(0);
              float rm_; A_ROWMAX(rm_); mrow = rm_;
#pragma unroll
              for (int i = 0; i < 16; ++i) { pc0[i] -= mrow; pc1[i] -= mrow; }
              A_EXPPACK(); }
#pragma unroll
            for (int k4 = 0; k4 < 4; ++k4) PAp[k4] = PAc[k4];
            pc0 = pn0; pc1 = pn1;
            __syncthreads();
            A_DMAK(2, 0);
            A_DMAWAIT(); __syncthreads();
            PT_END('U');
            for (int t = 1; t < NT; ++t) {
                if (t + 2 < NT) A_DMAK(t + 2, t & 1);
                A_DMAV(t, t & 1);
                const bool band = (t >= NT - 4);
                const bool doqk = (t + 1 <= Tw), dopv = (t - 1 <= Tw), dova = (t <= Tw);
                A_MFMA(t, doqk, dopv);
                if (dova) { A_VALU(t, band); } else { upd = false; }
                if (upd) {
                    if (hi == 0) wsf[r32] = fsc;
                    asm volatile("" ::: "memory");
#pragma unroll
                    for (int g4 = 0; g4 < 4; ++g4) { const f32x4 a = *(const LAS f32x4*)(wsf + 8 * g4 + 4 * hi);
#pragma unroll
                        for (int j = 0; j < 4; ++j) { o0[4 * g4 + j] *= a[j]; o1[4 * g4 + j] *= a[j]; } }
                    asm volatile("" ::: "memory");
                }
                A_DMAWAIT(); __syncthreads();
                pc0 = pn0; pc1 = pn1;
#pragma unroll
                for (int k4 = 0; k4 < 4; ++k4) PAp[k4] = PAc[k4];
            }
            PT_BEG('U');
            { const int inx = (it + 1 < nit) ? it + 1 : it; A_PREFETCH(inx); }
            if (NT - 1 <= Tw) { A_PV((NT - 1) & 1); }
            lrow = xor_sum<32>(lrow);
            { int le = lane; asm volatile("" : "+v"(le));
              const int r32e = le & 31, hie = le >> 5;
              if (hie == 0) wsf[r32e] = 1.0f / lrow;
              asm volatile("" ::: "memory");
              LAS bf16* st0 = stg + (4 * hie) * 64 + r32e;
#pragma unroll
              for (int g4 = 0; g4 < 4; ++g4) { const f32x4 a = *(const LAS f32x4*)(wsf + 8 * g4 + 4 * hie);
#pragma unroll
                  for (int j = 0; j < 4; ++j) { const int i = 4 * g4 + j;
                      st0[(8 * g4 + j) * 64] = (bf16)f2bf(o0[i] * a[j]); st0[(8 * g4 + j) * 64 + 32] = (bf16)f2bf(o1[i] * a[j]); } }
              asm volatile("s_waitcnt lgkmcnt(0)" ::: "memory");
              const unsigned lo_ = (unsigned)((le >> 3) * DM + (le & 7) * 8); const LAS bf16* sr0 = stg + (le >> 3) * 64 + (le & 7) * 8;
#pragma unroll
              for (int i = 0; i < 4; ++i) { gb* Ow = O + (rowbase + q0 + wid * 32 + i * 8) * DM + h * 64; const u32x4 v = *(const LAS u32x4*)(sr0 + i * 8 * 64); *(__attribute__((address_space(1))) u32x4*)(Ow + lo_) = v; } }
            A_DMAWAIT(); __syncthreads();
            PT_END('U');
        }
    }
#ifdef PROBE_AT
    { const unsigned long long w0 = __builtin_amdgcn_s_memtime(); while (__builtin_amdgcn_s_memtime() - w0 < pacc) __builtin_amdgcn_s_sleep(4); }
#endif
#undef PT_BEG
#undef PT_END
#undef A_GLDS
#undef A_UNIT
#undef A_PREFETCH
#undef A_DMAK
#undef A_DMAV
#undef A_DMAWAIT
#undef A_QK
#undef A_PV
#undef A_VRD
#undef A_MASK
#undef A_ROWMAX
#undef A_EXPPACK
#undef A_VALU
#undef A_MFMA
#undef A_KRD
}

#define XB_TMO      128
#define XB_XCNT(j)  (256  + 64 * (j))
#define XB_XSUB(j)  (1280 + 64 * (j))
#define XB_XGEN(j)  (2304 + 64 * (j))
#define XB_TOP      3328
#define XB_TOPGEN   3392
#define XCD_BAR_WORDS 3456
#define XB_SPIN_CAP (1u << 18)

__device__ __forceinline__ unsigned xb_ld(unsigned* p)              { return __hip_atomic_load(p, __ATOMIC_RELAXED, __HIP_MEMORY_SCOPE_AGENT); }
__device__ __forceinline__ unsigned xb_add(unsigned* p, unsigned v) { return __hip_atomic_fetch_add(p, v, __ATOMIC_RELAXED, __HIP_MEMORY_SCOPE_AGENT); }
__device__ __forceinline__ unsigned xb_xcc_id() { return (unsigned)__builtin_amdgcn_s_getreg((3 << 11) | 20) & 0xFu; }
#define XB_SPIN(cond, bar) do { unsigned _sp = 0; while (cond) { __builtin_amdgcn_s_sleep(1); \
    if ((++_sp & 255u) == 0u) { if (xb_ld(&(bar)[XB_TMO])) break; if (_sp > XB_SPIN_CAP) { atomicAdd(&(bar)[XB_TMO], 1u); break; } } } } while (0)

struct XcdBarrier {
    unsigned* bar; unsigned x;
    volatile LAS unsigned* st;
};

__device__ __forceinline__ XcdBarrier xcd_barrier_post(unsigned* bar, volatile LAS unsigned* st, const int wv_) {
    XcdBarrier b; b.bar = bar; b.x = xb_xcc_id(); b.st = st;
    if (otid(wv_) == 0) (void)xb_add(&bar[XB_XCNT(b.x)], 1u);
    return b;
}
__device__ __forceinline__ void xcd_barrier_complete(unsigned* bar, unsigned x, unsigned& nloc, unsigned& nx) {
    const unsigned G = gridDim.x * gridDim.y * gridDim.z;
    unsigned sum, cnt, mine, sp = 0u;
    for (;;) {
        sum = 0u; cnt = 0u; mine = 0u;
#pragma unroll
        for (unsigned j = 0; j < 16; ++j) { const unsigned c = xb_ld(&bar[XB_XCNT(j)]); sum += c; cnt += (c > 0u) ? 1u : 0u; mine = (j == x) ? c : mine; }
        if (sum == G) break;
        __builtin_amdgcn_s_sleep(1);
        if ((++sp & 255u) == 0u) { if (xb_ld(&bar[XB_TMO])) break; if (sp > XB_SPIN_CAP) { atomicAdd(&bar[XB_TMO], 1u); break; } }
    }
    nloc = mine > 0u ? mine : 1u; nx = cnt > 0u ? cnt : 1u;
}

__device__ __forceinline__ void xcd_barrier(const XcdBarrier& b, const int wv_) {
    asm volatile("s_waitcnt vmcnt(0)" ::: "memory");
    __syncthreads();
    if (otid(wv_) == 0) {
        unsigned* bar = b.bar;
        __builtin_amdgcn_s_waitcnt(0);
        unsigned nloc = b.st[0], nx = b.st[1];
        if (nloc == 0u) { xcd_barrier_complete(bar, b.x, nloc, nx); b.st[0] = nloc; b.st[1] = nx; }
        const unsigned old = xb_add(&bar[XB_XSUB(b.x)], 1u);
        const unsigned gen = old / nloc;
        if (old + 1u == (gen + 1u) * nloc) {
            __builtin_amdgcn_fence(__ATOMIC_RELEASE, "agent");
            asm volatile("s_waitcnt vmcnt(0)" ::: "memory");
            const unsigned og = xb_add(&bar[XB_TOP], 1u);
            const unsigned tg = og / nx;
            if (og + 1u == (tg + 1u) * nx) xb_add(&bar[XB_TOPGEN], 1u);
            else XB_SPIN(xb_ld(&bar[XB_TOPGEN]) == tg, bar);
            __builtin_amdgcn_fence(__ATOMIC_ACQUIRE, "agent");
            xb_add(&bar[XB_XGEN(b.x)], 1u);
            asm volatile("s_waitcnt vmcnt(0)" ::: "memory");
        } else {
            XB_SPIN(xb_ld(&bar[XB_XGEN(b.x)]) == gen, bar);
            __builtin_amdgcn_fence(__ATOMIC_ACQUIRE, "agent");
            asm volatile("s_waitcnt vmcnt(0)" ::: "memory");
        }
    }
    __syncthreads();
}

__device__ __forceinline__ const float* inptr(LAS unsigned char* lds, int i) {
    unsigned off = PTR_OFF + 8 * i; asm volatile("" : "+v"(off));
    const u32x2 v = *(const LAS u32x2*)(lds + off);
    const unsigned lo = __builtin_amdgcn_readfirstlane(v.x), hi = __builtin_amdgcn_readfirstlane(v.y);
    return (const float*)(((unsigned long long)hi << 32) | lo);
}
__global__ void __launch_bounds__(NTHR, 2) trunk_fwd(Params p) {
    extern __shared__ __attribute__((aligned(16))) unsigned char lds_raw[];
    LAS unsigned char* lds = (LAS unsigned char*)lds_raw;
    cg::grid_group grid = cg::this_grid();
    const int wv_ = __builtin_amdgcn_readfirstlane(threadIdx.x >> 6);
#ifdef PROBE_CAT
    const unsigned long long tp0_ = __builtin_amdgcn_s_memrealtime();
#endif
#ifndef NO_PRO
    prologue(p, lds, wv_);
#endif
#ifdef PROBE_CAT
    if (PROBE_CAT == 'P') { const unsigned long long d_ = __builtin_amdgcn_s_memrealtime() - tp0_; const unsigned long long w0_ = __builtin_amdgcn_s_memrealtime(); while (__builtin_amdgcn_s_memrealtime() - w0_ < d_) __builtin_amdgcn_s_sleep(8); }
#endif
    { const int t0 = otid(wv_); if (t0 < 22) { const unsigned long long v = (t0 < 20) ? (unsigned long long)p.in[t0 < 20 ? t0 : 0] : (t0 == 20 ? (unsigned long long)p.out : (unsigned long long)p.ws);
        ((LAS unsigned long long*)(lds + PTR_OFF))[t0] = v; }
      if (t0 < 2) ((volatile LAS unsigned*)(lds + PTR_OFF + 256))[t0] = 0u; }
    if (blockIdx.x == 0) { unsigned* bw = (unsigned*)(p.ws + WS_CTL); for (int i = otid(wv_); i < XCD_BAR_WORDS; i += NTHR) __hip_atomic_store(bw + i, 0u, __ATOMIC_RELAXED, __HIP_MEMORY_SCOPE_AGENT); }
    __syncthreads();
    grid.sync();
    const XcdBarrier bar = xcd_barrier_post((unsigned*)(p.ws + WS_CTL), (volatile LAS unsigned*)(lds + PTR_OFF + 256), wv_);
#ifdef PROBE_CAT
    unsigned long long tprev_ = __builtin_amdgcn_s_memrealtime();
#define GSYNC(C) do { if ((C) == PROBE_CAT) { const unsigned long long d_ = __builtin_amdgcn_s_memrealtime() - tprev_; const unsigned long long w0_ = __builtin_amdgcn_s_memrealtime(); \
        while (__builtin_amdgcn_s_memrealtime() - w0_ < d_) __builtin_amdgcn_s_sleep(8); } xcd_barrier(bar, wv_); tprev_ = __builtin_amdgcn_s_memrealtime(); } while (0)
#else
#define GSYNC(C) xcd_barrier(bar, wv_)
#endif
#define WSP ((unsigned char*)inptr(lds, 21))
#define XRES ((float*)inptr(lds, 20))
#pragma nounroll
    for (int l = 0; l < DEPTH; ++l) {
        const int j = l >> 1; const bool fox = (l & 1) == 0;
#ifndef NO_NORM
        { unsigned char* ws = WSP; const float* modl = (const float*)(ws + WS_MOD) + (size_t)l * 16 * 6144;
          if (fox) norm_phase<2, true>((l == 0) ? (const void*)inptr(lds, I_X) : (const void*)(ws + WS_XB), l != 0, inptr(lds, I_GMIX) + l * DM, modl + 0, modl + 1024, (bf16*)(ws + WS_H), inptr(lds, I_FWIN) + (size_t)j * DM * 3088, inptr(lds, I_FBF) + j * 16, (float*)(ws + WS_LF), lds, wv_);
          else norm_phase<8, false>((const void*)(ws + WS_XB), true, inptr(lds, I_GMIX) + l * DM, modl + 0, modl + 1024, (bf16*)(ws + WS_H), nullptr, nullptr, nullptr, lds, wv_); }
#endif
        GSYNC('N');
        if (fox) {
#ifndef NO_CUM
            { unsigned char* ws = WSP; fox_cumsum((const float*)(ws + WS_LF), (bf16*)(ws + WS_Q), (bf16*)(ws + WS_K), lds, wv_); }
#endif
#ifndef NO_G1F
            { unsigned char* ws = WSP; const bf16* WinT = (const bf16*)(ws + WS_W + W_FOX + (size_t)j * W_FOX_STRIDE);
              pg8::Gemm g{(const bf16*)(ws + WS_H), WinT, M, 3072, DM}; pg8::StaticOrder S; S.init(M, 3072, ogrid(), obid());
              pg8::EpiQkvFox E{ws, 0.125f * LOG2E};
              pg8::gemm_phase<pg8::EpiQkvFox, pg8::StaticOrder, true, true>(lds, g, S, E, wv_); }
#endif
            GSYNC('G');
#ifndef NO_ATT5
            { unsigned char* ws = WSP; attn_phase<5>(lds, (const bf16*)(ws + WS_Q), (const bf16*)(ws + WS_K), (const bf16*)(ws + WS_V), (bf16*)(ws + WS_H), wv_); }
#ifdef PROBE_ATT2
            { unsigned char* ws = WSP; attn_phase<5>(lds, (const bf16*)(ws + WS_Q), (const bf16*)(ws + WS_K), (const bf16*)(ws + WS_V), (bf16*)(ws + WS_H), wv_); }
#endif
#endif
            GSYNC('A');
        } else {
#ifndef NO_GD
            { unsigned char* ws = WSP; const bf16* WdT = (const bf16*)(ws + WS_W + W_MLA + (size_t)j * W_MLA_STRIDE);
              pg8::Gemm g{(const bf16*)(ws + WS_H), WdT, M, 512, DM}; pg8::StaticOrder S; S.init(M, 512, ogrid(), obid());
              pg8::EpiMlaDown E{ws};
              pg8::gemm_phase<pg8::EpiMlaDown, pg8::StaticOrder, true, true>(lds, g, S, E, wv_); }
#endif
            GSYNC('H');
#ifndef NO_GQ
            { unsigned char* ws = WSP; const bf16* WuqT = (const bf16*)(ws + WS_W + W_MLA + (size_t)j * W_MLA_STRIDE) + (size_t)512 * 1024;
              int Kq = 256; asm volatile("" : "+s"(Kq));
              pg8::Gemm g{(const bf16*)(ws + WS_CQ), WuqT, M, 1536, Kq}; pg8::StaticOrder S; S.init(M, 1536, ogrid(), obid());
              pg8::EpiMlaQ E{ws, 0.10206207261596575f * LOG2E};
              pg8::gemm_phase<pg8::EpiMlaQ, pg8::StaticOrder, true, true>(lds, g, S, E, wv_); }
#endif
#ifndef NO_GKV
            { unsigned char* ws = WSP; const bf16* WukvT = (const bf16*)(ws + WS_W + W_MLA + (size_t)j * W_MLA_STRIDE) + (size_t)512 * 1024 + (size_t)1536 * 256;
              int Kkv = 128; asm volatile("" : "+s"(Kkv));
              pg8::Gemm g{(const bf16*)(ws + WS_CKV), WukvT, M, 2048, Kkv}; pg8::StaticOrder S; S.init(M, 2048, ogrid(), obid());
              pg8::EpiMlaKv E{ws};
              pg8::gemm_phase<pg8::EpiMlaKv, pg8::StaticOrder, true, true>(lds, g, S, E, wv_); }
#endif
            GSYNC('Q');
#ifndef NO_ATT6
            { unsigned char* ws = WSP; attn_phase<6>(lds, (const bf16*)(ws + WS_Q), (const bf16*)(ws + WS_K), (const bf16*)(ws + WS_V), (bf16*)(ws + WS_H), wv_); }
#ifdef PROBE_ATT2
            { unsigned char* ws = WSP; attn_phase<6>(lds, (const bf16*)(ws + WS_Q), (const bf16*)(ws + WS_K), (const bf16*)(ws + WS_V), (bf16*)(ws + WS_H), wv_); }
#endif
#endif
            GSYNC('B');
        }
#ifndef NO_GO
        { unsigned char* ws = WSP; const float* modl = (const float*)(ws + WS_MOD) + (size_t)l * 16 * 6144;
          const bf16* WoutT = fox ? (const bf16*)(ws + WS_W + W_FOX + (size_t)j * W_FOX_STRIDE) + (size_t)3072 * DM : (const bf16*)(ws + WS_W + W_MLA + (size_t)j * W_MLA_STRIDE + 3 * MiB);
          pg8::Gemm g{(const bf16*)(ws + WS_H), WoutT, M, DM, DM}; pg8::StaticOrder S; S.init(M, DM, ogrid(), obid());
          pg8::EpiResid E{(l == 0) ? inptr(lds, I_X) : (const float*)nullptr, (bf16*)(ws + WS_XB), modl + 2048};
          pg8::gemm_phase<pg8::EpiResid, pg8::StaticOrder, true, true>(lds, g, S, E, wv_); }
#endif
        GSYNC('O');
#ifndef NO_NORM2
        { unsigned char* ws = WSP; const float* modl = (const float*)(ws + WS_MOD) + (size_t)l * 16 * 6144;
          norm_phase<8, false>((const void*)(ws + WS_XB), true, inptr(lds, I_GMLP) + l * DM, modl + 3072, modl + 4096, (bf16*)(ws + WS_H), nullptr, nullptr, nullptr, lds, wv_); }
#endif
        GSYNC('M');
#ifndef NO_GU
        { unsigned char* ws = WSP; const bf16* W1T = (const bf16*)(ws + WS_W + W_MLP + (size_t)l * W_MLP_STRIDE);
          pg8::Gemm g{(const bf16*)(ws + WS_H), W1T, M, FF, DM}; pg8::StaticOrder S; S.init(M, FF, ogrid(), obid());
          pg8::EpiRelu2 E{ws};
          pg8::gemm_phase<pg8::EpiRelu2, pg8::StaticOrder, true, true>(lds, g, S, E, wv_); }
#endif
        GSYNC('U');
#ifndef NO_GDN
        { unsigned char* ws = WSP; const float* modl = (const float*)(ws + WS_MOD) + (size_t)l * 16 * 6144;
          const bf16* W2T = (const bf16*)(ws + WS_W + W_MLP + (size_t)l * W_MLP_STRIDE) + (size_t)FF * DM;
          pg8::Gemm g{(const bf16*)(ws + WS_BIG), W2T, M, DM, FF}; pg8::StaticOrder S; S.init(M, DM, ogrid(), obid());
          pg8::EpiResid E{(const float*)nullptr, (bf16*)(ws + WS_XB), modl + 5120};
          pg8::gemm_phase<pg8::EpiResid, pg8::StaticOrder, true, true>(lds, g, S, E, wv_); }
#endif
        GSYNC('D');
    }
    final_norm((const bf16*)(WSP + WS_XB), XRES, inptr(lds, I_GFIN), wv_);
#ifdef PROBE_CAT
    if (PROBE_CAT == 'F') { const unsigned long long d_ = __builtin_amdgcn_s_memrealtime() - tprev_; const unsigned long long w0_ = __builtin_amdgcn_s_memrealtime(); while (__builtin_amdgcn_s_memrealtime() - w0_ < d_) __builtin_amdgcn_s_sleep(8); }
#endif
}

extern "C" void kernel_launch(void* const* d_in, const int* in_sizes, int n_in, void* d_out, int out_size, void* d_ws, size_t ws_size, hipStream_t stream) {
    static int grid = 0;
    if (grid == 0) {
        if (n_in != 20 || in_sizes[0] != M * DM || out_size != M * DM || ws_size < WS_END) { fprintf(stderr, "kernel_launch: unexpected shapes (n_in %d, in0 %d, out %d, ws %zu)\n", n_in, n_in > 0 ? in_sizes[0] : -1, out_size, ws_size); grid = -1; return; }
        int dev = 0, cus = 0, per_cu = 0;
        if (hipGetDevice(&dev) != hipSuccess || hipDeviceGetAttribute(&cus, hipDeviceAttributeMultiprocessorCount, dev) != hipSuccess) { fprintf(stderr, "kernel_launch: device query failed\n"); grid = -1; return; }
        if (hipFuncSetAttribute((const void*)trunk_fwd, hipFuncAttributeMaxDynamicSharedMemorySize, LDS_BYTES) != hipSuccess) { fprintf(stderr, "kernel_launch: hipFuncSetAttribute failed\n"); grid = -1; return; }
        if (hipOccupancyMaxActiveBlocksPerMultiprocessor(&per_cu, (const void*)trunk_fwd, NTHR, LDS_BYTES) != hipSuccess || per_cu < 1) { fprintf(stderr, "kernel_launch: occupancy query gave %d\n", per_cu); per_cu = 1; }
        (void)hipGetLastError();
        grid = cus * per_cu;
    }
    if (grid < 0) return;
    Params prm{};
    for (int i = 0; i < 20; ++i) prm.in[i] = (const float*)d_in[i];
    prm.out = (float*)d_out; prm.ws = (unsigned char*)d_ws;
    void* args[] = {&prm};
    hipError_t e = hipLaunchCooperativeKernel((const void*)trunk_fwd, dim3(grid), dim3(NTHR), args, LDS_BYTES, stream);
    if (e != hipSuccess) fprintf(stderr, "kernel_launch: cooperative launch failed: %s (grid %d)\n", hipGetErrorString(e), grid);
}
```

```cpp
#include <hip/hip_runtime.h>
#include <hip/hip_cooperative_groups.h>
#include <cstdio>
#include <cstdint>
namespace cg = cooperative_groups;
#define LAS __attribute__((address_space(3)))
typedef unsigned short bf16;
typedef short bf16x8 __attribute__((ext_vector_type(8)));
typedef short s16x4 __attribute__((ext_vector_type(4)));
typedef float f32x16 __attribute__((ext_vector_type(16)));
typedef float f32x4 __attribute__((ext_vector_type(4)));
typedef float f32x2 __attribute__((ext_vector_type(2)));
typedef unsigned u32x4 __attribute__((ext_vector_type(4)));
typedef unsigned u32x2 __attribute__((ext_vector_type(2)));

constexpr int NB = 16, SEQ = 2048, DM = 1024, NH = 16, FF = 4096, DEPTH = 4;
constexpr int M = NB * SEQ;
constexpr int NTHR = 512, NWAVE = 8;
constexpr float EPS = 1e-6f, LOG2E = 1.4426950408889634f;
constexpr size_t MiB = 1u << 20;
constexpr size_t WS_BIG = 0;
constexpr size_t WS_Q = 0, WS_K = 96 * MiB, WS_V = 192 * MiB;
constexpr size_t WS_H = 256 * MiB;
constexpr size_t WS_CQ = 320 * MiB, WS_CKV = 336 * MiB;
constexpr size_t WS_W = 344 * MiB;
constexpr size_t W_FOX = 0, W_FOX_STRIDE = 8 * MiB;
constexpr size_t W_MLA = 16 * MiB, W_MLA_STRIDE = 5 * MiB;
constexpr size_t W_MLP = 26 * MiB, W_MLP_STRIDE = 16 * MiB;
constexpr size_t WS_MOD = 436 * MiB;
constexpr size_t WS_CS = 438 * MiB;
constexpr size_t WS_LF = 442 * MiB;
constexpr size_t WS_SSQQ = 444 * MiB, WS_SSQKV = 445 * MiB;
constexpr size_t WS_CTL = 446 * MiB;
constexpr size_t WS_XB = 447 * MiB;
constexpr size_t WS_END = 511 * MiB;
static_assert(WS_W + W_MLP + 4 * W_MLP_STRIDE <= WS_MOD, "weights fit");
constexpr int LDS_BYTES = 135168;

template <int MASK> __device__ __forceinline__ float xor_sum(float v) {
    if constexpr (MASK == 32) return v + __shfl_xor(v, 32);
    else return v + __builtin_bit_cast(float, __builtin_amdgcn_ds_swizzle(__builtin_bit_cast(int, v), (MASK << 10) | 0x1F));
}
template <int MASK> __device__ __forceinline__ float xor_get(float v, bool upper) {
    if constexpr (MASK == 32) return __shfl_xor(v, 32);
    else return __builtin_bit_cast(float, __builtin_amdgcn_ds_swizzle(__builtin_bit_cast(int, v), (MASK << 10) | 0x1F));
}
__device__ __forceinline__ float wave_sum(float v) { v = xor_sum<1>(v); v = xor_sum<2>(v); v = xor_sum<4>(v); v = xor_sum<8>(v); v = xor_sum<16>(v); v = xor_sum<32>(v); return v; }
namespace pg8 {
#define PG8_LAS __attribute__((address_space(3)))
typedef unsigned short bf16_t;
typedef short bf16x8 __attribute__((ext_vector_type(8)));
typedef float f32x4 __attribute__((ext_vector_type(4)));
typedef unsigned u32x4 __attribute__((ext_vector_type(4)));
constexpr int BM = 256, BK = 64, HALF = 128, HTB = HALF * BK * 2  , STAGE_BYTES = 8 * HTB, NXCD = 8, WGM = 8;

__host__ __device__ __forceinline__ int lds_byte(int r, int c) { const int st = (r >> 4) * 2 + (c >> 5), rr = r & 15, cc = c & 31, ob = rr * 64 + cc * 2; return st * 1024 + (ob ^ (((ob >> 9) & 1) << 5)); }
__host__ __device__ __forceinline__ void stage_rc(int b, int& R, int& C) { const int st = b / 1024, sb = b % 1024, swz = sb ^ (((sb >> 9) & 1) << 5); R = (st >> 1) * 16 + swz / 64; C = (st & 1) * 32 + (swz % 64) / 2; }
__host__ __device__ __forceinline__ int perm32(int rho) { const int n = rho >> 4, i = rho & 15; return 8 * (i >> 2) + 4 * n + (i & 3); }

struct Unit { int pm, pn; };
struct Gemm { const bf16_t* A; const bf16_t* Bt; int M, N, K; };

struct StaticOrder {
    int nM, nN, nwg, G, c;
    __host__ __device__ void init(int M, int N, int G_, int c_) { nM = M / BM; nN = N / BM; nwg = nM * nN; G = G_; c = c_; }
    __host__ __device__ bool next(int i, Unit& u) const {
        const long L = (long)i * G + c; if (L >= nwg) return false;
        int wgid = (int)L; { const int q = nwg / NXCD, r = nwg % NXCD, xcd = wgid % NXCD, off = wgid / NXCD; wgid = (xcd < r ? xcd * (q + 1) : r * (q + 1) + (xcd - r) * q) + off; }
        const int nig = WGM * nN, gid = wgid / nig, fm = gid * WGM, gsz = (nM - fm) < WGM ? (nM - fm) : WGM;
        u.pm = fm + ((wgid % nig) % gsz); u.pn = (wgid % nig) / gsz; return true;
    }
    __device__ __forceinline__ void a_ready(const Unit&) const {}
    __device__ __forceinline__ void done(const Unit&) const {}
};

__device__ __forceinline__ unsigned cvt_pk_bf16(float lo, float hi) { unsigned r; asm volatile("v_cvt_pk_bf16_f32 %0, %1, %2" : "=v"(r) : "v"(lo), "v"(hi)); return r; }
typedef float f32x2 __attribute__((ext_vector_type(2)));
typedef unsigned u32x2 __attribute__((ext_vector_type(2)));
#define GAS __attribute__((address_space(1)))
typedef GAS bf16_t gbf16; typedef GAS float gf32; typedef GAS unsigned char gu8;
constexpr float RMS_EPS = 1e-6f;
__device__ __forceinline__ u32x4 pack8(const f32x4& v0, const f32x4& v1) { u32x4 w; w.x = cvt_pk_bf16(v0[0], v0[1]); w.y = cvt_pk_bf16(v0[2], v0[3]); w.z = cvt_pk_bf16(v1[0], v1[1]); w.w = cvt_pk_bf16(v1[2], v1[3]); return w; }
__device__ __forceinline__ u32x2 pack4(const f32x4& v) { u32x2 w; w.x = cvt_pk_bf16(v[0], v[1]); w.y = cvt_pk_bf16(v[2], v[3]); return w; }

struct EpiQkvFox {
    static constexpr bool PERM = true, AFTER_DRAIN = false;
    unsigned char* ws; float qscale;
    __device__ __forceinline__ void operator()(const f32x4 (&acc)[2][2][4][2], const Unit& u, int wr, int wc, int fr, int fq) const {
        gbf16* Q = (gbf16*)((gu8*)ws + WS_Q); gbf16* Kp = (gbf16*)((gu8*)ws + WS_K); gbf16* V = (gbf16*)((gu8*)ws + WS_V);
        const int row0 = u.pm * BM + wr * 64 + fr;
        const int t = u.pn >> 2;
        const int cin0 = (u.pn & 3) * BM + wc * 32 + 8 * fq;
        const float sc = (t == 0) ? qscale : 1.f;
#pragma unroll
        for (int ai = 0; ai < 2; ++ai)
#pragma unroll
            for (int m = 0; m < 4; ++m) { const unsigned row = (unsigned)(row0 + ai * HALF + m * 16);
#pragma unroll
                for (int bj = 0; bj < 2; ++bj) { const int cin = cin0 + bj * HALF;
                    gbf16* dst = (t == 2) ? (V + row * 1024 + cin) : ((t == 0 ? Q : Kp) + row * 1280 + (cin >> 6) * 80 + (cin & 63));
                    *(GAS u32x4*)dst = pack8(acc[ai][bj][m][0] * sc, acc[ai][bj][m][1] * sc); } }
    }
};
struct EpiRelu2 {
    static constexpr bool PERM = true, AFTER_DRAIN = false;
    unsigned char* ws;
    __device__ __forceinline__ void operator()(const f32x4 (&acc)[2][2][4][2], const Unit& u, int wr, int wc, int fr, int fq) const {
        gbf16* H = (gbf16*)((gu8*)ws + WS_BIG);
        const int row0 = u.pm * BM + wr * 64 + fr; const int col0 = u.pn * BM + wc * 32 + 8 * fq;
#pragma unroll
        for (int ai = 0; ai < 2; ++ai)
#pragma unroll
            for (int m = 0; m < 4; ++m) { gbf16* rowp = H + (unsigned)(row0 + ai * HALF + m * 16) * 4096u + (unsigned)col0;
#pragma unroll
                for (int bj = 0; bj < 2; ++bj) { f32x4 v0 = acc[ai][bj][m][0], v1 = acc[ai][bj][m][1];
#pragma unroll
                    for (int j = 0; j < 4; ++j) { const float a = fmaxf(v0[j], 0.f), b = fmaxf(v1[j], 0.f); v0[j] = a * a; v1[j] = b * b; }
                    *(GAS u32x4*)(rowp + bj * HALF) = pack8(v0, v1); } }
    }
};
struct EpiResid {
    static constexpr bool PERM = true, AFTER_DRAIN = false;
    const float* base32_; bf16_t* xb_; const float* gate_;
    __device__ __forceinline__ void operator()(const f32x4 (&acc)[2][2][4][2], const Unit& u, int wr, int wc, int fr, int fq) const {
        const gf32* base32 = (const gf32*)base32_; gbf16* xb = (gbf16*)xb_; const gf32* gate = (const gf32*)gate_;
        const int row0 = u.pm * BM + wr * 64 + fr; const int col0 = u.pn * BM + wc * 32 + 8 * fq;
        const gf32* gp = gate + (size_t)(u.pm >> 3) * 6144 + col0;
        f32x4 gv[2][2];
#pragma unroll
        for (int bj = 0; bj < 2; ++bj)
#pragma unroll
            for (int n = 0; n < 2; ++n) gv[bj][n] = *(const GAS f32x4*)(gp + bj * HALF + n * 4);
#pragma unroll
        for (int ai = 0; ai < 2; ++ai)
#pragma unroll
            for (int m = 0; m < 4; ++m) { const unsigned off = (unsigned)(row0 + ai * HALF + m * 16) * 1024u + (unsigned)col0;
#pragma unroll
                for (int bj = 0; bj < 2; ++bj) { f32x4 b0, b1;
                    if (base32_) { b0 = *(const GAS f32x4*)(base32 + off + bj * HALF); b1 = *(const GAS f32x4*)(base32 + off + bj * HALF + 4); }
                    else { const u32x4 w = *(const GAS u32x4*)(xb + off + bj * HALF);
                        b0 = (f32x4){__builtin_bit_cast(float, w.x << 16), __builtin_bit_cast(float, w.x & 0xffff0000u), __builtin_bit_cast(float, w.y << 16), __builtin_bit_cast(float, w.y & 0xffff0000u)};
                        b1 = (f32x4){__builtin_bit_cast(float, w.z << 16), __builtin_bit_cast(float, w.z & 0xffff0000u), __builtin_bit_cast(float, w.w << 16), __builtin_bit_cast(float, w.w & 0xffff0000u)}; }
                    *(GAS u32x4*)(xb + off + bj * HALF) = pack8(b0 + gv[bj][0] * acc[ai][bj][m][0], b1 + gv[bj][1] * acc[ai][bj][m][1]); } }
    }
};
struct EpiMlaKv {
    static constexpr bool PERM = true, AFTER_DRAIN = false;
    unsigned char* ws;
    __device__ __forceinline__ void operator()(const f32x4 (&acc)[2][2][4][2], const Unit& u, int wr, int wc, int fr, int fq) const {
        const gf32* ssq = (const gf32*)((gu8*)ws + WS_SSQKV); gbf16* Kp = (gbf16*)((gu8*)ws + WS_K); gbf16* V = (gbf16*)((gu8*)ws + WS_V);
        const int row0 = u.pm * BM + wr * 64 + fr;
        const int t = u.pn >> 2; const int cin0 = (u.pn & 3) * BM + wc * 32 + 8 * fq;
#pragma unroll
        for (int ai = 0; ai < 2; ++ai)
#pragma unroll
            for (int m = 0; m < 4; ++m) { const unsigned row = (unsigned)(row0 + ai * HALF + m * 16);
                const f32x4 s4 = *(const GAS f32x4*)(ssq + row * 4);
                const float rs = __builtin_amdgcn_rsqf(((s4[0] + s4[1]) + (s4[2] + s4[3])) * (1.0f / 128.0f) + RMS_EPS);
#pragma unroll
                for (int bj = 0; bj < 2; ++bj) { const int cin = cin0 + bj * HALF;
                    gbf16* dst = t ? (V + row * 1024 + cin) : (Kp + row * 1536 + (cin >> 6) * 96 + (cin & 63));
                    *(GAS u32x4*)dst = pack8(acc[ai][bj][m][0] * rs, acc[ai][bj][m][1] * rs); }
                asm volatile("" ::: "memory"); }
    }
};
struct EpiMlaQ {
    static constexpr bool PERM = false, AFTER_DRAIN = false;
    unsigned char* ws; float qscale;
    __device__ __forceinline__ void operator()(const f32x4 (&acc)[2][2][4][2], const Unit& u, int wr, int wc, int fr, int fq) const {
        const gf32* ssq = (const gf32*)((gu8*)ws + WS_SSQQ); const gf32* cst = (const gf32*)((gu8*)ws + WS_CS); gbf16* Q = (gbf16*)((gu8*)ws + WS_Q);
        const int row0 = u.pm * BM + wr * 64 + fr;
#pragma unroll
        for (int ai = 0; ai < 2; ++ai)
#pragma unroll
            for (int m = 0; m < 4; ++m) { const unsigned row = (unsigned)(row0 + ai * HALF + m * 16);
                const f32x4 s4 = *(const GAS f32x4*)(ssq + row * 4);
                const float rs = qscale * __builtin_amdgcn_rsqf(((s4[0] + s4[1]) + (s4[2] + s4[3])) * (1.0f / 256.0f) + RMS_EPS);
                if (u.pn < 4) {
#pragma unroll
                    for (int bj = 0; bj < 2; ++bj)
#pragma unroll
                        for (int n = 0; n < 2; ++n) { const int cin = u.pn * BM + bj * HALF + wc * 32 + n * 16 + 4 * fq;
                            *(GAS u32x2*)(Q + row * 1536 + (cin >> 6) * 96 + (cin & 63)) = pack4(acc[ai][bj][m][n] * rs); }
                } else {
                    const f32x4 cs = *(const GAS f32x4*)(cst + row * 32 + 4 * fq), sn = *(const GAS f32x4*)(cst + row * 32 + 16 + 4 * fq);
#pragma unroll
                    for (int bj = 0; bj < 2; ++bj) { const int head = ((u.pn - 4) * BM + bj * HALF + wc * 32) >> 5;
                        const f32x4 x1 = acc[ai][bj][m][0] * rs, x2 = acc[ai][bj][m][1] * rs;
                        gbf16* dst = Q + row * 1536 + head * 96 + 64 + 4 * fq;
                        *(GAS u32x2*)dst = pack4(x1 * cs - x2 * sn); *(GAS u32x2*)(dst + 16) = pack4(x2 * cs + x1 * sn); }
                }
                asm volatile("" ::: "memory");
            }
    }
};
struct EpiMlaDown {
    static constexpr bool PERM = false, AFTER_DRAIN = false;
    unsigned char* ws;
    __device__ __forceinline__ void operator()(const f32x4 (&acc)[2][2][4][2], const Unit& u, int wr, int wc, int fr, int fq) const {
        gbf16* cq = (gbf16*)((gu8*)ws + WS_CQ); gbf16* ckv = (gbf16*)((gu8*)ws + WS_CKV); gf32* ssqq = (gf32*)((gu8*)ws + WS_SSQQ); gf32* ssqkv = (gf32*)((gu8*)ws + WS_SSQKV); const gf32* cst = (const gf32*)((gu8*)ws + WS_CS); gbf16* Kp = (gbf16*)((gu8*)ws + WS_K);
        const int row0 = u.pm * BM + wr * 64 + fr;
#pragma unroll
        for (int ai = 0; ai < 2; ++ai)
#pragma unroll
            for (int m = 0; m < 4; ++m) { const unsigned row = (unsigned)(row0 + ai * HALF + m * 16);
                if (u.pn == 0) {
                    float ss = 0.f;
#pragma unroll
                    for (int bj = 0; bj < 2; ++bj)
#pragma unroll
                        for (int n = 0; n < 2; ++n) { const f32x4 v = acc[ai][bj][m][n]; ss += (v[0] * v[0] + v[1] * v[1]) + (v[2] * v[2] + v[3] * v[3]);
                            *(GAS u32x2*)(cq + row * 256 + bj * HALF + wc * 32 + n * 16 + 4 * fq) = pack4(v); }
                    ss = xor_sum<16>(ss); ss = xor_sum<32>(ss);
                    if (fq == 0) ssqq[row * 4 + wc] = ss;
                } else {
                    float ss = 0.f;
#pragma unroll
                    for (int n = 0; n < 2; ++n) { const f32x4 v = acc[ai][0][m][n]; ss += (v[0] * v[0] + v[1] * v[1]) + (v[2] * v[2] + v[3] * v[3]);
                        *(GAS u32x2*)(ckv + row * 128 + wc * 32 + n * 16 + 4 * fq) = pack4(v); }
                    ss = xor_sum<16>(ss); ss = xor_sum<32>(ss);
                    if (fq == 0) ssqkv[row * 4 + wc] = ss;
                    if (wc == 0) {
                        const f32x4 cs = *(const GAS f32x4*)(cst + row * 32 + 4 * fq), sn = *(const GAS f32x4*)(cst + row * 32 + 16 + 4 * fq);
                        const f32x4 x1 = acc[ai][1][m][0], x2 = acc[ai][1][m][1];
                        const u32x2 o1 = pack4(x1 * cs - x2 * sn), o2 = pack4(x2 * cs + x1 * sn);
                        gbf16* dst = Kp + row * 1536 + 64 + 4 * fq;
#pragma unroll
                        for (int hd = 0; hd < 16; ++hd) { *(GAS u32x2*)(dst + hd * 96) = o1; *(GAS u32x2*)(dst + hd * 96 + 16) = o2; }
                    }
                }
            }
    }
};

template <class Epi, class Sched, bool ALIGN_EPI = false, bool SP2 = false>
__device__ __forceinline__ void gemm_phase(PG8_LAS unsigned char* lds, const Gemm g, const Sched& S, const Epi& E, const int wv_) {
    int tid_; asm volatile("v_mbcnt_lo_u32_b32 %0, -1, 0\n\tv_mbcnt_hi_u32_b32 %0, -1, %0" : "=v"(tid_)); tid_ += wv_ * 64;
    const int tid = tid_, wid = __builtin_amdgcn_readfirstlane(tid >> 6), lane = tid & 63, wr = wid >> 2, wc = wid & 3, fr = lane & 15, fq = lane >> 4;
    const int K = g.K, nt = K / BK;
    unsigned voffA[2], voffB[2];
#pragma unroll
    for (int i = 0; i < 2; ++i) { int R, C; stage_rc(tid * 16 + i * 8192, R, C); const int Rb = Epi::PERM ? ((R & ~31) + perm32(R & 31)) : R;
        voffA[i] = (unsigned)(R * K + C) * 2u; voffB[i] = (unsigned)(Rb * K + C) * 2u; }
    const size_t kstep = (size_t)(BK * 2);
    const size_t hstep = (size_t)HALF * K * 2;
    const size_t tstep = 2 * hstep;
    const unsigned ldsw = (unsigned)wid * 1024u;
    const int aoff = lds_byte(wr * 64 + fr, fq * 8), boff = lds_byte(wc * 32 + fr, fq * 8);
#define PG8_SA(b, h) (((b) * 2 + (h)) * HTB)
#define PG8_SB(b, h) ((4 + (b) * 2 + (h)) * HTB)
#define PG8_STAGE(bufoff, gbase, voff) do { _Pragma("unroll") for (int _i = 0; _i < 2; ++_i) \
        __builtin_amdgcn_global_load_lds((const unsigned*)((const char*)(gbase) + (voff)[_i]), (PG8_LAS unsigned*)(lds + (bufoff) + ldsw + _i * 8192), 16, 0, 0); } while (0)
#define PG8_LDA(dst, b, h) do { _Pragma("unroll") for (int m = 0; m < 4; ++m) _Pragma("unroll") for (int k = 0; k < 2; ++k) dst[m][k] = *(const PG8_LAS bf16x8*)(lds + PG8_SA(b, h) + aoff + m * 2048 + k * 1024); } while (0)
#define PG8_LDB(dst, b, h) do { _Pragma("unroll") for (int n = 0; n < 2; ++n) _Pragma("unroll") for (int k = 0; k < 2; ++k) dst[n][k] = *(const PG8_LAS bf16x8*)(lds + PG8_SB(b, h) + boff + n * 2048 + k * 1024); } while (0)
#define PG8_MMA(ai, bj, At, Bt) do { __builtin_amdgcn_s_setprio(1); _Pragma("unroll") for (int m = 0; m < 4; ++m) _Pragma("unroll") for (int n = 0; n < 2; ++n) _Pragma("unroll") for (int k = 0; k < 2; ++k) \
        acc[ai][bj][m][n] = __builtin_amdgcn_mfma_f32_16x16x32_bf16(Bt[n][k], At[m][k], acc[ai][bj][m][n], 0, 0, 0); __builtin_amdgcn_s_setprio(0); } while (0)
#define PG8_WAIT_V(n) asm volatile("s_waitcnt vmcnt(" #n ")" ::: "memory")
#define PG8_WAIT_L(n) asm volatile("s_waitcnt lgkmcnt(" #n ")" ::: "memory")
#define PG8_BAR __builtin_amdgcn_s_barrier()
#define PG8_SCHED __builtin_amdgcn_sched_barrier(0)
    Unit cur, nxt; int ui = 0;
    if (!S.next(0, cur)) return;
    f32x4 acc[2][2][4][2];
#pragma unroll
    for (int a = 0; a < 2; ++a)
#pragma unroll
        for (int b = 0; b < 2; ++b)
#pragma unroll
            for (int m = 0; m < 4; ++m)
#pragma unroll
                for (int n = 0; n < 2; ++n) acc[a][b][m][n] = (f32x4){0.f, 0.f, 0.f, 0.f};
    bf16x8 At[4][2], B0[2][2], B1[2][2];
    const char* cA = (const char*)g.A + (size_t)cur.pm * tstep; const char* cB = (const char*)g.Bt + (size_t)cur.pn * tstep;
    S.a_ready(cur);
    if constexpr (SP2) {
        PG8_STAGE(PG8_SB(0, 0), cB, voffB); PG8_STAGE(PG8_SB(0, 1), cB + hstep, voffB); PG8_STAGE(PG8_SA(0, 0), cA, voffA); PG8_STAGE(PG8_SA(0, 1), cA + hstep, voffA);
        if (wr == 1) PG8_BAR;
        PG8_WAIT_V(2); PG8_BAR;
        PG8_STAGE(PG8_SB(1, 0), cB + kstep, voffB); PG8_STAGE(PG8_SA(1, 0), cA + kstep, voffA); PG8_STAGE(PG8_SB(1, 1), cB + hstep + kstep, voffB);
        PG8_WAIT_V(6); PG8_BAR;
    } else {
        PG8_STAGE(PG8_SB(0, 0), cB, voffB); PG8_STAGE(PG8_SA(0, 0), cA, voffA); PG8_STAGE(PG8_SB(0, 1), cB + hstep, voffB); PG8_STAGE(PG8_SA(0, 1), cA + hstep, voffA);
        if (wr == 1) PG8_BAR;
        PG8_WAIT_V(4); PG8_BAR;
        PG8_STAGE(PG8_SB(1, 0), cB + kstep, voffB); PG8_STAGE(PG8_SA(1, 0), cA + kstep, voffA); PG8_STAGE(PG8_SB(1, 1), cB + hstep + kstep, voffB);
        PG8_WAIT_V(6); PG8_BAR;
    }
    for (;;) {
        const bool has_next = S.next(ui + 1, nxt);
        const char* nA = has_next ? (const char*)g.A + (size_t)nxt.pm * tstep : cA; const char* nB = has_next ? (const char*)g.Bt + (size_t)nxt.pn * tstep : cB;
        for (int t = 0; t < nt; t += 2) {
            const bool last = (t == nt - 2);
            const char* a1 = cA + (size_t)(t + 1) * kstep;
            const char* a2 = last ? nA : cA + (size_t)(t + 2) * kstep; const char* b2 = last ? nB : cB + (size_t)(t + 2) * kstep;
            const char* a3 = a2 + kstep; const char* b3 = b2 + kstep;
            if (last && has_next) S.a_ready(nxt);
            if constexpr (SP2) {
            PG8_LDB(B0, 0, 0); PG8_LDB(B1, 0, 1); PG8_SCHED; PG8_LDA(At, 0, 0); PG8_STAGE(PG8_SA(1, 1), a1 + hstep, voffA);
            PG8_WAIT_V(8); PG8_WAIT_L(0); PG8_BAR; PG8_MMA(0, 0, At, B0); PG8_MMA(0, 1, At, B1); PG8_BAR; PG8_SCHED;
            PG8_LDA(At, 0, 1); PG8_STAGE(PG8_SB(0, 0), b2, voffB); PG8_STAGE(PG8_SB(0, 1), b2 + hstep, voffB); PG8_STAGE(PG8_SA(0, 0), a2, voffA);
            PG8_WAIT_V(8); PG8_WAIT_L(0); PG8_BAR; PG8_MMA(1, 0, At, B0); PG8_MMA(1, 1, At, B1); PG8_BAR; PG8_SCHED;
            PG8_LDB(B0, 1, 0); PG8_LDB(B1, 1, 1); PG8_SCHED; PG8_LDA(At, 1, 0); PG8_STAGE(PG8_SA(0, 1), a2 + hstep, voffA);
            PG8_WAIT_V(8); PG8_WAIT_L(0); PG8_BAR; PG8_MMA(0, 0, At, B0); PG8_MMA(0, 1, At, B1); PG8_BAR; PG8_SCHED;
            PG8_LDA(At, 1, 1); PG8_STAGE(PG8_SB(1, 0), b3, voffB); PG8_STAGE(PG8_SB(1, 1), b3 + hstep, voffB); PG8_STAGE(PG8_SA(1, 0), a3, voffA);
            PG8_WAIT_V(8); PG8_WAIT_L(0); PG8_BAR; PG8_MMA(1, 0, At, B0); PG8_MMA(1, 1, At, B1); PG8_BAR; PG8_SCHED;
            } else {
            PG8_LDB(B0, 0, 0); PG8_SCHED; PG8_LDA(At, 0, 0); PG8_STAGE(PG8_SA(1, 1), a1 + hstep, voffA);
            PG8_WAIT_L(8); PG8_BAR; PG8_WAIT_L(0); PG8_MMA(0, 0, At, B0); PG8_BAR; PG8_SCHED;
            PG8_LDB(B1, 0, 1); PG8_STAGE(PG8_SB(0, 0), b2, voffB);
            PG8_BAR; PG8_WAIT_L(0); PG8_MMA(0, 1, At, B1); PG8_BAR;
            PG8_LDA(At, 0, 1); PG8_STAGE(PG8_SA(0, 0), a2, voffA);
            PG8_BAR; PG8_WAIT_L(0); PG8_MMA(1, 0, At, B0); PG8_BAR; PG8_SCHED;
            PG8_STAGE(PG8_SB(0, 1), b2 + hstep, voffB);
            PG8_WAIT_V(6); PG8_BAR; PG8_MMA(1, 1, At, B1); PG8_BAR;
            PG8_LDB(B0, 1, 0); PG8_SCHED; PG8_LDA(At, 1, 0); PG8_STAGE(PG8_SA(0, 1), a2 + hstep, voffA);
            PG8_WAIT_L(8); PG8_BAR; PG8_WAIT_L(0); PG8_MMA(0, 0, At, B0); PG8_BAR; PG8_SCHED;
            PG8_LDB(B1, 1, 1); PG8_STAGE(PG8_SB(1, 0), b3, voffB);
            PG8_BAR; PG8_WAIT_L(0); PG8_MMA(0, 1, At, B1); PG8_BAR;
            PG8_LDA(At, 1, 1); PG8_STAGE(PG8_SA(1, 0), a3, voffA);
            PG8_BAR; PG8_WAIT_L(0); PG8_MMA(1, 0, At, B0); PG8_BAR; PG8_SCHED;
            PG8_STAGE(PG8_SB(1, 1), b3 + hstep, voffB);
            PG8_WAIT_V(6); PG8_BAR; PG8_MMA(1, 1, At, B1); PG8_BAR;
            }
        }
        if constexpr (ALIGN_EPI) { if (wr == 0) PG8_BAR; }
        if constexpr (!Epi::AFTER_DRAIN) { E(acc, cur, wr, wc, fr, fq); S.done(cur); }
        if (!has_next) break;
#pragma unroll
        for (int a = 0; a < 2; ++a)
#pragma unroll
            for (int b = 0; b < 2; ++b)
#pragma unroll
                for (int m = 0; m < 4; ++m)
#pragma unroll
                    for (int n = 0; n < 2; ++n) acc[a][b][m][n] = (f32x4){0.f, 0.f, 0.f, 0.f};
        cur = nxt; cA = nA; cB = nB; ++ui;
        if constexpr (ALIGN_EPI) { if (wr == 1) PG8_BAR; }
    }
    PG8_WAIT_V(0);
    if constexpr (!ALIGN_EPI) { if (wr == 0) PG8_BAR; }
    PG8_BAR;
    if constexpr (Epi::AFTER_DRAIN) { E.fused(acc, cur, wr, wc, fr, fq, lds, wid, lane); S.done(cur); }
#undef PG8_SA
#undef PG8_SB
#undef PG8_STAGE
#undef PG8_LDA
#undef PG8_LDB
#undef PG8_MMA
#undef PG8_WAIT_V
#undef PG8_WAIT_L
#undef PG8_BAR
#undef PG8_SCHED
}
}

__device__ __forceinline__ int olane() { int l; asm volatile("v_mbcnt_lo_u32_b32 %0, -1, 0\n\tv_mbcnt_hi_u32_b32 %0, -1, %0" : "=v"(l)); return l; }
__device__ __forceinline__ int otid(int wv) { return wv * 64 + olane(); }
__device__ __forceinline__ int obid() { int b = blockIdx.x; asm volatile("" : "+s"(b)); return b; }
__device__ __forceinline__ int ogrid() { int g = gridDim.x; asm volatile("" : "+s"(g)); return g; }
__device__ __forceinline__ unsigned f2bf(float f) { unsigned u = __builtin_bit_cast(unsigned, f); return (u + 0x7fffu + ((u >> 16) & 1u)) >> 16; }
__device__ __forceinline__ unsigned pk2(float lo, float hi) { return f2bf(lo) | (f2bf(hi) << 16); }
__device__ __forceinline__ float bf2f(unsigned b) { return __builtin_bit_cast(float, b << 16); }

__device__ __forceinline__ void transpose_item(const float* W, int ld, int K, int N, bf16* WT, int map, int drow0, const float* gk, LAS float* scr, int item, int lane) {
    const int nblk = N / 32, kb = item / nblk, nb = item % nblk, k0 = 64 * kb, n0 = 32 * nb;
    int drow;
    if (map == 1) { const int hd = n0 / 96, d = n0 % 96; drow = (d < 64) ? hd * 64 + d : 1024 + hd * 32 + (d - 64); }
    else if (map == 2) { const int hd = n0 / 128, d = n0 % 128; drow = (d < 64) ? hd * 64 + d : 1024 + hd * 64 + (d - 64); }
    else drow = drow0 + n0;
    { const int kr = lane >> 3, c4 = lane & 7; f32x4 t[8];
#pragma unroll
      for (int i = 0; i < 8; ++i) t[i] = *(const f32x4*)(W + (size_t)(k0 + 8 * i + kr) * ld + n0 + 4 * c4);
#pragma unroll
      for (int i = 0; i < 8; ++i) { const int kk = 8 * i + kr; f32x4 v = t[i]; if (gk) v = v * gk[k0 + kk];
          LAS float* d = scr + kk * 33 + 4 * c4; d[0] = v[0]; d[1] = v[1]; d[2] = v[2]; d[3] = v[3]; } }
    asm volatile("s_waitcnt lgkmcnt(0)" ::: "memory");
    const int c = lane & 7;
#pragma unroll
    for (int j = 0; j < 4; ++j) { const int n = (lane >> 3) + 8 * j; const LAS float* s = scr + (8 * c) * 33 + n;
        u32x4 o; o.x = pk2(s[0 * 33], s[1 * 33]); o.y = pk2(s[2 * 33], s[3 * 33]); o.z = pk2(s[4 * 33], s[5 * 33]); o.w = pk2(s[6 * 33], s[7 * 33]);
        *(u32x4*)(WT + (size_t)(drow + n) * K + k0 + 8 * c) = o; }
    asm volatile("s_waitcnt lgkmcnt(0)" ::: "memory");
}

struct Params { const float* in[20]; float* out; unsigned char* ws; };
enum { I_X = 0, I_C, I_POS, I_ADAW, I_ADAB, I_GMIX, I_GMLP, I_FWIN, I_FBF, I_FWOUT, I_MDQ, I_MQG, I_MUQ, I_MDKV, I_MKVG, I_MUKV, I_MOUT, I_W1, I_W2, I_GFIN };

__device__ __forceinline__ void prologue(const Params& p, LAS unsigned char* lds, const int wv_) {
    const int BID = obid(), GSZ = ogrid(); const int tid_ = otid(wv_);
    const int tid = tid_, lane = tid & 63, wave = __builtin_amdgcn_readfirstlane(tid >> 6);
    unsigned char* ws = p.ws;
    {
        LAS float* cact = (LAS float*)lds;
        LAS float* part = (LAS float*)(lds + 65536);
        const float* c = p.in[I_C];
        for (int idx = tid; idx < NB * DM; idx += NTHR) { const int b = idx >> 10, k = idx & 1023; const float v = c[idx]; cact[k * 16 + b] = v / (1.0f + __expf(-v)); }
        __syncthreads();
        float* mod = (float*)(ws + WS_MOD);
        for (int item = BID; item < 256; item += GSZ) {
            const int l = item >> 6, n0 = (item & 63) * 96, cg = tid % 24, ks = tid / 24; const bool act = tid < 384;
            f32x4 acc[16];
#pragma unroll
            for (int b = 0; b < 16; ++b) acc[b] = (f32x4){0.f, 0.f, 0.f, 0.f};
            if (act) {
                const float* wp = p.in[I_ADAW] + ((size_t)l * DM + ks * 64) * 6144 + n0 + 4 * cg;
                const LAS f32x4* cp = (const LAS f32x4*)(cact + ks * 64 * 16);
#pragma unroll 4
                for (int k = 0; k < 64; ++k) { const f32x4 w = *(const f32x4*)(wp + (size_t)k * 6144);
                    const f32x4 c0 = cp[k * 4 + 0], c1 = cp[k * 4 + 1], c2 = cp[k * 4 + 2], c3 = cp[k * 4 + 3];
                    acc[0] += w * c0[0]; acc[1] += w * c0[1]; acc[2] += w * c0[2]; acc[3] += w * c0[3];
                    acc[4] += w * c1[0]; acc[5] += w * c1[1]; acc[6] += w * c1[2]; acc[7] += w * c1[3];
                    acc[8] += w * c2[0]; acc[9] += w * c2[1]; acc[10] += w * c2[2]; acc[11] += w * c2[3];
                    acc[12] += w * c3[0]; acc[13] += w * c3[1]; acc[14] += w * c3[2]; acc[15] += w * c3[3]; }
            }
#pragma unroll
            for (int half = 0; half < 2; ++half) {
                if (act) {
#pragma unroll
                    for (int b8 = 0; b8 < 8; ++b8) *(LAS f32x4*)(part + (ks * 8 + b8) * 96 + 4 * cg) = acc[half * 8 + b8]; }
                __syncthreads();
                for (int o = tid; o < 8 * 96; o += NTHR) { const int b8 = o / 96, cc = o % 96; float s = 0.f;
#pragma unroll
                    for (int k2 = 0; k2 < 16; ++k2) s += part[(k2 * 8 + b8) * 96 + cc];
                    mod[((size_t)l * 16 + half * 8 + b8) * 6144 + n0 + cc] = s + p.in[I_ADAB][(size_t)l * 6144 + n0 + cc]; }
                __syncthreads();
            }
        }
    }
    __syncthreads();
    {
        const int* pos = (const int*)p.in[I_POS]; float* cst = (float*)(ws + WS_CS);
        for (size_t idx = (size_t)BID * NTHR + tid; idx < (size_t)M * 16; idx += (size_t)GSZ * NTHR) {
            const int tok = (int)(idx >> 4), i = (int)(idx & 15);
            const float invf = exp2f(-(float)i * (13.287712379549449f / 16.0f));
            const float ang = (float)pos[tok] * invf;
            double rev = (double)ang * 0.15915494309189535; rev -= __builtin_rint(rev);
            const float rf = (float)rev;
            cst[(size_t)tok * 32 + i] = __builtin_amdgcn_cosf(rf); cst[(size_t)tok * 32 + 16 + i] = __builtin_amdgcn_sinf(rf);
        }
    }
    for (int j = 0; j < 2; ++j) { u32x4* z = (u32x4*)(ws + WS_W + W_MLA + j * W_MLA_STRIDE + (size_t)416 * 1024 * 2);
        for (int idx = BID * NTHR + tid; idx < 96 * 1024 * 2 / 16; idx += GSZ * NTHR) z[idx] = (u32x4){0u, 0u, 0u, 0u}; }
    {
        LAS float* scr = (LAS float*)(lds + wave * 16384);
        const int gw = BID * NWAVE + wave, NGW = GSZ * NWAVE;
        constexpr int N_MLP = 4 * 4096, N_FOX = 2 * 2048, N_MLA = 2 * 1040;
        for (int it = gw; it < N_MLP + N_FOX + N_MLA; it += NGW) {
            int r = it;
            if (r < N_MLP) { const int l = r >> 12, rr = r & 4095; bf16* wb = (bf16*)(ws + WS_W + W_MLP + (size_t)l * W_MLP_STRIDE);
                if (rr < 2048) transpose_item(p.in[I_W1] + (size_t)l * DM * FF, FF, DM, FF, wb, 0, 0, nullptr, scr, rr, lane);
                else transpose_item(p.in[I_W2] + (size_t)l * DM * FF, DM, FF, DM, wb + (size_t)FF * DM, 0, 0, nullptr, scr, rr - 2048, lane);
                continue; }
            r -= N_MLP;
            if (r < N_FOX) { const int j = r >> 11, rr = r & 2047; bf16* wb = (bf16*)(ws + WS_W + W_FOX + (size_t)j * W_FOX_STRIDE);
                if (rr < 1536) transpose_item(p.in[I_FWIN] + (size_t)j * DM * 3088, 3088, DM, 3072, wb, 0, 0, nullptr, scr, rr, lane);
                else transpose_item(p.in[I_FWOUT] + (size_t)j * DM * DM, DM, DM, DM, wb + (size_t)3072 * DM, 0, 0, nullptr, scr, rr - 1536, lane);
                continue; }
            r -= N_FOX;
            { const int j = r / 1040, rr = r % 1040; bf16* wb = (bf16*)(ws + WS_W + W_MLA + (size_t)j * W_MLA_STRIDE);
                if (rr < 128) transpose_item(p.in[I_MDQ] + (size_t)j * DM * 256, 256, DM, 256, wb, 0, 0, nullptr, scr, rr, lane);
                else if (rr < 208) transpose_item(p.in[I_MDKV] + (size_t)j * DM * 160, 160, DM, 160, wb, 0, 256, nullptr, scr, rr - 128, lane);
                else if (rr < 400) transpose_item(p.in[I_MUQ] + (size_t)j * 256 * 1536, 1536, 256, 1536, wb + (size_t)512 * 1024, 1, 0, p.in[I_MQG] + j * 256, scr, rr - 208, lane);
                else if (rr < 528) transpose_item(p.in[I_MUKV] + (size_t)j * 128 * 2048, 2048, 128, 2048, wb + (size_t)512 * 1024 + (size_t)1536 * 256, 2, 0, p.in[I_MKVG] + j * 128, scr, rr - 400, lane);
                else transpose_item(p.in[I_MOUT] + (size_t)j * DM * DM, DM, DM, DM, (bf16*)((unsigned char*)wb + 3 * MiB), 0, 0, nullptr, scr, rr - 528, lane);
            }
        }
    }
}

template <int NR, bool gates>
__device__ __forceinline__ void norm_phase(const void* xv, const bool xbf, const float* g, const float* sh0, const float* sc0, bf16* hout, const float* wfsrc, const float* bfv, float* lf, LAS unsigned char* lds, const int wv_) {
    const int BID = obid(), GSZ = ogrid(); const int tid_ = otid(wv_);
    const int tid = tid_, lane = tid & 63, wave = __builtin_amdgcn_readfirstlane(tid >> 6);
    LAS float* wfs = (LAS float*)lds;
    if constexpr (gates) {
        for (int idx = tid; idx < 16 * 1024; idx += NTHR) { const int k = idx >> 4, j = idx & 15; wfs[j * 1024 + k] = wfsrc[(size_t)k * 3088 + 3072 + j]; }
        __syncthreads();
    }
    const int gw = BID * NWAVE + wave, NGW = GSZ * NWAVE;
    for (int row0 = gw * NR; row0 < M; row0 += NGW * NR) {
        const int b = row0 >> 11;
        f32x4 v[NR][4]; float ss[NR];
        if (xbf) {
#pragma unroll
            for (int r = 0; r < NR; ++r) { const u32x2* xr = (const u32x2*)((const bf16*)xv + (size_t)(row0 + r) * DM) + lane;
#pragma unroll
                for (int j = 0; j < 4; ++j) { const u32x2 w = xr[64 * j];
                    v[r][j] = (f32x4){__builtin_bit_cast(float, w.x << 16), __builtin_bit_cast(float, w.x & 0xffff0000u), __builtin_bit_cast(float, w.y << 16), __builtin_bit_cast(float, w.y & 0xffff0000u)}; } }
        } else {
#pragma unroll
            for (int r = 0; r < NR; ++r) { const f32x4* xr = (const f32x4*)((const float*)xv + (size_t)(row0 + r) * DM) + lane;
#pragma unroll
                for (int j = 0; j < 4; ++j) v[r][j] = xr[64 * j]; }
        }
#pragma unroll
        for (int r = 0; r < NR; ++r) { float s = 0.f;
#pragma unroll
            for (int j = 0; j < 4; ++j) s += (v[r][j][0] * v[r][j][0] + v[r][j][1] * v[r][j][1]) + (v[r][j][2] * v[r][j][2] + v[r][j][3] * v[r][j][3]);
            ss[r] = s; }
#pragma unroll
        for (int r = 0; r < NR; ++r) ss[r] = wave_sum(ss[r]);
        const f32x4* gp = (const f32x4*)g + lane; const f32x4* shp = (const f32x4*)(sh0 + (size_t)b * 6144) + lane; const f32x4* scp = (const f32x4*)(sc0 + (size_t)b * 6144) + lane;
#pragma unroll
        for (int j = 0; j < 4; ++j) { const f32x4 aa = gp[64 * j] * (scp[64 * j] + 1.0f), sh = shp[64 * j];
#pragma unroll
            for (int r = 0; r < NR; ++r) { const float rstd = __builtin_amdgcn_rsqf(ss[r] * (1.0f / DM) + EPS);
                v[r][j] = (v[r][j] * rstd) * aa + sh;
                u32x2 w; w.x = pk2(v[r][j][0], v[r][j][1]); w.y = pk2(v[r][j][2], v[r][j][3]); ((u32x2*)(hout + (size_t)(row0 + r) * DM) + lane)[64 * j] = w; } }
        if constexpr (gates) {
            static_assert(NR == 2, "the gate path pairs two rows in f32x2");
            f32x2 vv[4][4], z[16];
#pragma unroll
            for (int jj = 0; jj < 4; ++jj)
#pragma unroll
                for (int e = 0; e < 4; ++e) vv[jj][e] = (f32x2){v[0][jj][e], v[1][jj][e]};
#pragma unroll
            for (int jg = 0; jg < 16; ++jg) {
                f32x2 acc = (f32x2){0.f, 0.f};
#pragma unroll
                for (int jj = 0; jj < 4; ++jj) { const f32x4 w = *(const LAS f32x4*)(wfs + jg * 1024 + 256 * jj + 4 * lane);
                    acc += (vv[jj][0] * w[0] + vv[jj][1] * w[1]) + (vv[jj][2] * w[2] + vv[jj][3] * w[3]); }
                z[jg] = acc;
                if (jg & 1) asm volatile("" ::: "memory"); }
            const bool b5 = (lane & 32) != 0, b4 = (lane & 16) != 0, b3 = (lane & 8) != 0, b2 = (lane & 4) != 0;
            f32x2 a8[8], a4[4], a2[2], a1;
#pragma unroll
            for (int i = 0; i < 8; ++i) { const f32x2 send = b5 ? z[i] : z[i + 8], keep = b5 ? z[i + 8] : z[i]; a8[i] = keep + (f32x2){xor_get<32>(send[0], b5), xor_get<32>(send[1], b5)}; }
#pragma unroll
            for (int i = 0; i < 4; ++i) { const f32x2 send = b4 ? a8[i] : a8[i + 4], keep = b4 ? a8[i + 4] : a8[i]; a4[i] = keep + (f32x2){xor_get<16>(send[0], b4), xor_get<16>(send[1], b4)}; }
#pragma unroll
            for (int i = 0; i < 2; ++i) { const f32x2 send = b3 ? a4[i] : a4[i + 2], keep = b3 ? a4[i + 2] : a4[i]; a2[i] = keep + (f32x2){xor_get<8>(send[0], b3), xor_get<8>(send[1], b3)}; }
            { const f32x2 send = b2 ? a2[0] : a2[1], keep = b2 ? a2[1] : a2[0]; a1 = keep + (f32x2){xor_get<4>(send[0], b2), xor_get<4>(send[1], b2)}; }
            a1 = (f32x2){xor_sum<2>(a1[0]), xor_sum<2>(a1[1])}; a1 = (f32x2){xor_sum<1>(a1[0]), xor_sum<1>(a1[1])};
            const int gate = (b5 ? 8 : 0) + (b4 ? 4 : 0) + (b3 ? 2 : 0) + (b2 ? 1 : 0);
            if ((lane & 3) == 0) { const float bb = bfv[gate];
#pragma unroll
                for (int r = 0; r < NR; ++r) { const float zz = a1[r] + bb; lf[(size_t)(row0 + r) * 16 + gate] = fminf(zz, 0.f) - __logf(1.0f + __expf(-fabsf(zz))); } }
        }
    }
}

__device__ __forceinline__ void final_norm(const bf16* xb, float* out, const float* g, const int wv_) {
    constexpr int NR = 4;
    const int BID = obid(), GSZ = ogrid(); const int tid_ = otid(wv_);
    const int tid = tid_, lane = tid & 63, wave = __builtin_amdgcn_readfirstlane(tid >> 6);
    const int gw = BID * NWAVE + wave, NGW = GSZ * NWAVE;
    for (int row0 = gw * NR; row0 < M; row0 += NGW * NR) {
        f32x4 v[NR][4]; float ss[NR];
#pragma unroll
        for (int r = 0; r < NR; ++r) { const u32x2* xr = (const u32x2*)(xb + (size_t)(row0 + r) * DM) + lane;
#pragma unroll
            for (int j = 0; j < 4; ++j) { const u32x2 w = xr[64 * j];
                v[r][j] = (f32x4){__builtin_bit_cast(float, w.x << 16), __builtin_bit_cast(float, w.x & 0xffff0000u), __builtin_bit_cast(float, w.y << 16), __builtin_bit_cast(float, w.y & 0xffff0000u)}; } }
#pragma unroll
        for (int r = 0; r < NR; ++r) { float s = 0.f;
#pragma unroll
            for (int j = 0; j < 4; ++j) s += (v[r][j][0] * v[r][j][0] + v[r][j][1] * v[r][j][1]) + (v[r][j][2] * v[r][j][2] + v[r][j][3] * v[r][j][3]);
            ss[r] = wave_sum(s); }
        const f32x4* gp = (const f32x4*)g + lane;
#pragma unroll
        for (int j = 0; j < 4; ++j) { const f32x4 gg = gp[64 * j];
#pragma unroll
            for (int r = 0; r < NR; ++r) { const float rstd = __builtin_amdgcn_rsqf(ss[r] * (1.0f / DM) + EPS); ((f32x4*)(out + (size_t)(row0 + r) * DM) + lane)[64 * j] = (v[r][j] * rstd) * gg; } }
    }
}

__device__ __forceinline__ void fox_cumsum(const float* lf, bf16* Qb, bf16* Kb, LAS unsigned char* lds, const int wv_) {
    const int BID = obid(), GSZ = ogrid(); const int tid_ = otid(wv_);
    const int tid = tid_, lane = tid & 63, wave = __builtin_amdgcn_readfirstlane(tid >> 6);
    LAS float* wtot = (LAS float*)lds;
    for (int bh = BID; bh < NB * NH; bh += GSZ) {
        const int b = bh >> 4, h = bh & 15; const int s0 = 4 * tid;
        float a[4];
#pragma unroll
        for (int i = 0; i < 4; ++i) a[i] = lf[((size_t)(b * SEQ + s0 + i)) * 16 + h];
        a[1] += a[0]; a[2] += a[1]; a[3] += a[2];
        float xs = a[3];
#pragma unroll
        for (int off = 1; off < 64; off <<= 1) { const float t = __shfl_up(xs, off); if (lane >= off) xs += t; }
        if (lane == 63) wtot[wave] = xs;
        __syncthreads();
        float base = 0.f;
#pragma unroll
        for (int w = 0; w < NWAVE; ++w) { const float t = wtot[w]; if (w < wave) base += t; }
        const float excl = xs - a[3] + base;
#pragma unroll
        for (int i = 0; i < 4; ++i) {
            const float F = (a[i] + excl) * LOG2E;
            const unsigned fh = f2bf(F); const float r1 = F - bf2f(fh); const unsigned fm = f2bf(r1); const float r2 = r1 - bf2f(fm); const unsigned fl = f2bf(r2);
            const size_t tok = (size_t)(b * SEQ + s0 + i);
            u32x4* qd = (u32x4*)(Qb + tok * 1280 + h * 80 + 64); u32x4* kd = (u32x4*)(Kb + tok * 1280 + h * 80 + 64);
            unsigned zz = 0u; asm volatile("" : "+v"(zz));
            qd[0] = (u32x4){0x3F803F80u, 0x3F80u | (fh << 16), fm | (fl << 16), zz}; qd[1] = (u32x4){zz, zz, zz, zz};
            kd[0] = (u32x4){(fh ^ 0x8000u) | ((fm ^ 0x8000u) << 16), (fl ^ 0x8000u) | (0x3F80u << 16), 0x3F803F80u, zz}; kd[1] = (u32x4){zz, zz, zz, zz};
        }
        __syncthreads();
    }
}

constexpr int PTR_OFF = 131072;
__device__ __forceinline__ int crow(int r, int hi) { return (r & 3) + 8 * (r >> 2) + 4 * hi; }
__device__ __forceinline__ unsigned cvtpk(float lo, float hi) { typedef __bf16 bf16x2_t __attribute__((ext_vector_type(2))); f32x2 v = {lo, hi}; bf16x2_t b = __builtin_convertvector(v, bf16x2_t); return __builtin_bit_cast(unsigned, b); }
typedef short v4i16_t __attribute__((ext_vector_type(4)));
__device__ __forceinline__ s16x4 vtr(const LAS unsigned char* p) { return __builtin_bit_cast(s16x4, __builtin_amdgcn_ds_read_tr16_b64_v4i16((LAS v4i16_t*)p)); }
#define MFMA32(a, b, c) __builtin_amdgcn_mfma_f32_32x32x16_bf16((a), (b), (c), 0, 0, 0)

template <int NKS>
__device__ __forceinline__ void attn_phase(LAS unsigned char* lds, const bf16* Q_, const bf16* K_, const bf16* V_, bf16* O_, const int wv_) {
    constexpr int QKD = 16 * NKS, QP = 16 * QKD, RS = QKD * 2 + 16, KCH = QKD / 8, NKC = 64 * KCH;
    constexpr int KB_BYTES = 64 * RS, L_K = 0, L_V = 2 * KB_BYTES, L_WS = L_V + 2 * 8192, L_ST = L_WS + NWAVE * 128;
    constexpr float THR = 20.0f;
    static_assert(L_ST + NWAVE * 4096 <= PTR_OFF, "attention LDS");
    typedef __attribute__((address_space(1))) const bf16 gcb; typedef __attribute__((address_space(1))) bf16 gb;
    gcb* Q = (gcb*)Q_; gcb* K = (gcb*)K_; gcb* V = (gcb*)V_; gb* O = (gb*)O_;
    const int BID = obid(), GSZ = ogrid(); const int tid_ = otid(wv_);
    const int tid = tid_, lane = tid & 63, r32 = lane & 31, hi = lane >> 5; const int wid = __builtin_amdgcn_readfirstlane(tid >> 6);
    LAS float* wsf = (LAS float*)(lds + L_WS) + wid * 32;
    LAS bf16* stg = (LAS bf16*)(lds + L_ST) + wid * 2048;
    constexpr int KCP = KCH + 1, NCHK = 64 * KCP; static_assert(NCHK % 64 == 0 && NCHK <= 1024, "K image is a whole number of 1 KiB pieces");
    const bool has1 = (wid + 8) * 64 < NCHK;
    const int ca = wid * 64 + lane, cb = has1 ? ca + 512 : ca;
    const unsigned kgo0 = (unsigned)((ca / KCP) * QP + ((ca % KCP) < KCH ? (ca % KCP) : 0) * 8), kgo1 = (unsigned)((cb / KCP) * QP + ((cb % KCP) < KCH ? (cb % KCP) : 0) * 8);
    const int vr = ca >> 3, vp = ca & 7; const unsigned vgo = (unsigned)(vr * DM + ((((vp >> 2) ^ ((vr >> 1) & 1)) << 2) | (vp & 3)) * 8);
    const int kd0 = wid * 1024, kd1 = (wid + 8) * 1024, vd = wid * 1024;
    const int kfb = r32 * RS + hi * 16;
    const int i16 = lane & 15, qq = i16 >> 2, pp = i16 & 3, blk = (lane >> 4) & 1, swz = (qq >> 1) & 1;
    const int vfb0 = (4 * hi + qq) * 128 + 32 * blk + 8 * pp + swz * 64, vfb1 = (4 * hi + qq) * 128 + 32 * blk + 8 * pp + (swz ^ 1) * 64;
#define A_GLDS(GP, LOFF) do { unsigned keep_; const unsigned ldst_ = (unsigned)__builtin_amdgcn_readfirstlane((int)(unsigned)(size_t)(lds + (LOFF))); \
        asm volatile("s_mov_b32 %0, m0\n\ts_mov_b32 m0, %2\n\ts_nop 0\n\tglobal_load_lds_dwordx4 %1, off\n\ts_mov_b32 m0, %0" : "=&s"(keep_) : "v"(GP), "s"(ldst_) : "memory"); } while (0)
#define A_DMAK(t, buf) do { gcb* Kt_ = Kh + (size_t)((unsigned)(t) * 64u) * QP; asm volatile("" : "+s"(Kt_)); A_GLDS(Kt_ + kgo0, L_K + (buf) * KB_BYTES + kd0); \
        if (has1) A_GLDS(Kt_ + kgo1, L_K + (buf) * KB_BYTES + kd1); } while (0)
#define A_DMAV(t, buf) do { gcb* Vt_ = Vh + (size_t)((unsigned)(t) * 64u) * DM; asm volatile("" : "+s"(Vt_)); A_GLDS(Vt_ + vgo, L_V + (buf) * 8192 + vd); } while (0)
#define A_DMAWAIT() asm volatile("s_waitcnt vmcnt(0)" ::: "memory")
#define A_QK(P0, P1, buf, CINIT) do { const LAS unsigned char* Kl_ = lds + L_K + (buf) * KB_BYTES + kfb; \
        bf16x8 a0_ = *(const LAS bf16x8*)(Kl_), a1_ = *(const LAS bf16x8*)(Kl_ + 32 * RS); \
        _Pragma("unroll") for (int ks = 0; ks < NKS; ++ks) { bf16x8 n0_ = a0_, n1_ = a1_; \
            if (ks + 1 < NKS) { n0_ = *(const LAS bf16x8*)(Kl_ + (ks + 1) * 32); n1_ = *(const LAS bf16x8*)(Kl_ + 32 * RS + (ks + 1) * 32); } \
            if (ks == 0) { P0 = MFMA32(a0_, qr[0], CINIT); P1 = MFMA32(a1_, qr[0], CINIT); } else { P0 = MFMA32(a0_, qr[ks], P0); P1 = MFMA32(a1_, qr[ks], P1); } \
            a0_ = n0_; a1_ = n1_; } } while (0)
#define A_VRD(kk, L0, H0, L1, H1) do { L0 = vtr(Vl_ + vfb0 + (kk) * 2048); H0 = vtr(Vl_ + vfb0 + (kk) * 2048 + 1024); L1 = vtr(Vl_ + vfb1 + (kk) * 2048); H1 = vtr(Vl_ + vfb1 + (kk) * 2048 + 1024); } while (0)
#define A_PV(buf) do { const LAS unsigned char* Vl_ = lds + L_V + (buf) * 8192; s16x4 l0_, h0_, l1_, h1_; A_VRD(0, l0_, h0_, l1_, h1_); \
        _Pragma("unroll") for (int kk = 0; kk < 4; ++kk) { s16x4 nl0_ = l0_, nh0_ = h0_, nl1_ = l1_, nh1_ = h1_; \
            if (kk + 1 < 4) A_VRD(kk + 1, nl0_, nh0_, nl1_, nh1_); \
            const bf16x8 b0_ = (bf16x8){l0_[0], l0_[1], l0_[2], l0_[3], h0_[0], h0_[1], h0_[2], h0_[3]}, b1_ = (bf16x8){l1_[0], l1_[1], l1_[2], l1_[3], h1_[0], h1_[1], h1_[2], h1_[3]}; \
            o0 = MFMA32(PAp[kk], b0_, o0); o1 = MFMA32(PAp[kk], b1_, o1); \
            l0_ = nl0_; h0_ = nh0_; l1_ = nl1_; h1_ = nh1_; } } while (0)
#define A_MASK(t) do { const int kb0_ = 64 * (t) + 4 * hi; \
        _Pragma("unroll") for (int i = 0; i < 16; ++i) { const int kv_ = kb0_ + (i & 3) + 8 * (i >> 2); if (kv_ > qabs) pc0[i] = -INFINITY; if (kv_ + 32 > qabs) pc1[i] = -INFINITY; } } while (0)
#define A_ROWMAX(RM) do { float a_ = __builtin_fmaxf(__builtin_fmaxf(pc0[0], pc0[1]), pc1[0]), b_ = __builtin_fmaxf(__builtin_fmaxf(pc0[2], pc0[3]), pc1[1]); a_ = __builtin_fmaxf(__builtin_fmaxf(a_, pc1[2]), pc1[3]); \
        _Pragma("unroll") for (int r = 4; r < 16; r += 4) { a_ = __builtin_fmaxf(__builtin_fmaxf(a_, pc0[r]), pc0[r + 1]); b_ = __builtin_fmaxf(__builtin_fmaxf(b_, pc0[r + 2]), pc0[r + 3]); \
            a_ = __builtin_fmaxf(__builtin_fmaxf(a_, pc1[r]), pc1[r + 1]); b_ = __builtin_fmaxf(__builtin_fmaxf(b_, pc1[r + 2]), pc1[r + 3]); } \
        RM = __builtin_fmaxf(a_, b_); { auto rr_ = __builtin_amdgcn_permlane32_swap(__float_as_uint(RM), __float_as_uint(RM), false, false); RM = __builtin_fmaxf(__uint_as_float(rr_[0]), __uint_as_float(rr_[1])); } } while (0)
#define A_EXPPACK() do { float ls_ = 0.f; \
        _Pragma("unroll") for (int i = 0; i < 16; ++i) { pc0[i] = __builtin_amdgcn_exp2f(pc0[i]); pc1[i] = __builtin_amdgcn_exp2f(pc1[i]); ls_ += pc0[i] + pc1[i]; } \
        lrow += ls_; u32x4 w_; \
        w_ = (u32x4){cvtpk(pc0[0], pc0[1]), cvtpk(pc0[2], pc0[3]), cvtpk(pc0[4], pc0[5]), cvtpk(pc0[6], pc0[7])}; PAc[0] = __builtin_bit_cast(bf16x8, w_); \
        w_ = (u32x4){cvtpk(pc0[8], pc0[9]), cvtpk(pc0[10], pc0[11]), cvtpk(pc0[12], pc0[13]), cvtpk(pc0[14], pc0[15])}; PAc[1] = __builtin_bit_cast(bf16x8, w_); \
        w_ = (u32x4){cvtpk(pc1[0], pc1[1]), cvtpk(pc1[2], pc1[3]), cvtpk(pc1[4], pc1[5]), cvtpk(pc1[6], pc1[7])}; PAc[2] = __builtin_bit_cast(bf16x8, w_); \
        w_ = (u32x4){cvtpk(pc1[8], pc1[9]), cvtpk(pc1[10], pc1[11]), cvtpk(pc1[12], pc1[13]), cvtpk(pc1[14], pc1[15])}; PAc[3] = __builtin_bit_cast(bf16x8, w_); } while (0)
#define A_VALU(t, BAND) do { if (BAND) A_MASK(t); float rm_; A_ROWMAX(rm_); rm_ -= mrow; upd = __any(rm_ > THR); \
        if (upd) { const float dl_ = __builtin_fmaxf(rm_, 0.f); mrow += dl_; \
            fsc = __builtin_amdgcn_exp2f(-dl_); lrow *= fsc; } \
        _Pragma("unroll") for (int i = 0; i < 16; ++i) { pc0[i] -= mrow; pc1[i] -= mrow; } \
        A_EXPPACK(); } while (0)
#define A_KRD(ks) do { kf_[2 * (ks)] = *(const LAS bf16x8*)(Kl_ + (ks) * 32); kf_[2 * (ks) + 1] = *(const LAS bf16x8*)(Kl_ + 32 * RS + (ks) * 32); } while (0)
#define A_MFMA(t, DOQK, DOPV) do { const LAS unsigned char* Kl_ = lds + L_K + (((t) + 1) & 1) * KB_BYTES + kfb; const LAS unsigned char* Vl_ = lds + L_V + (((t) - 1) & 1) * 8192; \
        s16x4 vl0_[4], vh0_[4], vl1_[4], vh1_[4]; \
        if (DOQK) { bf16x8 kf_[2 * NKS]; \
            A_KRD(0); A_KRD(1); \
            __builtin_amdgcn_sched_barrier(0); \
            _Pragma("unroll") for (int ks = 0; ks < NKS; ++ks) { \
                if (ks == 0) { pn0 = MFMA32(kf_[0], qr[0], ((f32x16)(0.0f))); pn1 = MFMA32(kf_[1], qr[0], ((f32x16)(0.0f))); } \
                else { pn0 = MFMA32(kf_[2 * ks], qr[ks], pn0); pn1 = MFMA32(kf_[2 * ks + 1], qr[ks], pn1); } \
                if (ks + 2 < NKS) A_KRD(ks + 2); \
                if (ks >= NKS - 2) A_VRD(ks - (NKS - 2), vl0_[ks - (NKS - 2)], vh0_[ks - (NKS - 2)], vl1_[ks - (NKS - 2)], vh1_[ks - (NKS - 2)]); \
                __builtin_amdgcn_sched_barrier(0); } } \
        else if (DOPV) { A_VRD(0, vl0_[0], vh0_[0], vl1_[0], vh1_[0]); A_VRD(1, vl0_[1], vh0_[1], vl1_[1], vh1_[1]); } \
        if (DOPV) { \
            _Pragma("unroll") for (int kk = 0; kk < 4; ++kk) { \
                const bf16x8 b0_ = (bf16x8){vl0_[kk][0], vl0_[kk][1], vl0_[kk][2], vl0_[kk][3], vh0_[kk][0], vh0_[kk][1], vh0_[kk][2], vh0_[kk][3]}; \
                const bf16x8 b1_ = (bf16x8){vl1_[kk][0], vl1_[kk][1], vl1_[kk][2], vl1_[kk][3], vh1_[kk][0], vh1_[kk][1], vh1_[kk][2], vh1_[kk][3]}; \
                o0 = MFMA32(PAp[kk], b0_, o0); o1 = MFMA32(PAp[kk], b1_, o1); \
                if (kk + 2 < 4) A_VRD(kk + 2, vl0_[kk + 2], vh0_[kk + 2], vl1_[kk + 2], vh1_[kk + 2]); \
                __builtin_amdgcn_sched_barrier(0); } } } while (0)
    const bool teamed = (GSZ == 256);
    const int xcd = BID & 7, slot = BID >> 3, team = slot >> 3, mem = slot & 7;
#ifdef PROBE_AT
    unsigned long long pacc = 0, pt0 = 0;
#define PT_BEG(C) do { if (PROBE_AT == (C)) pt0 = __builtin_amdgcn_s_memtime(); } while (0)
#define PT_END(C) do { if (PROBE_AT == (C)) pacc += __builtin_amdgcn_s_memtime() - pt0; } while (0)
#else
#define PT_BEG(C) do {} while (0)
#define PT_END(C) do {} while (0)
#endif
    const int nit = teamed ? 8 : 8 * ((NB * NH - BID + GSZ - 1) / GSZ);
#define A_UNIT(i, BH, QB) do { if (teamed) { BH = (xcd * 4 + team) * 8 + (i); QB = (mem + (i)) & 7; } else { BH = BID + ((i) >> 3) * GSZ; QB = 7 - ((i) & 7); } } while (0)
    bf16x8 qr[NKS];
#define A_PREFETCH(i) do { int bh_, qb_; A_UNIT(i, bh_, qb_); const size_t rb_ = (size_t)(bh_ >> 4) * SEQ; const int h_ = bh_ & 15; \
        gcb* Kh = K + rb_ * QP + h_ * QKD; gcb* Vh = V + rb_ * DM + h_ * 64; gcb* Qu_ = Q + (rb_ + qb_ * 256 + wid * 32) * QP + h_ * QKD; \
        unsigned qgo_; { int lq = lane; asm volatile("" : "+v"(lq)); qgo_ = (unsigned)((lq & 31) * QP + (lq >> 5) * 8); } \
        _Pragma("unroll") for (int ks = 0; ks < NKS; ++ks) qr[ks] = *(const __attribute__((address_space(1))) bf16x8*)(Qu_ + qgo_ + ks * 16); \
        A_DMAK(0, 0); A_DMAV(0, 0); A_DMAK(1, 1); } while (0)
    if (nit > 0) A_PREFETCH(0);
    for (int it = 0; it < nit; ++it) {
        int bh, qb; A_UNIT(it, bh, qb);
        const int b = bh >> 4, h = bh & 15; const size_t rowbase = (size_t)b * SEQ;
        gcb* Kh = K + rowbase * QP + h * QKD; gcb* Vh = V + rowbase * DM + h * 64;
        {
            const int q0 = qb * 256; const int NT = 4 * qb + 4;
            PT_BEG('U');
            const int qabs = q0 + wid * 32 + r32; const int Tw = 4 * qb + (wid >> 1);
            A_DMAWAIT(); __syncthreads();
            f32x16 pc0, pc1, pn0, pn1, o0 = (f32x16)(0.0f), o1 = (f32x16)(0.0f);
            A_QK(pc0, pc1, 0, ((f32x16)(0.0f))); A_QK(pn0, pn1, 1, ((f32x16)(0.0f)));
            bf16x8 PAp[4], PAc[4]; float mrow, lrow = 0.f, fsc = 1.f; bool upd = false;
            { if (NT == 4) A_MASK(0);
              float rm_; A_ROWMAX(rm_); mrow = rm_;
#pragma unroll
              for (int i = 0; i < 16; ++i) { pc0[i] -= mrow; pc1[i] -= mrow; }
              A_EXPPACK(); }
#pragma unroll
            for (int k4 = 0; k4 < 4; ++k4) PAp[k4] = PAc[k4];
            pc0 = pn0; pc1 = pn1;
            __syncthreads();
            A_DMAK(2, 0);
            A_DMAWAIT(); __syncthreads();
            PT_END('U');
            for (int t = 1; t < NT; ++t) {
                if (t + 2 < NT) A_DMAK(t + 2, t & 1);
                A_DMAV(t, t & 1);
                const bool band = (t >= NT - 4);
                const bool doqk = (t + 1 <= Tw), dopv = (t - 1 <= Tw), dova = (t <= Tw);
                A_MFMA(t, doqk, dopv);
                if (dova) { A_VALU(t, band); } else { upd = false; }
                if (upd) {
                    if (hi == 0) wsf[r32] = fsc;
                    asm volatile("" ::: "memory");
#pragma unroll
                    for (int g4 = 0; g4 < 4; ++g4) { const f32x4 a = *(const LAS f32x4*)(wsf + 8 * g4 + 4 * hi);
#pragma unroll
                        for (int j = 0; j < 4; ++j) { o0[4 * g4 + j] *= a[j]; o1[4 * g4 + j] *= a[j]; } }
                    asm volatile("" ::: "memory");
                }
                A_DMAWAIT(); __syncthreads();
                pc0 = pn0; pc1 = pn1;
#pragma unroll
                for (int k4 = 0; k4 < 4; ++k4) PAp[k4] = PAc[k4];
            }
            PT_BEG('U');
            { const int inx = (it + 1 < nit) ? it + 1 : it; A_PREFETCH(inx); }
            if (NT - 1 <= Tw) { A_PV((NT - 1) & 1); }
            lrow = xor_sum<32>(lrow);
            { int le = lane; asm volatile("" : "+v"(le));
              const int r32e = le & 31, hie = le >> 5;
              if (hie == 0) wsf[r32e] = 1.0f / lrow;
              asm volatile("" ::: "memory");
              LAS bf16* st0 = stg + (4 * hie) * 64 + r32e;
#pragma unroll
              for (int g4 = 0; g4 < 4; ++g4) { const f32x4 a = *(const LAS f32x4*)(wsf + 8 * g4 + 4 * hie);
#pragma unroll
                  for (int j = 0; j < 4; ++j) { const int i = 4 * g4 + j;
                      st0[(8 * g4 + j) * 64] = (bf16)f2bf(o0[i] * a[j]); st0[(8 * g4 + j) * 64 + 32] = (bf16)f2bf(o1[i] * a[j]); } }
              asm volatile("s_waitcnt lgkmcnt(0)" ::: "memory");
              const unsigned lo_ = (unsigned)((le >> 3) * DM + (le & 7) * 8); const LAS bf16* sr0 = stg + (le >> 3) * 64 + (le & 7) * 8;
#pragma unroll
              for (int i = 0; i < 4; ++i) { gb* Ow = O + (rowbase + q0 + wid * 32 + i * 8) * DM + h * 64; const u32x4 v = *(const LAS u32x4*)(sr0 + i * 8 * 64); *(__attribute__((address_space(1))) u32x4*)(Ow + lo_) = v; } }
            A_DMAWAIT(); __syncthreads();
            PT_END('U');
        }
    }
#ifdef PROBE_AT
    { const unsigned long long w0 = __builtin_amdgcn_s_memtime(); while (__builtin_amdgcn_s_memtime() - w0 < pacc) __builtin_amdgcn_s_sleep(4); }
#endif
#undef PT_BEG
#undef PT_END
#undef A_GLDS
#undef A_UNIT
#undef A_PREFETCH
#undef A_DMAK
#undef A_DMAV
#undef A_DMAWAIT
#undef A_QK
#undef A_PV
#undef A_VRD
#undef A_MASK
#undef A_ROWMAX
#undef A_EXPPACK
#undef A_VALU
#undef A_MFMA
#undef A_KRD
}

#define XB_TMO      128
#define XB_XCNT(j)  (256  + 64 * (j))
#define XB_XSUB(j)  (1280 + 64 * (j))
#define XB_XGEN(j)  (2304 + 64 * (j))
#define XB_TOP      3328
#define XB_TOPGEN   3392
#define XCD_BAR_WORDS 3456
#define XB_SPIN_CAP (1u << 18)

__device__ __forceinline__ unsigned xb_ld(unsigned* p)              { return __hip_atomic_load(p, __ATOMIC_RELAXED, __HIP_MEMORY_SCOPE_AGENT); }
__device__ __forceinline__ unsigned xb_add(unsigned* p, unsigned v) { return __hip_atomic_fetch_add(p, v, __ATOMIC_RELAXED, __HIP_MEMORY_SCOPE_AGENT); }
__device__ __forceinline__ unsigned xb_xcc_id() { return (unsigned)__builtin_amdgcn_s_getreg((3 << 11) | 20) & 0xFu; }
#define XB_SPIN(cond, bar) do { unsigned _sp = 0; while (cond) { __builtin_amdgcn_s_sleep(1); \
    if ((++_sp & 255u) == 0u) { if (xb_ld(&(bar)[XB_TMO])) break; if (_sp > XB_SPIN_CAP) { atomicAdd(&(bar)[XB_TMO], 1u); break; } } } } while (0)

struct XcdBarrier {
    unsigned* bar; unsigned x;
    volatile LAS unsigned* st;
};

__device__ __forceinline__ XcdBarrier xcd_barrier_post(unsigned* bar, volatile LAS unsigned* st, const int wv_) {
    XcdBarrier b; b.bar = bar; b.x = xb_xcc_id(); b.st = st;
    if (otid(wv_) == 0) (void)xb_add(&bar[XB_XCNT(b.x)], 1u);
    return b;
}
__device__ __forceinline__ void xcd_barrier_complete(unsigned* bar, unsigned x, unsigned& nloc, unsigned& nx) {
    const unsigned G = gridDim.x * gridDim.y * gridDim.z;
    unsigned sum, cnt, mine, sp = 0u;
    for (;;) {
        sum = 0u; cnt = 0u; mine = 0u;
#pragma unroll
        for (unsigned j = 0; j < 16; ++j) { const unsigned c = xb_ld(&bar[XB_XCNT(j)]); sum += c; cnt += (c > 0u) ? 1u : 0u; mine = (j == x) ? c : mine; }
        if (sum == G) break;
        __builtin_amdgcn_s_sleep(1);
        if ((++sp & 255u) == 0u) { if (xb_ld(&bar[XB_TMO])) break; if (sp > XB_SPIN_CAP) { atomicAdd(&bar[XB_TMO], 1u); break; } }
    }
    nloc = mine > 0u ? mine : 1u; nx = cnt > 0u ? cnt : 1u;
}

__device__ __forceinline__ void xcd_barrier(const XcdBarrier& b, const int wv_) {
    asm volatile("s_waitcnt vmcnt(0)" ::: "memory");
    __syncthreads();
    if (otid(wv_) == 0) {
        unsigned* bar = b.bar;
        __builtin_amdgcn_s_waitcnt(0);
        unsigned nloc = b.st[0], nx = b.st[1];
        if (nloc == 0u) { xcd_barrier_complete(bar, b.x, nloc, nx); b.st[0] = nloc; b.st[1] = nx; }
        const unsigned old = xb_add(&bar[XB_XSUB(b.x)], 1u);
        const unsigned gen = old / nloc;
        if (old + 1u == (gen + 1u) * nloc) {
            __builtin_amdgcn_fence(__ATOMIC_RELEASE, "agent");
            asm volatile("s_waitcnt vmcnt(0)" ::: "memory");
            const unsigned og = xb_add(&bar[XB_TOP], 1u);
            const unsigned tg = og / nx;
            if (og + 1u == (tg + 1u) * nx) xb_add(&bar[XB_TOPGEN], 1u);
            else XB_SPIN(xb_ld(&bar[XB_TOPGEN]) == tg, bar);
            __builtin_amdgcn_fence(__ATOMIC_ACQUIRE, "agent");
            xb_add(&bar[XB_XGEN(b.x)], 1u);
            asm volatile("s_waitcnt vmcnt(0)" ::: "memory");
        } else {
            XB_SPIN(xb_ld(&bar[XB_XGEN(b.x)]) == gen, bar);
            __builtin_amdgcn_fence(__ATOMIC_ACQUIRE, "agent");
            asm volatile("s_waitcnt vmcnt(0)" ::: "memory");
        }
    }
    __syncthreads();
}

__device__ __forceinline__ const float* inptr(LAS unsigned char* lds, int i) {
    unsigned off = PTR_OFF + 8 * i; asm volatile("" : "+v"(off));
    const u32x2 v = *(const LAS u32x2*)(lds + off);
    const unsigned lo = __builtin_amdgcn_readfirstlane(v.x), hi = __builtin_amdgcn_readfirstlane(v.y);
    return (const float*)(((unsigned long long)hi << 32) | lo);
}
__global__ void __launch_bounds__(NTHR, 2) trunk_fwd(Params p) {
    extern __shared__ __attribute__((aligned(16))) unsigned char lds_raw[];
    LAS unsigned char* lds = (LAS unsigned char*)lds_raw;
    cg::grid_group grid = cg::this_grid();
    const int wv_ = __builtin_amdgcn_readfirstlane(threadIdx.x >> 6);
#ifdef PROBE_CAT
    const unsigned long long tp0_ = __builtin_amdgcn_s_memrealtime();
#endif
#ifndef NO_PRO
    prologue(p, lds, wv_);
#endif
#ifdef PROBE_CAT
    if (PROBE_CAT == 'P') { const unsigned long long d_ = __builtin_amdgcn_s_memrealtime() - tp0_; const unsigned long long w0_ = __builtin_amdgcn_s_memrealtime(); while (__builtin_amdgcn_s_memrealtime() - w0_ < d_) __builtin_amdgcn_s_sleep(8); }
#endif
    { const int t0 = otid(wv_); if (t0 < 22) { const unsigned long long v = (t0 < 20) ? (unsigned long long)p.in[t0 < 20 ? t0 : 0] : (t0 == 20 ? (unsigned long long)p.out : (unsigned long long)p.ws);
        ((LAS unsigned long long*)(lds + PTR_OFF))[t0] = v; }
      if (t0 < 2) ((volatile LAS unsigned*)(lds + PTR_OFF + 256))[t0] = 0u; }
    if (blockIdx.x == 0) { unsigned* bw = (unsigned*)(p.ws + WS_CTL); for (int i = otid(wv_); i < XCD_BAR_WORDS; i += NTHR) __hip_atomic_store(bw + i, 0u, __ATOMIC_RELAXED, __HIP_MEMORY_SCOPE_AGENT); }
    __syncthreads();
    grid.sync();
    const XcdBarrier bar = xcd_barrier_post((unsigned*)(p.ws + WS_CTL), (volatile LAS unsigned*)(lds + PTR_OFF + 256), wv_);
#ifdef PROBE_CAT
    unsigned long long tprev_ = __builtin_amdgcn_s_memrealtime();
#define GSYNC(C) do { if ((C) == PROBE_CAT) { const unsigned long long d_ = __builtin_amdgcn_s_memrealtime() - tprev_; const unsigned long long w0_ = __builtin_amdgcn_s_memrealtime(); \
        while (__builtin_amdgcn_s_memrealtime() - w0_ < d_) __builtin_amdgcn_s_sleep(8); } xcd_barrier(bar, wv_); tprev_ = __builtin_amdgcn_s_memrealtime(); } while (0)
#else
#define GSYNC(C) xcd_barrier(bar, wv_)
#endif
#define WSP ((unsigned char*)inptr(lds, 21))
#define XRES ((float*)inptr(lds, 20))
#pragma nounroll
    for (int l = 0; l < DEPTH; ++l) {
        const int j = l >> 1; const bool fox = (l & 1) == 0;
#ifndef NO_NORM
        { unsigned char* ws = WSP; const float* modl = (const float*)(ws + WS_MOD) + (size_t)l * 16 * 6144;
          if (fox) norm_phase<2, true>((l == 0) ? (const void*)inptr(lds, I_X) : (const void*)(ws + WS_XB), l != 0, inptr(lds, I_GMIX) + l * DM, modl + 0, modl + 1024, (bf16*)(ws + WS_H), inptr(lds, I_FWIN) + (size_t)j * DM * 3088, inptr(lds, I_FBF) + j * 16, (float*)(ws + WS_LF), lds, wv_);
          else norm_phase<8, false>((const void*)(ws + WS_XB), true, inptr(lds, I_GMIX) + l * DM, modl + 0, modl + 1024, (bf16*)(ws + WS_H), nullptr, nullptr, nullptr, lds, wv_); }
#endif
        GSYNC('N');
        if (fox) {
#ifndef NO_CUM
            { unsigned char* ws = WSP; fox_cumsum((const float*)(ws + WS_LF), (bf16*)(ws + WS_Q), (bf16*)(ws + WS_K), lds, wv_); }
#endif
#ifndef NO_G1F
            { unsigned char* ws = WSP; const bf16* WinT = (const bf16*)(ws + WS_W + W_FOX + (size_t)j * W_FOX_STRIDE);
              pg8::Gemm g{(const bf16*)(ws + WS_H), WinT, M, 3072, DM}; pg8::StaticOrder S; S.init(M, 3072, ogrid(), obid());
              pg8::EpiQkvFox E{ws, 0.125f * LOG2E};
              pg8::gemm_phase<pg8::EpiQkvFox, pg8::StaticOrder, true, true>(lds, g, S, E, wv_); }
#endif
            GSYNC('G');
#ifndef NO_ATT5
            { unsigned char* ws = WSP; attn_phase<5>(lds, (const bf16*)(ws + WS_Q), (const bf16*)(ws + WS_K), (const bf16*)(ws + WS_V), (bf16*)(ws + WS_H), wv_); }
#ifdef PROBE_ATT2
            { unsigned char* ws = WSP; attn_phase<5>(lds, (const bf16*)(ws + WS_Q), (const bf16*)(ws + WS_K), (const bf16*)(ws + WS_V), (bf16*)(ws + WS_H), wv_); }
#endif
#endif
            GSYNC('A');
        } else {
#ifndef NO_GD
            { unsigned char* ws = WSP; const bf16* WdT = (const bf16*)(ws + WS_W + W_MLA + (size_t)j * W_MLA_STRIDE);
              pg8::Gemm g{(const bf16*)(ws + WS_H), WdT, M, 512, DM}; pg8::StaticOrder S; S.init(M, 512, ogrid(), obid());
              pg8::EpiMlaDown E{ws};
              pg8::gemm_phase<pg8::EpiMlaDown, pg8::StaticOrder, true, true>(lds, g, S, E, wv_); }
#endif
            GSYNC('H');
#ifndef NO_GQ
            { unsigned char* ws = WSP; const bf16* WuqT = (const bf16*)(ws + WS_W + W_MLA + (size_t)j * W_MLA_STRIDE) + (size_t)512 * 1024;
              int Kq = 256; asm volatile("" : "+s"(Kq));
              pg8::Gemm g{(const bf16*)(ws + WS_CQ), WuqT, M, 1536, Kq}; pg8::StaticOrder S; S.init(M, 1536, ogrid(), obid());
              pg8::EpiMlaQ E{ws, 0.10206207261596575f * LOG2E};
              pg8::gemm_phase<pg8::EpiMlaQ, pg8::StaticOrder, true, true>(lds, g, S, E, wv_); }
#endif
#ifndef NO_GKV
            { unsigned char* ws = WSP; const bf16* WukvT = (const bf16*)(ws + WS_W + W_MLA + (size_t)j * W_MLA_STRIDE) + (size_t)512 * 1024 + (size_t)1536 * 256;
              int Kkv = 128; asm volatile("" : "+s"(Kkv));
              pg8::Gemm g{(const bf16*)(ws + WS_CKV), WukvT, M, 2048, Kkv}; pg8::StaticOrder S; S.init(M, 2048, ogrid(), obid());
              pg8::EpiMlaKv E{ws};
              pg8::gemm_phase<pg8::EpiMlaKv, pg8::StaticOrder, true, true>(lds, g, S, E, wv_); }
#endif
            GSYNC('Q');
#ifndef NO_ATT6
            { unsigned char* ws = WSP; attn_phase<6>(lds, (const bf16*)(ws + WS_Q), (const bf16*)(ws + WS_K), (const bf16*)(ws + WS_V), (bf16*)(ws + WS_H), wv_); }
#ifdef PROBE_ATT2
            { unsigned char* ws = WSP; attn_phase<6>(lds, (const bf16*)(ws + WS_Q), (const bf16*)(ws + WS_K), (const bf16*)(ws + WS_V), (bf16*)(ws + WS_H), wv_); }
#endif
#endif
            GSYNC('B');
        }
#ifndef NO_GO
        { unsigned char* ws = WSP; const float* modl = (const float*)(ws + WS_MOD) + (size_t)l * 16 * 6144;
          const bf16* WoutT = fox ? (const bf16*)(ws + WS_W + W_FOX + (size_t)j * W_FOX_STRIDE) + (size_t)3072 * DM : (const bf16*)(ws + WS_W + W_MLA + (size_t)j * W_MLA_STRIDE + 3 * MiB);
          pg8::Gemm g{(const bf16*)(ws + WS_H), WoutT, M, DM, DM}; pg8::StaticOrder S; S.init(M, DM, ogrid(), obid());
          pg8::EpiResid E{(l == 0) ? inptr(lds, I_X) : (const float*)nullptr, (bf16*)(ws + WS_XB), modl + 2048};
          pg8::gemm_phase<pg8::EpiResid, pg8::StaticOrder, true, true>(lds, g, S, E, wv_); }
#endif
        GSYNC('O');
#ifndef NO_NORM2
        { unsigned char* ws = WSP; const float* modl = (const float*)(ws + WS_MOD) + (size_t)l * 16 * 6144;
          norm_phase<8, false>((const void*)(ws + WS_XB), true, inptr(lds, I_GMLP) + l * DM, modl + 3072, modl + 4096, (bf16*)(ws + WS_H), nullptr, nullptr, nullptr, lds, wv_); }
#endif
        GSYNC('M');
#ifndef NO_GU
        { unsigned char* ws = WSP; const bf16* W1T = (const bf16*)(ws + WS_W + W_MLP + (size_t)l * W_MLP_STRIDE);
          pg8::Gemm g{(const bf16*)(ws + WS_H), W1T, M, FF, DM}; pg8::StaticOrder S; S.init(M, FF, ogrid(), obid());
          pg8::EpiRelu2 E{ws};
          pg8::gemm_phase<pg8::EpiRelu2, pg8::StaticOrder, true, true>(lds, g, S, E, wv_); }
#endif
        GSYNC('U');
#ifndef NO_GDN
        { unsigned char* ws = WSP; const float* modl = (const float*)(ws + WS_MOD) + (size_t)l * 16 * 6144;
          const bf16* W2T = (const bf16*)(ws + WS_W + W_MLP + (size_t)l * W_MLP_STRIDE) + (size_t)FF * DM;
          pg8::Gemm g{(const bf16*)(ws + WS_BIG), W2T, M, DM, FF}; pg8::StaticOrder S; S.init(M, DM, ogrid(), obid());
          pg8::EpiResid E{(const float*)nullptr, (bf16*)(ws + WS_XB), modl + 5120};
          pg8::gemm_phase<pg8::EpiResid, pg8::StaticOrder, true, true>(lds, g, S, E, wv_); }
#endif
        GSYNC('D');
    }
    final_norm((const bf16*)(WSP + WS_XB), XRES, inptr(lds, I_GFIN), wv_);
#ifdef PROBE_CAT
    if (PROBE_CAT == 'F') { const unsigned long long d_ = __builtin_amdgcn_s_memrealtime() - tprev_; const unsigned long long w0_ = __builtin_amdgcn_s_memrealtime(); while (__builtin_amdgcn_s_memrealtime() - w0_ < d_) __builtin_amdgcn_s_sleep(8); }
#endif
}

extern "C" void kernel_launch(void* const* d_in, const int* in_sizes, int n_in, void* d_out, int out_size, void* d_ws, size_t ws_size, hipStream_t stream) {
    static int grid = 0;
    if (grid == 0) {
        if (n_in != 20 || in_sizes[0] != M * DM || out_size != M * DM || ws_size < WS_END) { fprintf(stderr, "kernel_launch: unexpected shapes (n_in %d, in0 %d, out %d, ws %zu)\n", n_in, n_in > 0 ? in_sizes[0] : -1, out_size, ws_size); grid = -1; return; }
        int dev = 0, cus = 0, per_cu = 0;
        if (hipGetDevice(&dev) != hipSuccess || hipDeviceGetAttribute(&cus, hipDeviceAttributeMultiprocessorCount, dev) != hipSuccess) { fprintf(stderr, "kernel_launch: device query failed\n"); grid = -1; return; }
        if (hipFuncSetAttribute((const void*)trunk_fwd, hipFuncAttributeMaxDynamicSharedMemorySize, LDS_BYTES) != hipSuccess) { fprintf(stderr, "kernel_launch: hipFuncSetAttribute failed\n"); grid = -1; return; }
        if (hipOccupancyMaxActiveBlocksPerMultiprocessor(&per_cu, (const void*)trunk_fwd, NTHR, LDS_BYTES) != hipSuccess || per_cu < 1) { fprintf(stderr, "kernel_launch: occupancy query gave %d\n", per_cu); per_cu = 1; }
        (void)hipGetLastError();
        grid = cus * per_cu;
    }
    if (grid < 0) return;
    Params prm{};
    for (int i = 0; i < 20; ++i) prm.in[i] = (const float*)d_in[i];
    prm.out = (float*)d_out; prm.ws = (unsigned char*)d_ws;
    void* args[] = {&prm};
    hipError_t e = hipLaunchCooperativeKernel((const void*)trunk_fwd, dim3(grid), dim3(NTHR), args, LDS_BYTES, stream);
    if (e != hipSuccess) fprintf(stderr, "kernel_launch: cooperative launch failed: %s (grid %d)\n", hipGetErrorString(e), grid);
}
```

```cpp
#include <hip/hip_runtime.h>
#include <hip/hip_cooperative_groups.h>
#include <cstdio>
#include <cstdint>
namespace cg = cooperative_groups;
#define LAS __attribute__((address_space(3)))
typedef unsigned short bf16;
typedef short bf16x8 __attribute__((ext_vector_type(8)));
typedef short s16x4 __attribute__((ext_vector_type(4)));
typedef float f32x16 __attribute__((ext_vector_type(16)));
typedef float f32x4 __attribute__((ext_vector_type(4)));
typedef float f32x2 __attribute__((ext_vector_type(2)));
typedef unsigned u32x4 __attribute__((ext_vector_type(4)));
typedef unsigned u32x2 __attribute__((ext_vector_type(2)));

constexpr int NB = 16, SEQ = 2048, DM = 1024, NH = 16, FF = 4096, DEPTH = 4;
constexpr int M = NB * SEQ;
constexpr int NTHR = 512, NWAVE = 8;
constexpr float EPS = 1e-6f, LOG2E = 1.4426950408889634f;
constexpr size_t MiB = 1u << 20;
constexpr size_t WS_BIG = 0;
constexpr size_t WS_Q = 0, WS_K = 96 * MiB, WS_V = 192 * MiB;
constexpr size_t WS_H = 256 * MiB;
constexpr size_t WS_CQ = 320 * MiB, WS_CKV = 336 * MiB;
constexpr size_t WS_W = 344 * MiB;
constexpr size_t W_FOX = 0, W_FOX_STRIDE = 8 * MiB;
constexpr size_t W_MLA = 16 * MiB, W_MLA_STRIDE = 5 * MiB;
constexpr size_t W_MLP = 26 * MiB, W_MLP_STRIDE = 16 * MiB;
constexpr size_t WS_MOD = 436 * MiB;
constexpr size_t WS_CS = 438 * MiB;
constexpr size_t WS_LF = 442 * MiB;
constexpr size_t WS_SSQQ = 444 * MiB, WS_SSQKV = 445 * MiB;
constexpr size_t WS_CTL = 446 * MiB;
constexpr size_t WS_XB = 447 * MiB;
constexpr size_t WS_END = 511 * MiB;
static_assert(WS_W + W_MLP + 4 * W_MLP_STRIDE <= WS_MOD, "weights fit");
constexpr int LDS_BYTES = 135168;

template <int MASK> __device__ __forceinline__ float xor_sum(float v) {
    if constexpr (MASK == 32) return v + __shfl_xor(v, 32);
    else return v + __builtin_bit_cast(float, __builtin_amdgcn_ds_swizzle(__builtin_bit_cast(int, v), (MASK << 10) | 0x1F));
}
template <int MASK> __device__ __forceinline__ float xor_get(float v, bool upper) {
    if constexpr (MASK == 32) return __shfl_xor(v, 32);
    else return __builtin_bit_cast(float, __builtin_amdgcn_ds_swizzle(__builtin_bit_cast(int, v), (MASK << 10) | 0x1F));
}
__device__ __forceinline__ float wave_sum(float v) { v = xor_sum<1>(v); v = xor_sum<2>(v); v = xor_sum<4>(v); v = xor_sum<8>(v); v = xor_sum<16>(v); v = xor_sum<32>(v); return v; }
namespace pg8 {
#define PG8_LAS __attribute__((address_space(3)))
typedef unsigned short bf16_t;
typedef short bf16x8 __attribute__((ext_vector_type(8)));
typedef float f32x4 __attribute__((ext_vector_type(4)));
typedef unsigned u32x4 __attribute__((ext_vector_type(4)));
constexpr int BM = 256, BK = 64, HALF = 128, HTB = HALF * BK * 2  , STAGE_BYTES = 8 * HTB, NXCD = 8, WGM = 8;

__host__ __device__ __forceinline__ int lds_byte(int r, int c) { const int st = (r >> 4) * 2 + (c >> 5), rr = r & 15, cc = c & 31, ob = rr * 64 + cc * 2; return st * 1024 + (ob ^ (((ob >> 9) & 1) << 5)); }
__host__ __device__ __forceinline__ void stage_rc(int b, int& R, int& C) { const int st = b / 1024, sb = b % 1024, swz = sb ^ (((sb >> 9) & 1) << 5); R = (st >> 1) * 16 + swz / 64; C = (st & 1) * 32 + (swz % 64) / 2; }
__host__ __device__ __forceinline__ int perm32(int rho) { const int n = rho >> 4, i = rho & 15; return 8 * (i >> 2) + 4 * n + (i & 3); }

struct Unit { int pm, pn; };
struct Gemm { const bf16_t* A; const bf16_t* Bt; int M, N, K; };

struct StaticOrder {
    int nM, nN, nwg, G, c;
    __host__ __device__ void init(int M, int N, int G_, int c_) { nM = M / BM; nN = N / BM; nwg = nM * nN; G = G_; c = c_; }
    __host__ __device__ bool next(int i, Unit& u) const {
        const long L = (long)i * G + c; if (L >= nwg) return false;
        int wgid = (int)L; { const int q = nwg / NXCD, r = nwg % NXCD, xcd = wgid % NXCD, off = wgid / NXCD; wgid = (xcd < r ? xcd * (q + 1) : r * (q + 1) + (xcd - r) * q) + off; }
        const int nig = WGM * nN, gid = wgid / nig, fm = gid * WGM, gsz = (nM - fm) < WGM ? (nM - fm) : WGM;
        u.pm = fm + ((wgid % nig) % gsz); u.pn = (wgid % nig) / gsz; return true;
    }
    __device__ __forceinline__ void a_ready(const Unit&) const {}
    __device__ __forceinline__ void done(const Unit&) const {}
};

__device__ __forceinline__ unsigned cvt_pk_bf16(float lo, float hi) { unsigned r; asm volatile("v_cvt_pk_bf16_f32 %0, %1, %2" : "=v"(r) : "v"(lo), "v"(hi)); return r; }
typedef float f32x2 __attribute__((ext_vector_type(2)));
typedef unsigned u32x2 __attribute__((ext_vector_type(2)));
#define GAS __attribute__((address_space(1)))
typedef GAS bf16_t gbf16; typedef GAS float gf32; typedef GAS unsigned char gu8;
constexpr float RMS_EPS = 1e-6f;
__device__ __forceinline__ u32x4 pack8(const f32x4& v0, const f32x4& v1) { u32x4 w; w.x = cvt_pk_bf16(v0[0], v0[1]); w.y = cvt_pk_bf16(v0[2], v0[3]); w.z = cvt_pk_bf16(v1[0], v1[1]); w.w = cvt_pk_bf16(v1[2], v1[3]); return w; }
__device__ __forceinline__ u32x2 pack4(const f32x4& v) { u32x2 w; w.x = cvt_pk_bf16(v[0], v[1]); w.y = cvt_pk_bf16(v[2], v[3]); return w; }

struct EpiQkvFox {
    static constexpr bool PERM = true, AFTER_DRAIN = false;
    unsigned char* ws; float qscale;
    __device__ __forceinline__ void operator()(const f32x4 (&acc)[2][2][4][2], const Unit& u, int wr, int wc, int fr, int fq) const {
        gbf16* Q = (gbf16*)((gu8*)ws + WS_Q); gbf16* Kp = (gbf16*)((gu8*)ws + WS_K); gbf16* V = (gbf16*)((gu8*)ws + WS_V);
        const int row0 = u.pm * BM + wr * 64 + fr;
        const int t = u.pn >> 2;
        const int cin0 = (u.pn & 3) * BM + wc * 32 + 8 * fq;
        const float sc = (t == 0) ? qscale : 1.f;
#pragma unroll
        for (int ai = 0; ai < 2; ++ai)
#pragma unroll
            for (int m = 0; m < 4; ++m) { const unsigned row = (unsigned)(row0 + ai * HALF + m * 16);
#pragma unroll
                for (int bj = 0; bj < 2; ++bj) { const int cin = cin0 + bj * HALF;
                    gbf16* dst = (t == 2) ? (V + row * 1024 + cin) : ((t == 0 ? Q : Kp) + row * 1024 + cin);
                    *(GAS u32x4*)dst = pack8(acc[ai][bj][m][0] * sc, acc[ai][bj][m][1] * sc); } }
    }
};
struct EpiRelu2 {
    static constexpr bool PERM = true, AFTER_DRAIN = false;
    unsigned char* ws;
    __device__ __forceinline__ void operator()(const f32x4 (&acc)[2][2][4][2], const Unit& u, int wr, int wc, int fr, int fq) const {
        gbf16* H = (gbf16*)((gu8*)ws + WS_BIG);
        const int row0 = u.pm * BM + wr * 64 + fr; const int col0 = u.pn * BM + wc * 32 + 8 * fq;
#pragma unroll
        for (int ai = 0; ai < 2; ++ai)
#pragma unroll
            for (int m = 0; m < 4; ++m) { gbf16* rowp = H + (unsigned)(row0 + ai * HALF + m * 16) * 4096u + (unsigned)col0;
#pragma unroll
                for (int bj = 0; bj < 2; ++bj) { f32x4 v0 = acc[ai][bj][m][0], v1 = acc[ai][bj][m][1];
#pragma unroll
                    for (int j = 0; j < 4; ++j) { const float a = fmaxf(v0[j], 0.f), b = fmaxf(v1[j], 0.f); v0[j] = a * a; v1[j] = b * b; }
                    *(GAS u32x4*)(rowp + bj * HALF) = pack8(v0, v1); } }
    }
};
struct EpiResid {
    static constexpr bool PERM = true, AFTER_DRAIN = false;
    const float* base32_; bf16_t* xb_; const float* gate_;
    __device__ __forceinline__ void operator()(const f32x4 (&acc)[2][2][4][2], const Unit& u, int wr, int wc, int fr, int fq) const {
        const gf32* base32 = (const gf32*)base32_; gbf16* xb = (gbf16*)xb_; const gf32* gate = (const gf32*)gate_;
        const int row0 = u.pm * BM + wr * 64 + fr; const int col0 = u.pn * BM + wc * 32 + 8 * fq;
        const gf32* gp = gate + (size_t)(u.pm >> 3) * 6144 + col0;
        f32x4 gv[2][2];
#pragma unroll
        for (int bj = 0; bj < 2; ++bj)
#pragma unroll
            for (int n = 0; n < 2; ++n) gv[bj][n] = *(const GAS f32x4*)(gp + bj * HALF + n * 4);
#pragma unroll
        for (int ai = 0; ai < 2; ++ai)
#pragma unroll
            for (int m = 0; m < 4; ++m) { const unsigned off = (unsigned)(row0 + ai * HALF + m * 16) * 1024u + (unsigned)col0;
#pragma unroll
                for (int bj = 0; bj < 2; ++bj) { f32x4 b0, b1;
                    if (base32_) { b0 = *(const GAS f32x4*)(base32 + off + bj * HALF); b1 = *(const GAS f32x4*)(base32 + off + bj * HALF + 4); }
                    else { const u32x4 w = *(const GAS u32x4*)(xb + off + bj * HALF);
                        b0 = (f32x4){__builtin_bit_cast(float, w.x << 16), __builtin_bit_cast(float, w.x & 0xffff0000u), __builtin_bit_cast(float, w.y << 16), __builtin_bit_cast(float, w.y & 0xffff0000u)};
                        b1 = (f32x4){__builtin_bit_cast(float, w.z << 16), __builtin_bit_cast(float, w.z & 0xffff0000u), __builtin_bit_cast(float, w.w << 16), __builtin_bit_cast(float, w.w & 0xffff0000u)}; }
                    *(GAS u32x4*)(xb + off + bj * HALF) = pack8(b0 + gv[bj][0] * acc[ai][bj][m][0], b1 + gv[bj][1] * acc[ai][bj][m][1]); } }
    }
};
struct EpiMlaKv {
    static constexpr bool PERM = true, AFTER_DRAIN = false;
    unsigned char* ws;
    __device__ __forceinline__ void operator()(const f32x4 (&acc)[2][2][4][2], const Unit& u, int wr, int wc, int fr, int fq) const {
        const gf32* ssq = (const gf32*)((gu8*)ws + WS_SSQKV); gbf16* Kp = (gbf16*)((gu8*)ws + WS_K); gbf16* V = (gbf16*)((gu8*)ws + WS_V);
        const int row0 = u.pm * BM + wr * 64 + fr;
        const int t = u.pn >> 2; const int cin0 = (u.pn & 3) * BM + wc * 32 + 8 * fq;
#pragma unroll
        for (int ai = 0; ai < 2; ++ai)
#pragma unroll
            for (int m = 0; m < 4; ++m) { const unsigned row = (unsigned)(row0 + ai * HALF + m * 16);
                const f32x4 s4 = *(const GAS f32x4*)(ssq + row * 4);
                const float rs = __builtin_amdgcn_rsqf(((s4[0] + s4[1]) + (s4[2] + s4[3])) * (1.0f / 128.0f) + RMS_EPS);
#pragma unroll
                for (int bj = 0; bj < 2; ++bj) { const int cin = cin0 + bj * HALF;
                    gbf16* dst = t ? (V + row * 1024 + cin) : (Kp + row * 1536 + (cin >> 6) * 96 + (cin & 63));
                    *(GAS u32x4*)dst = pack8(acc[ai][bj][m][0] * rs, acc[ai][bj][m][1] * rs); }
                asm volatile("" ::: "memory"); }
    }
};
struct EpiMlaQ {
    static constexpr bool PERM = false, AFTER_DRAIN = false;
    unsigned char* ws; float qscale;
    __device__ __forceinline__ void operator()(const f32x4 (&acc)[2][2][4][2], const Unit& u, int wr, int wc, int fr, int fq) const {
        const gf32* ssq = (const gf32*)((gu8*)ws + WS_SSQQ); const gf32* cst = (const gf32*)((gu8*)ws + WS_CS); gbf16* Q = (gbf16*)((gu8*)ws + WS_Q);
        const int row0 = u.pm * BM + wr * 64 + fr;
#pragma unroll
        for (int ai = 0; ai < 2; ++ai)
#pragma unroll
            for (int m = 0; m < 4; ++m) { const unsigned row = (unsigned)(row0 + ai * HALF + m * 16);
                const f32x4 s4 = *(const GAS f32x4*)(ssq + row * 4);
                const float rs = qscale * __builtin_amdgcn_rsqf(((s4[0] + s4[1]) + (s4[2] + s4[3])) * (1.0f / 256.0f) + RMS_EPS);
                if (u.pn < 4) {
#pragma unroll
                    for (int bj = 0; bj < 2; ++bj)
#pragma unroll
                        for (int n = 0; n < 2; ++n) { const int cin = u.pn * BM + bj * HALF + wc * 32 + n * 16 + 4 * fq;
                            *(GAS u32x2*)(Q + row * 1536 + (cin >> 6) * 96 + (cin & 63)) = pack4(acc[ai][bj][m][n] * rs); }
                } else {
                    const f32x4 cs = *(const GAS f32x4*)(cst + row * 32 + 4 * fq), sn = *(const GAS f32x4*)(cst + row * 32 + 16 + 4 * fq);
#pragma unroll
                    for (int bj = 0; bj < 2; ++bj) { const int head = ((u.pn - 4) * BM + bj * HALF + wc * 32) >> 5;
                        const f32x4 x1 = acc[ai][bj][m][0] * rs, x2 = acc[ai][bj][m][1] * rs;
                        gbf16* dst = Q + row * 1536 + head * 96 + 64 + 4 * fq;
                        *(GAS u32x2*)dst = pack4(x1 * cs - x2 * sn); *(GAS u32x2*)(dst + 16) = pack4(x2 * cs + x1 * sn); }
                }
                asm volatile("" ::: "memory");
            }
    }
};
struct EpiMlaDown {
    static constexpr bool PERM = false, AFTER_DRAIN = false;
    unsigned char* ws;
    __device__ __forceinline__ void operator()(const f32x4 (&acc)[2][2][4][2], const Unit& u, int wr, int wc, int fr, int fq) const {
        gbf16* cq = (gbf16*)((gu8*)ws + WS_CQ); gbf16* ckv = (gbf16*)((gu8*)ws + WS_CKV); gf32* ssqq = (gf32*)((gu8*)ws + WS_SSQQ); gf32* ssqkv = (gf32*)((gu8*)ws + WS_SSQKV); const gf32* cst = (const gf32*)((gu8*)ws + WS_CS); gbf16* Kp = (gbf16*)((gu8*)ws + WS_K);
        const int row0 = u.pm * BM + wr * 64 + fr;
#pragma unroll
        for (int ai = 0; ai < 2; ++ai)
#pragma unroll
            for (int m = 0; m < 4; ++m) { const unsigned row = (unsigned)(row0 + ai * HALF + m * 16);
                if (u.pn == 0) {
                    float ss = 0.f;
#pragma unroll
                    for (int bj = 0; bj < 2; ++bj)
#pragma unroll
                        for (int n = 0; n < 2; ++n) { const f32x4 v = acc[ai][bj][m][n]; ss += (v[0] * v[0] + v[1] * v[1]) + (v[2] * v[2] + v[3] * v[3]);
                            *(GAS u32x2*)(cq + row * 256 + bj * HALF + wc * 32 + n * 16 + 4 * fq) = pack4(v); }
                    ss = xor_sum<16>(ss); ss = xor_sum<32>(ss);
                    if (fq == 0) ssqq[row * 4 + wc] = ss;
                } else {
                    float ss = 0.f;
#pragma unroll
                    for (int n = 0; n < 2; ++n) { const f32x4 v = acc[ai][0][m][n]; ss += (v[0] * v[0] + v[1] * v[1]) + (v[2] * v[2] + v[3] * v[3]);
                        *(GAS u32x2*)(ckv + row * 128 + wc * 32 + n * 16 + 4 * fq) = pack4(v); }
                    ss = xor_sum<16>(ss); ss = xor_sum<32>(ss);
                    if (fq == 0) ssqkv[row * 4 + wc] = ss;
                    if (wc == 0) {
                        const f32x4 cs = *(const GAS f32x4*)(cst + row * 32 + 4 * fq), sn = *(const GAS f32x4*)(cst + row * 32 + 16 + 4 * fq);
                        const f32x4 x1 = acc[ai][1][m][0], x2 = acc[ai][1][m][1];
                        const u32x2 o1 = pack4(x1 * cs - x2 * sn), o2 = pack4(x2 * cs + x1 * sn);
                        gbf16* dst = Kp + row * 1536 + 64 + 4 * fq;
#pragma unroll
                        for (int hd = 0; hd < 16; ++hd) { *(GAS u32x2*)(dst + hd * 96) = o1; *(GAS u32x2*)(dst + hd * 96 + 16) = o2; }
                    }
                }
            }
    }
};

template <class Epi, class Sched, bool ALIGN_EPI = false, bool SP2 = false>
__device__ __forceinline__ void gemm_phase(PG8_LAS unsigned char* lds, const Gemm g, const Sched& S, const Epi& E, const int wv_) {
    int tid_; asm volatile("v_mbcnt_lo_u32_b32 %0, -1, 0\n\tv_mbcnt_hi_u32_b32 %0, -1, %0" : "=v"(tid_)); tid_ += wv_ * 64;
    const int tid = tid_, wid = __builtin_amdgcn_readfirstlane(tid >> 6), lane = tid & 63, wr = wid >> 2, wc = wid & 3, fr = lane & 15, fq = lane >> 4;
    const int K = g.K, nt = K / BK;
    unsigned voffA[2], voffB[2];
#pragma unroll
    for (int i = 0; i < 2; ++i) { int R, C; stage_rc(tid * 16 + i * 8192, R, C); const int Rb = Epi::PERM ? ((R & ~31) + perm32(R & 31)) : R;
        voffA[i] = (unsigned)(R * K + C) * 2u; voffB[i] = (unsigned)(Rb * K + C) * 2u; }
    const size_t kstep = (size_t)(BK * 2);
    const size_t hstep = (size_t)HALF * K * 2;
    const size_t tstep = 2 * hstep;
    const unsigned ldsw = (unsigned)wid * 1024u;
    const int aoff = lds_byte(wr * 64 + fr, fq * 8), boff = lds_byte(wc * 32 + fr, fq * 8);
#define PG8_SA(b, h) (((b) * 2 + (h)) * HTB)
#define PG8_SB(b, h) ((4 + (b) * 2 + (h)) * HTB)
#define PG8_STAGE(bufoff, gbase, voff) do { _Pragma("unroll") for (int _i = 0; _i < 2; ++_i) \
        __builtin_amdgcn_global_load_lds((const unsigned*)((const char*)(gbase) + (voff)[_i]), (PG8_LAS unsigned*)(lds + (bufoff) + ldsw + _i * 8192), 16, 0, 0); } while (0)
#define PG8_LDA(dst, b, h) do { _Pragma("unroll") for (int m = 0; m < 4; ++m) _Pragma("unroll") for (int k = 0; k < 2; ++k) dst[m][k] = *(const PG8_LAS bf16x8*)(lds + PG8_SA(b, h) + aoff + m * 2048 + k * 1024); } while (0)
#define PG8_LDB(dst, b, h) do { _Pragma("unroll") for (int n = 0; n < 2; ++n) _Pragma("unroll") for (int k = 0; k < 2; ++k) dst[n][k] = *(const PG8_LAS bf16x8*)(lds + PG8_SB(b, h) + boff + n * 2048 + k * 1024); } while (0)
#define PG8_MMA(ai, bj, At, Bt) do { __builtin_amdgcn_s_setprio(1); _Pragma("unroll") for (int m = 0; m < 4; ++m) _Pragma("unroll") for (int n = 0; n < 2; ++n) _Pragma("unroll") for (int k = 0; k < 2; ++k) \
        acc[ai][bj][m][n] = __builtin_amdgcn_mfma_f32_16x16x32_bf16(Bt[n][k], At[m][k], acc[ai][bj][m][n], 0, 0, 0); __builtin_amdgcn_s_setprio(0); } while (0)
#define PG8_WAIT_V(n) asm volatile("s_waitcnt vmcnt(" #n ")" ::: "memory")
#define PG8_WAIT_L(n) asm volatile("s_waitcnt lgkmcnt(" #n ")" ::: "memory")
#define PG8_BAR __builtin_amdgcn_s_barrier()
#define PG8_SCHED __builtin_amdgcn_sched_barrier(0)
    Unit cur, nxt; int ui = 0;
    if (!S.next(0, cur)) return;
    f32x4 acc[2][2][4][2];
#pragma unroll
    for (int a = 0; a < 2; ++a)
#pragma unroll
        for (int b = 0; b < 2; ++b)
#pragma unroll
            for (int m = 0; m < 4; ++m)
#pragma unroll
                for (int n = 0; n < 2; ++n) acc[a][b][m][n] = (f32x4){0.f, 0.f, 0.f, 0.f};
    bf16x8 At[4][2], B0[2][2], B1[2][2];
    const char* cA = (const char*)g.A + (size_t)cur.pm * tstep; const char* cB = (const char*)g.Bt + (size_t)cur.pn * tstep;
    S.a_ready(cur);
    if constexpr (SP2) {
        PG8_STAGE(PG8_SB(0, 0), cB, voffB); PG8_STAGE(PG8_SB(0, 1), cB + hstep, voffB); PG8_STAGE(PG8_SA(0, 0), cA, voffA); PG8_STAGE(PG8_SA(0, 1), cA + hstep, voffA);
        if (wr == 1) PG8_BAR;
        PG8_WAIT_V(2); PG8_BAR;
        PG8_STAGE(PG8_SB(1, 0), cB + kstep, voffB); PG8_STAGE(PG8_SA(1, 0), cA + kstep, voffA); PG8_STAGE(PG8_SB(1, 1), cB + hstep + kstep, voffB);
        PG8_WAIT_V(6); PG8_BAR;
    } else {
        PG8_STAGE(PG8_SB(0, 0), cB, voffB); PG8_STAGE(PG8_SA(0, 0), cA, voffA); PG8_STAGE(PG8_SB(0, 1), cB + hstep, voffB); PG8_STAGE(PG8_SA(0, 1), cA + hstep, voffA);
        if (wr == 1) PG8_BAR;
        PG8_WAIT_V(4); PG8_BAR;
        PG8_STAGE(PG8_SB(1, 0), cB + kstep, voffB); PG8_STAGE(PG8_SA(1, 0), cA + kstep, voffA); PG8_STAGE(PG8_SB(1, 1), cB + hstep + kstep, voffB);
        PG8_WAIT_V(6); PG8_BAR;
    }
    for (;;) {
        const bool has_next = S.next(ui + 1, nxt);
        const char* nA = has_next ? (const char*)g.A + (size_t)nxt.pm * tstep : cA; const char* nB = has_next ? (const char*)g.Bt + (size_t)nxt.pn * tstep : cB;
        for (int t = 0; t < nt; t += 2) {
            const bool last = (t == nt - 2);
            const char* a1 = cA + (size_t)(t + 1) * kstep;
            const char* a2 = last ? nA : cA + (size_t)(t + 2) * kstep; const char* b2 = last ? nB : cB + (size_t)(t + 2) * kstep;
            const char* a3 = a2 + kstep; const char* b3 = b2 + kstep;
            if (last && has_next) S.a_ready(nxt);
            if constexpr (SP2) {
            PG8_LDB(B0, 0, 0); PG8_LDB(B1, 0, 1); PG8_SCHED; PG8_LDA(At, 0, 0); PG8_STAGE(PG8_SA(1, 1), a1 + hstep, voffA);
            PG8_WAIT_V(8); PG8_WAIT_L(0); PG8_BAR; PG8_MMA(0, 0, At, B0); PG8_MMA(0, 1, At, B1); PG8_BAR; PG8_SCHED;
            PG8_LDA(At, 0, 1); PG8_STAGE(PG8_SB(0, 0), b2, voffB); PG8_STAGE(PG8_SB(0, 1), b2 + hstep, voffB); PG8_STAGE(PG8_SA(0, 0), a2, voffA);
            PG8_WAIT_V(8); PG8_WAIT_L(0); PG8_BAR; PG8_MMA(1, 0, At, B0); PG8_MMA(1, 1, At, B1); PG8_BAR; PG8_SCHED;
            PG8_LDB(B0, 1, 0); PG8_LDB(B1, 1, 1); PG8_SCHED; PG8_LDA(At, 1, 0); PG8_STAGE(PG8_SA(0, 1), a2 + hstep, voffA);
            PG8_WAIT_V(8); PG8_WAIT_L(0); PG8_BAR; PG8_MMA(0, 0, At, B0); PG8_MMA(0, 1, At, B1); PG8_BAR; PG8_SCHED;
            PG8_LDA(At, 1, 1); PG8_STAGE(PG8_SB(1, 0), b3, voffB); PG8_STAGE(PG8_SB(1, 1), b3 + hstep, voffB); PG8_STAGE(PG8_SA(1, 0), a3, voffA);
            PG8_WAIT_V(8); PG8_WAIT_L(0); PG8_BAR; PG8_MMA(1, 0, At, B0); PG8_MMA(1, 1, At, B1); PG8_BAR; PG8_SCHED;
            } else {
            PG8_LDB(B0, 0, 0); PG8_SCHED; PG8_LDA(At, 0, 0); PG8_STAGE(PG8_SA(1, 1), a1 + hstep, voffA);
            PG8_WAIT_L(8); PG8_BAR; PG8_WAIT_L(0); PG8_MMA(0, 0, At, B0); PG8_BAR; PG8_SCHED;
            PG8_LDB(B1, 0, 1); PG8_STAGE(PG8_SB(0, 0), b2, voffB);
            PG8_BAR; PG8_WAIT_L(0); PG8_MMA(0, 1, At, B1); PG8_BAR;
            PG8_LDA(At, 0, 1); PG8_STAGE(PG8_SA(0, 0), a2, voffA);
            PG8_BAR; PG8_WAIT_L(0); PG8_MMA(1, 0, At, B0); PG8_BAR; PG8_SCHED;
            PG8_STAGE(PG8_SB(0, 1), b2 + hstep, voffB);
            PG8_WAIT_V(6); PG8_BAR; PG8_MMA(1, 1, At, B1); PG8_BAR;
            PG8_LDB(B0, 1, 0); PG8_SCHED; PG8_LDA(At, 1, 0); PG8_STAGE(PG8_SA(0, 1), a2 + hstep, voffA);
            PG8_WAIT_L(8); PG8_BAR; PG8_WAIT_L(0); PG8_MMA(0, 0, At, B0); PG8_BAR; PG8_SCHED;
            PG8_LDB(B1, 1, 1); PG8_STAGE(PG8_SB(1, 0), b3, voffB);
            PG8_BAR; PG8_WAIT_L(0); PG8_MMA(0, 1, At, B1); PG8_BAR;
            PG8_LDA(At, 1, 1); PG8_STAGE(PG8_SA(1, 0), a3, voffA);
            PG8_BAR; PG8_WAIT_L(0); PG8_MMA(1, 0, At, B0); PG8_BAR; PG8_SCHED;
            PG8_STAGE(PG8_SB(1, 1), b3 + hstep, voffB);
            PG8_WAIT_V(6); PG8_BAR; PG8_MMA(1, 1, At, B1); PG8_BAR;
            }
        }
        if constexpr (ALIGN_EPI) { if (wr == 0) PG8_BAR; }
        if constexpr (!Epi::AFTER_DRAIN) { E(acc, cur, wr, wc, fr, fq); S.done(cur); }
        if (!has_next) break;
#pragma unroll
        for (int a = 0; a < 2; ++a)
#pragma unroll
            for (int b = 0; b < 2; ++b)
#pragma unroll
                for (int m = 0; m < 4; ++m)
#pragma unroll
                    for (int n = 0; n < 2; ++n) acc[a][b][m][n] = (f32x4){0.f, 0.f, 0.f, 0.f};
        cur = nxt; cA = nA; cB = nB; ++ui;
        if constexpr (ALIGN_EPI) { if (wr == 1) PG8_BAR; }
    }
    PG8_WAIT_V(0);
    if constexpr (!ALIGN_EPI) { if (wr == 0) PG8_BAR; }
    PG8_BAR;
    if constexpr (Epi::AFTER_DRAIN) { E.fused(acc, cur, wr, wc, fr, fq, lds, wid, lane); S.done(cur); }
#undef PG8_SA
#undef PG8_SB
#undef PG8_STAGE
#undef PG8_LDA
#undef PG8_LDB
#undef PG8_MMA
#undef PG8_WAIT_V
#undef PG8_WAIT_L
#undef PG8_BAR
#undef PG8_SCHED
}
}

__device__ __forceinline__ int olane() { int l; asm volatile("v_mbcnt_lo_u32_b32 %0, -1, 0\n\tv_mbcnt_hi_u32_b32 %0, -1, %0" : "=v"(l)); return l; }
__device__ __forceinline__ int otid(int wv) { return wv * 64 + olane(); }
__device__ __forceinline__ int obid() { int b = blockIdx.x; asm volatile("" : "+s"(b)); return b; }
__device__ __forceinline__ int ogrid() { int g = gridDim.x; asm volatile("" : "+s"(g)); return g; }
__device__ __forceinline__ unsigned f2bf(float f) { unsigned u = __builtin_bit_cast(unsigned, f); return (u + 0x7fffu + ((u >> 16) & 1u)) >> 16; }
__device__ __forceinline__ unsigned pk2(float lo, float hi) { return f2bf(lo) | (f2bf(hi) << 16); }
__device__ __forceinline__ float bf2f(unsigned b) { return __builtin_bit_cast(float, b << 16); }

__device__ __forceinline__ void transpose_item(const float* W, int ld, int K, int N, bf16* WT, int map, int drow0, const float* gk, LAS float* scr, int item, int lane) {
    const int nblk = N / 32, kb = item / nblk, nb = item % nblk, k0 = 64 * kb, n0 = 32 * nb;
    int drow;
    if (map == 1) { const int hd = n0 / 96, d = n0 % 96; drow = (d < 64) ? hd * 64 + d : 1024 + hd * 32 + (d - 64); }
    else if (map == 2) { const int hd = n0 / 128, d = n0 % 128; drow = (d < 64) ? hd * 64 + d : 1024 + hd * 64 + (d - 64); }
    else drow = drow0 + n0;
    { const int kr = lane >> 3, c4 = lane & 7; f32x4 t[8];
#pragma unroll
      for (int i = 0; i < 8; ++i) t[i] = *(const f32x4*)(W + (size_t)(k0 + 8 * i + kr) * ld + n0 + 4 * c4);
#pragma unroll
      for (int i = 0; i < 8; ++i) { const int kk = 8 * i + kr; f32x4 v = t[i]; if (gk) v = v * gk[k0 + kk];
          LAS float* d = scr + kk * 33 + 4 * c4; d[0] = v[0]; d[1] = v[1]; d[2] = v[2]; d[3] = v[3]; } }
    asm volatile("s_waitcnt lgkmcnt(0)" ::: "memory");
    const int c = lane & 7;
#pragma unroll
    for (int j = 0; j < 4; ++j) { const int n = (lane >> 3) + 8 * j; const LAS float* s = scr + (8 * c) * 33 + n;
        u32x4 o; o.x = pk2(s[0 * 33], s[1 * 33]); o.y = pk2(s[2 * 33], s[3 * 33]); o.z = pk2(s[4 * 33], s[5 * 33]); o.w = pk2(s[6 * 33], s[7 * 33]);
        *(u32x4*)(WT + (size_t)(drow + n) * K + k0 + 8 * c) = o; }
    asm volatile("s_waitcnt lgkmcnt(0)" ::: "memory");
}

struct Params { const float* in[20]; float* out; unsigned char* ws; };
enum { I_X = 0, I_C, I_POS, I_ADAW, I_ADAB, I_GMIX, I_GMLP, I_FWIN, I_FBF, I_FWOUT, I_MDQ, I_MQG, I_MUQ, I_MDKV, I_MKVG, I_MUKV, I_MOUT, I_W1, I_W2, I_GFIN };

__device__ __forceinline__ void prologue(const Params& p, LAS unsigned char* lds, const int wv_) {
    const int BID = obid(), GSZ = ogrid(); const int tid_ = otid(wv_);
    const int tid = tid_, lane = tid & 63, wave = __builtin_amdgcn_readfirstlane(tid >> 6);
    unsigned char* ws = p.ws;
    {
        LAS float* cact = (LAS float*)lds;
        LAS float* part = (LAS float*)(lds + 65536);
        const float* c = p.in[I_C];
        for (int idx = tid; idx < NB * DM; idx += NTHR) { const int b = idx >> 10, k = idx & 1023; const float v = c[idx]; cact[k * 16 + b] = v / (1.0f + __expf(-v)); }
        __syncthreads();
        float* mod = (float*)(ws + WS_MOD);
        for (int item = BID; item < 256; item += GSZ) {
            const int l = item >> 6, n0 = (item & 63) * 96, cg = tid % 24, ks = tid / 24; const bool act = tid < 384;
            f32x4 acc[16];
#pragma unroll
            for (int b = 0; b < 16; ++b) acc[b] = (f32x4){0.f, 0.f, 0.f, 0.f};
            if (act) {
                const float* wp = p.in[I_ADAW] + ((size_t)l * DM + ks * 64) * 6144 + n0 + 4 * cg;
                const LAS f32x4* cp = (const LAS f32x4*)(cact + ks * 64 * 16);
#pragma unroll 4
                for (int k = 0; k < 64; ++k) { const f32x4 w = *(const f32x4*)(wp + (size_t)k * 6144);
                    const f32x4 c0 = cp[k * 4 + 0], c1 = cp[k * 4 + 1], c2 = cp[k * 4 + 2], c3 = cp[k * 4 + 3];
                    acc[0] += w * c0[0]; acc[1] += w * c0[1]; acc[2] += w * c0[2]; acc[3] += w * c0[3];
                    acc[4] += w * c1[0]; acc[5] += w * c1[1]; acc[6] += w * c1[2]; acc[7] += w * c1[3];
                    acc[8] += w * c2[0]; acc[9] += w * c2[1]; acc[10] += w * c2[2]; acc[11] += w * c2[3];
                    acc[12] += w * c3[0]; acc[13] += w * c3[1]; acc[14] += w * c3[2]; acc[15] += w * c3[3]; }
            }
#pragma unroll
            for (int half = 0; half < 2; ++half) {
                if (act) {
#pragma unroll
                    for (int b8 = 0; b8 < 8; ++b8) *(LAS f32x4*)(part + (ks * 8 + b8) * 96 + 4 * cg) = acc[half * 8 + b8]; }
                __syncthreads();
                for (int o = tid; o < 8 * 96; o += NTHR) { const int b8 = o / 96, cc = o % 96; float s = 0.f;
#pragma unroll
                    for (int k2 = 0; k2 < 16; ++k2) s += part[(k2 * 8 + b8) * 96 + cc];
                    mod[((size_t)l * 16 + half * 8 + b8) * 6144 + n0 + cc] = s + p.in[I_ADAB][(size_t)l * 6144 + n0 + cc]; }
                __syncthreads();
            }
        }
    }
    __syncthreads();
    {
        const int* pos = (const int*)p.in[I_POS]; float* cst = (float*)(ws + WS_CS);
        for (size_t idx = (size_t)BID * NTHR + tid; idx < (size_t)M * 16; idx += (size_t)GSZ * NTHR) {
            const int tok = (int)(idx >> 4), i = (int)(idx & 15);
            const float invf = exp2f(-(float)i * (13.287712379549449f / 16.0f));
            const float ang = (float)pos[tok] * invf;
            double rev = (double)ang * 0.15915494309189535; rev -= __builtin_rint(rev);
            const float rf = (float)rev;
            cst[(size_t)tok * 32 + i] = __builtin_amdgcn_cosf(rf); cst[(size_t)tok * 32 + 16 + i] = __builtin_amdgcn_sinf(rf);
        }
    }
    for (int j = 0; j < 2; ++j) { u32x4* z = (u32x4*)(ws + WS_W + W_MLA + j * W_MLA_STRIDE + (size_t)416 * 1024 * 2);
        for (int idx = BID * NTHR + tid; idx < 96 * 1024 * 2 / 16; idx += GSZ * NTHR) z[idx] = (u32x4){0u, 0u, 0u, 0u}; }
    {
        LAS float* scr = (LAS float*)(lds + wave * 16384);
        const int gw = BID * NWAVE + wave, NGW = GSZ * NWAVE;
        constexpr int N_MLP = 4 * 4096, N_FOX = 2 * 2048, N_MLA = 2 * 1040;
        for (int it = gw; it < N_MLP + N_FOX + N_MLA; it += NGW) {
            int r = it;
            if (r < N_MLP) { const int l = r >> 12, rr = r & 4095; bf16* wb = (bf16*)(ws + WS_W + W_MLP + (size_t)l * W_MLP_STRIDE);
                if (rr < 2048) transpose_item(p.in[I_W1] + (size_t)l * DM * FF, FF, DM, FF, wb, 0, 0, nullptr, scr, rr, lane);
                else transpose_item(p.in[I_W2] + (size_t)l * DM * FF, DM, FF, DM, wb + (size_t)FF * DM, 0, 0, nullptr, scr, rr - 2048, lane);
                continue; }
            r -= N_MLP;
            if (r < N_FOX) { const int j = r >> 11, rr = r & 2047; bf16* wb = (bf16*)(ws + WS_W + W_FOX + (size_t)j * W_FOX_STRIDE);
                if (rr < 1536) transpose_item(p.in[I_FWIN] + (size_t)j * DM * 3088, 3088, DM, 3072, wb, 0, 0, nullptr, scr, rr, lane);
                else transpose_item(p.in[I_FWOUT] + (size_t)j * DM * DM, DM, DM, DM, wb + (size_t)3072 * DM, 0, 0, nullptr, scr, rr - 1536, lane);
                continue; }
            r -= N_FOX;
            { const int j = r / 1040, rr = r % 1040; bf16* wb = (bf16*)(ws + WS_W + W_MLA + (size_t)j * W_MLA_STRIDE);
                if (rr < 128) transpose_item(p.in[I_MDQ] + (size_t)j * DM * 256, 256, DM, 256, wb, 0, 0, nullptr, scr, rr, lane);
                else if (rr < 208) transpose_item(p.in[I_MDKV] + (size_t)j * DM * 160, 160, DM, 160, wb, 0, 256, nullptr, scr, rr - 128, lane);
                else if (rr < 400) transpose_item(p.in[I_MUQ] + (size_t)j * 256 * 1536, 1536, 256, 1536, wb + (size_t)512 * 1024, 1, 0, p.in[I_MQG] + j * 256, scr, rr - 208, lane);
                else if (rr < 528) transpose_item(p.in[I_MUKV] + (size_t)j * 128 * 2048, 2048, 128, 2048, wb + (size_t)512 * 1024 + (size_t)1536 * 256, 2, 0, p.in[I_MKVG] + j * 128, scr, rr - 400, lane);
                else transpose_item(p.in[I_MOUT] + (size_t)j * DM * DM, DM, DM, DM, (bf16*)((unsigned char*)wb + 3 * MiB), 0, 0, nullptr, scr, rr - 528, lane);
            }
        }
    }
}

template <int NR, bool gates>
__device__ __forceinline__ void norm_phase(const void* xv, const bool xbf, const float* g, const float* sh0, const float* sc0, bf16* hout, const float* wfsrc, const float* bfv, float* lf, LAS unsigned char* lds, const int wv_) {
    const int BID = obid(), GSZ = ogrid(); const int tid_ = otid(wv_);
    const int tid = tid_, lane = tid & 63, wave = __builtin_amdgcn_readfirstlane(tid >> 6);
    LAS float* wfs = (LAS float*)lds;
    if constexpr (gates) {
        for (int idx = tid; idx < 16 * 1024; idx += NTHR) { const int k = idx >> 4, j = idx & 15; wfs[j * 1024 + k] = wfsrc[(size_t)k * 3088 + 3072 + j]; }
        __syncthreads();
    }
    const int gw = BID * NWAVE + wave, NGW = GSZ * NWAVE;
    for (int row0 = gw * NR; row0 < M; row0 += NGW * NR) {
        const int b = row0 >> 11;
        f32x4 v[NR][4]; float ss[NR];
        if (xbf) {
#pragma unroll
            for (int r = 0; r < NR; ++r) { const u32x2* xr = (const u32x2*)((const bf16*)xv + (size_t)(row0 + r) * DM) + lane;
#pragma unroll
                for (int j = 0; j < 4; ++j) { const u32x2 w = xr[64 * j];
                    v[r][j] = (f32x4){__builtin_bit_cast(float, w.x << 16), __builtin_bit_cast(float, w.x & 0xffff0000u), __builtin_bit_cast(float, w.y << 16), __builtin_bit_cast(float, w.y & 0xffff0000u)}; } }
        } else {
#pragma unroll
            for (int r = 0; r < NR; ++r) { const f32x4* xr = (const f32x4*)((const float*)xv + (size_t)(row0 + r) * DM) + lane;
#pragma unroll
                for (int j = 0; j < 4; ++j) v[r][j] = xr[64 * j]; }
        }
#pragma unroll
        for (int r = 0; r < NR; ++r) { float s = 0.f;
#pragma unroll
            for (int j = 0; j < 4; ++j) s += (v[r][j][0] * v[r][j][0] + v[r][j][1] * v[r][j][1]) + (v[r][j][2] * v[r][j][2] + v[r][j][3] * v[r][j][3]);
            ss[r] = s; }
#pragma unroll
        for (int r = 0; r < NR; ++r) ss[r] = wave_sum(ss[r]);
        const f32x4* gp = (const f32x4*)g + lane; const f32x4* shp = (const f32x4*)(sh0 + (size_t)b * 6144) + lane; const f32x4* scp = (const f32x4*)(sc0 + (size_t)b * 6144) + lane;
#pragma unroll
        for (int j = 0; j < 4; ++j) { const f32x4 aa = gp[64 * j] * (scp[64 * j] + 1.0f), sh = shp[64 * j];
#pragma unroll
            for (int r = 0; r < NR; ++r) { const float rstd = __builtin_amdgcn_rsqf(ss[r] * (1.0f / DM) + EPS);
                v[r][j] = (v[r][j] * rstd) * aa + sh;
                u32x2 w; w.x = pk2(v[r][j][0], v[r][j][1]); w.y = pk2(v[r][j][2], v[r][j][3]); ((u32x2*)(hout + (size_t)(row0 + r) * DM) + lane)[64 * j] = w; } }
        if constexpr (gates) {
            static_assert(NR == 2, "the gate path pairs two rows in f32x2");
            f32x2 vv[4][4], z[16];
#pragma unroll
            for (int jj = 0; jj < 4; ++jj)
#pragma unroll
                for (int e = 0; e < 4; ++e) vv[jj][e] = (f32x2){v[0][jj][e], v[1][jj][e]};
#pragma unroll
            for (int jg = 0; jg < 16; ++jg) {
                f32x2 acc = (f32x2){0.f, 0.f};
#pragma unroll
                for (int jj = 0; jj < 4; ++jj) { const f32x4 w = *(const LAS f32x4*)(wfs + jg * 1024 + 256 * jj + 4 * lane);
                    acc += (vv[jj][0] * w[0] + vv[jj][1] * w[1]) + (vv[jj][2] * w[2] + vv[jj][3] * w[3]); }
                z[jg] = acc;
                if (jg & 1) asm volatile("" ::: "memory"); }
            const bool b5 = (lane & 32) != 0, b4 = (lane & 16) != 0, b3 = (lane & 8) != 0, b2 = (lane & 4) != 0;
            f32x2 a8[8], a4[4], a2[2], a1;
#pragma unroll
            for (int i = 0; i < 8; ++i) { const f32x2 send = b5 ? z[i] : z[i + 8], keep = b5 ? z[i + 8] : z[i]; a8[i] = keep + (f32x2){xor_get<32>(send[0], b5), xor_get<32>(send[1], b5)}; }
#pragma unroll
            for (int i = 0; i < 4; ++i) { const f32x2 send = b4 ? a8[i] : a8[i + 4], keep = b4 ? a8[i + 4] : a8[i]; a4[i] = keep + (f32x2){xor_get<16>(send[0], b4), xor_get<16>(send[1], b4)}; }
#pragma unroll
            for (int i = 0; i < 2; ++i) { const f32x2 send = b3 ? a4[i] : a4[i + 2], keep = b3 ? a4[i + 2] : a4[i]; a2[i] = keep + (f32x2){xor_get<8>(send[0], b3), xor_get<8>(send[1], b3)}; }
            { const f32x2 send = b2 ? a2[0] : a2[1], keep = b2 ? a2[1] : a2[0]; a1 = keep + (f32x2){xor_get<4>(send[0], b2), xor_get<4>(send[1], b2)}; }
            a1 = (f32x2){xor_sum<2>(a1[0]), xor_sum<2>(a1[1])}; a1 = (f32x2){xor_sum<1>(a1[0]), xor_sum<1>(a1[1])};
            const int gate = (b5 ? 8 : 0) + (b4 ? 4 : 0) + (b3 ? 2 : 0) + (b2 ? 1 : 0);
            if ((lane & 3) == 0) { const float bb = bfv[gate];
#pragma unroll
                for (int r = 0; r < NR; ++r) { const float zz = a1[r] + bb; lf[(size_t)(row0 + r) * 16 + gate] = fminf(zz, 0.f) - __logf(1.0f + __expf(-fabsf(zz))); } }
        }
    }
}

__device__ __forceinline__ void final_norm(const bf16* xb, float* out, const float* g, const int wv_) {
    constexpr int NR = 4;
    const int BID = obid(), GSZ = ogrid(); const int tid_ = otid(wv_);
    const int tid = tid_, lane = tid & 63, wave = __builtin_amdgcn_readfirstlane(tid >> 6);
    const int gw = BID * NWAVE + wave, NGW = GSZ * NWAVE;
    for (int row0 = gw * NR; row0 < M; row0 += NGW * NR) {
        f32x4 v[NR][4]; float ss[NR];
#pragma unroll
        for (int r = 0; r < NR; ++r) { const u32x2* xr = (const u32x2*)(xb + (size_t)(row0 + r) * DM) + lane;
#pragma unroll
            for (int j = 0; j < 4; ++j) { const u32x2 w = xr[64 * j];
                v[r][j] = (f32x4){__builtin_bit_cast(float, w.x << 16), __builtin_bit_cast(float, w.x & 0xffff0000u), __builtin_bit_cast(float, w.y << 16), __builtin_bit_cast(float, w.y & 0xffff0000u)}; } }
#pragma unroll
        for (int r = 0; r < NR; ++r) { float s = 0.f;
#pragma unroll
            for (int j = 0; j < 4; ++j) s += (v[r][j][0] * v[r][j][0] + v[r][j][1] * v[r][j][1]) + (v[r][j][2] * v[r][j][2] + v[r][j][3] * v[r][j][3]);
            ss[r] = wave_sum(s); }
        const f32x4* gp = (const f32x4*)g + lane;
#pragma unroll
        for (int j = 0; j < 4; ++j) { const f32x4 gg = gp[64 * j];
#pragma unroll
            for (int r = 0; r < NR; ++r) { const float rstd = __builtin_amdgcn_rsqf(ss[r] * (1.0f / DM) + EPS); ((f32x4*)(out + (size_t)(row0 + r) * DM) + lane)[64 * j] = (v[r][j] * rstd) * gg; } }
    }
}

__device__ __forceinline__ void fox_cumsum(const float* lf, float* Fc, LAS unsigned char* lds, const int wv_) {
    const int BID = obid(), GSZ = ogrid(); const int tid_ = otid(wv_);
    const int tid = tid_, lane = tid & 63, wave = __builtin_amdgcn_readfirstlane(tid >> 6);
    LAS float* wtot = (LAS float*)lds;
    for (int bh = BID; bh < NB * NH; bh += GSZ) {
        const int b = bh >> 4, h = bh & 15; const int s0 = 4 * tid;
        float a[4];
#pragma unroll
        for (int i = 0; i < 4; ++i) a[i] = lf[((size_t)(b * SEQ + s0 + i)) * 16 + h];
        a[1] += a[0]; a[2] += a[1]; a[3] += a[2];
        float xs = a[3];
#pragma unroll
        for (int off = 1; off < 64; off <<= 1) { const float t = __shfl_up(xs, off); if (lane >= off) xs += t; }
        if (lane == 63) wtot[wave] = xs;
        __syncthreads();
        float base = 0.f;
#pragma unroll
        for (int w = 0; w < NWAVE; ++w) { const float t = wtot[w]; if (w < wave) base += t; }
        const float excl = xs - a[3] + base;
        *(f32x4*)(Fc + (size_t)bh * SEQ + s0) = (f32x4){(a[0] + excl) * LOG2E, (a[1] + excl) * LOG2E, (a[2] + excl) * LOG2E, (a[3] + excl) * LOG2E};
        __syncthreads();
    }
}

constexpr int PTR_OFF = 131072;
__device__ __forceinline__ int crow(int r, int hi) { return (r & 3) + 8 * (r >> 2) + 4 * hi; }
__device__ __forceinline__ unsigned cvtpk(float lo, float hi) { typedef __bf16 bf16x2_t __attribute__((ext_vector_type(2))); f32x2 v = {lo, hi}; bf16x2_t b = __builtin_convertvector(v, bf16x2_t); return __builtin_bit_cast(unsigned, b); }
typedef short v4i16_t __attribute__((ext_vector_type(4)));
__device__ __forceinline__ s16x4 vtr(const LAS unsigned char* p) { return __builtin_bit_cast(s16x4, __builtin_amdgcn_ds_read_tr16_b64_v4i16((LAS v4i16_t*)p)); }
#define MFMA32(a, b, c) __builtin_amdgcn_mfma_f32_32x32x16_bf16((a), (b), (c), 0, 0, 0)

template <int NKS, bool BIAS>
__device__ __forceinline__ void attn_phase(LAS unsigned char* lds, const bf16* Q_, const bf16* K_, const bf16* V_, bf16* O_, const float* Fc_, const int wv_) {
    constexpr int QKD = 16 * NKS, QP = 16 * QKD, RS = QKD * 2 + 16, KCH = QKD / 8, NKC = 64 * KCH;
    constexpr int KB_BYTES = 64 * RS, L_K = 0, L_V = 2 * KB_BYTES, L_WS = L_V + 2 * 8192, L_ST = L_WS + NWAVE * 128, L_F = L_ST + NWAVE * 4096;
    constexpr float THR = 20.0f;
    static_assert(L_F + SEQ * 4 <= PTR_OFF, "attention LDS");
    typedef __attribute__((address_space(1))) const bf16 gcb; typedef __attribute__((address_space(1))) bf16 gb;
    gcb* Q = (gcb*)Q_; gcb* K = (gcb*)K_; gcb* V = (gcb*)V_; gb* O = (gb*)O_;
    const int BID = obid(), GSZ = ogrid(); const int tid_ = otid(wv_);
    const int tid = tid_, lane = tid & 63, r32 = lane & 31, hi = lane >> 5; const int wid = __builtin_amdgcn_readfirstlane(tid >> 6);
    LAS float* wsf = (LAS float*)(lds + L_WS) + wid * 32;
    LAS bf16* stg = (LAS bf16*)(lds + L_ST) + wid * 2048;
    constexpr int KCP = KCH + 1, NCHK = 64 * KCP; static_assert(NCHK % 64 == 0 && NCHK <= 1024, "K image is a whole number of 1 KiB pieces");
    const bool has1 = (wid + 8) * 64 < NCHK;
    const int ca = wid * 64 + lane, cb = has1 ? ca + 512 : ca;
    const unsigned kgo0 = (unsigned)((ca / KCP) * QP + ((ca % KCP) < KCH ? (ca % KCP) : 0) * 8), kgo1 = (unsigned)((cb / KCP) * QP + ((cb % KCP) < KCH ? (cb % KCP) : 0) * 8);
    const int vr = ca >> 3, vp = ca & 7; const unsigned vgo = (unsigned)(vr * DM + ((((vp >> 2) ^ ((vr >> 1) & 1)) << 2) | (vp & 3)) * 8);
    const int kd0 = wid * 1024, kd1 = (wid + 8) * 1024, vd = wid * 1024;
    const int kfb = r32 * RS + hi * 16;
    const int i16 = lane & 15, qq = i16 >> 2, pp = i16 & 3, blk = (lane >> 4) & 1, swz = (qq >> 1) & 1;
    const int vfb0 = (4 * hi + qq) * 128 + 32 * blk + 8 * pp + swz * 64, vfb1 = (4 * hi + qq) * 128 + 32 * blk + 8 * pp + (swz ^ 1) * 64;
#define A_GLDS(GP, LOFF) do { unsigned keep_; const unsigned ldst_ = (unsigned)__builtin_amdgcn_readfirstlane((int)(unsigned)(size_t)(lds + (LOFF))); \
        asm volatile("s_mov_b32 %0, m0\n\ts_mov_b32 m0, %2\n\ts_nop 0\n\tglobal_load_lds_dwordx4 %1, off\n\ts_mov_b32 m0, %0" : "=&s"(keep_) : "v"(GP), "s"(ldst_) : "memory"); } while (0)
#define A_DMAK(t, buf) do { gcb* Kt_ = Kh + (size_t)((unsigned)(t) * 64u) * QP; asm volatile("" : "+s"(Kt_)); A_GLDS(Kt_ + kgo0, L_K + (buf) * KB_BYTES + kd0); \
        if (has1) A_GLDS(Kt_ + kgo1, L_K + (buf) * KB_BYTES + kd1); } while (0)
#define A_DMAV(t, buf) do { gcb* Vt_ = Vh + (size_t)((unsigned)(t) * 64u) * DM; asm volatile("" : "+s"(Vt_)); A_GLDS(Vt_ + vgo, L_V + (buf) * 8192 + vd); } while (0)
#define A_DMAWAIT() asm volatile("s_waitcnt vmcnt(0)" ::: "memory")
#define A_QK(P0, P1, buf, CINIT) do { const LAS unsigned char* Kl_ = lds + L_K + (buf) * KB_BYTES + kfb; \
        bf16x8 a0_ = *(const LAS bf16x8*)(Kl_), a1_ = *(const LAS bf16x8*)(Kl_ + 32 * RS); \
        _Pragma("unroll") for (int ks = 0; ks < NKS; ++ks) { bf16x8 n0_ = a0_, n1_ = a1_; \
            if (ks + 1 < NKS) { n0_ = *(const LAS bf16x8*)(Kl_ + (ks + 1) * 32); n1_ = *(const LAS bf16x8*)(Kl_ + 32 * RS + (ks + 1) * 32); } \
            if (ks == 0) { P0 = MFMA32(a0_, qr[0], CINIT); P1 = MFMA32(a1_, qr[0], CINIT); } else { P0 = MFMA32(a0_, qr[ks], P0); P1 = MFMA32(a1_, qr[ks], P1); } \
            a0_ = n0_; a1_ = n1_; } } while (0)
#define A_VRD(kk, L0, H0, L1, H1) do { L0 = vtr(Vl_ + vfb0 + (kk) * 2048); H0 = vtr(Vl_ + vfb0 + (kk) * 2048 + 1024); L1 = vtr(Vl_ + vfb1 + (kk) * 2048); H1 = vtr(Vl_ + vfb1 + (kk) * 2048 + 1024); } while (0)
#define A_PV(buf) do { const LAS unsigned char* Vl_ = lds + L_V + (buf) * 8192; s16x4 l0_, h0_, l1_, h1_; A_VRD(0, l0_, h0_, l1_, h1_); \
        _Pragma("unroll") for (int kk = 0; kk < 4; ++kk) { s16x4 nl0_ = l0_, nh0_ = h0_, nl1_ = l1_, nh1_ = h1_; \
            if (kk + 1 < 4) A_VRD(kk + 1, nl0_, nh0_, nl1_, nh1_); \
            const bf16x8 b0_ = (bf16x8){l0_[0], l0_[1], l0_[2], l0_[3], h0_[0], h0_[1], h0_[2], h0_[3]}, b1_ = (bf16x8){l1_[0], l1_[1], l1_[2], l1_[3], h1_[0], h1_[1], h1_[2], h1_[3]}; \
            o0 = MFMA32(PAp[kk], b0_, o0); o1 = MFMA32(PAp[kk], b1_, o1); \
            l0_ = nl0_; h0_ = nh0_; l1_ = nl1_; h1_ = nh1_; } } while (0)
#define A_MASK(t) do { const int kb0_ = 64 * (t) + 4 * hi; \
        _Pragma("unroll") for (int i = 0; i < 16; ++i) { const int kv_ = kb0_ + (i & 3) + 8 * (i >> 2); if (kv_ > qabs) pc0[i] = -INFINITY; if (kv_ + 32 > qabs) pc1[i] = -INFINITY; } } while (0)
#define A_ROWMAX(RM) do { float a_ = __builtin_fmaxf(__builtin_fmaxf(pc0[0], pc0[1]), pc1[0]), b_ = __builtin_fmaxf(__builtin_fmaxf(pc0[2], pc0[3]), pc1[1]); a_ = __builtin_fmaxf(__builtin_fmaxf(a_, pc1[2]), pc1[3]); \
        _Pragma("unroll") for (int r = 4; r < 16; r += 4) { a_ = __builtin_fmaxf(__builtin_fmaxf(a_, pc0[r]), pc0[r + 1]); b_ = __builtin_fmaxf(__builtin_fmaxf(b_, pc0[r + 2]), pc0[r + 3]); \
            a_ = __builtin_fmaxf(__builtin_fmaxf(a_, pc1[r]), pc1[r + 1]); b_ = __builtin_fmaxf(__builtin_fmaxf(b_, pc1[r + 2]), pc1[r + 3]); } \
        RM = __builtin_fmaxf(a_, b_); { auto rr_ = __builtin_amdgcn_permlane32_swap(__float_as_uint(RM), __float_as_uint(RM), false, false); RM = __builtin_fmaxf(__uint_as_float(rr_[0]), __uint_as_float(rr_[1])); } } while (0)
#define A_EXPPACK() do { float ls_ = 0.f; \
        _Pragma("unroll") for (int i = 0; i < 16; ++i) { pc0[i] = __builtin_amdgcn_exp2f(pc0[i]); pc1[i] = __builtin_amdgcn_exp2f(pc1[i]); ls_ += pc0[i] + pc1[i]; } \
        lrow += ls_; u32x4 w_; \
        w_ = (u32x4){cvtpk(pc0[0], pc0[1]), cvtpk(pc0[2], pc0[3]), cvtpk(pc0[4], pc0[5]), cvtpk(pc0[6], pc0[7])}; PAc[0] = __builtin_bit_cast(bf16x8, w_); \
        w_ = (u32x4){cvtpk(pc0[8], pc0[9]), cvtpk(pc0[10], pc0[11]), cvtpk(pc0[12], pc0[13]), cvtpk(pc0[14], pc0[15])}; PAc[1] = __builtin_bit_cast(bf16x8, w_); \
        w_ = (u32x4){cvtpk(pc1[0], pc1[1]), cvtpk(pc1[2], pc1[3]), cvtpk(pc1[4], pc1[5]), cvtpk(pc1[6], pc1[7])}; PAc[2] = __builtin_bit_cast(bf16x8, w_); \
        w_ = (u32x4){cvtpk(pc1[8], pc1[9]), cvtpk(pc1[10], pc1[11]), cvtpk(pc1[12], pc1[13]), cvtpk(pc1[14], pc1[15])}; PAc[3] = __builtin_bit_cast(bf16x8, w_); } while (0)
#define A_BIAS(t) do { if (BIAS) { const LAS float* fb_ = (const LAS float*)(lds + L_F) + 64 * (t) + 4 * hi; \
        _Pragma("unroll") for (int g4 = 0; g4 < 4; ++g4) { const f32x4 b0_ = *(const LAS f32x4*)(fb_ + 8 * g4), b1_ = *(const LAS f32x4*)(fb_ + 8 * g4 + 32); \
            _Pragma("unroll") for (int j = 0; j < 4; ++j) { pc0[4 * g4 + j] -= b0_[j]; pc1[4 * g4 + j] -= b1_[j]; } } } } while (0)
#define A_VALU(t, BAND) do { A_BIAS(t); if (BAND) A_MASK(t); float rm_; A_ROWMAX(rm_); rm_ -= mrow; upd = __any(rm_ > THR); \
        if (upd) { const float dl_ = __builtin_fmaxf(rm_, 0.f); mrow += dl_; \
            fsc = __builtin_amdgcn_exp2f(-dl_); lrow *= fsc; } \
        _Pragma("unroll") for (int i = 0; i < 16; ++i) { pc0[i] -= mrow; pc1[i] -= mrow; } \
        A_EXPPACK(); } while (0)
#define A_KRD(ks) do { kf_[2 * (ks)] = *(const LAS bf16x8*)(Kl_ + (ks) * 32); kf_[2 * (ks) + 1] = *(const LAS bf16x8*)(Kl_ + 32 * RS + (ks) * 32); } while (0)
#define A_MFMA(t, DOQK, DOPV) do { const LAS unsigned char* Kl_ = lds + L_K + (((t) + 1) & 1) * KB_BYTES + kfb; const LAS unsigned char* Vl_ = lds + L_V + (((t) - 1) & 1) * 8192; \
        s16x4 vl0_[4], vh0_[4], vl1_[4], vh1_[4]; \
        if (DOQK) { bf16x8 kf_[2 * NKS]; \
            A_KRD(0); A_KRD(1); \
            __builtin_amdgcn_sched_barrier(0); \
            _Pragma("unroll") for (int ks = 0; ks < NKS; ++ks) { \
                if (ks == 0) { pn0 = MFMA32(kf_[0], qr[0], ((f32x16)(0.0f))); pn1 = MFMA32(kf_[1], qr[0], ((f32x16)(0.0f))); } \
                else { pn0 = MFMA32(kf_[2 * ks], qr[ks], pn0); pn1 = MFMA32(kf_[2 * ks + 1], qr[ks], pn1); } \
                if (ks + 2 < NKS) A_KRD(ks + 2); \
                if (ks >= NKS - 2) A_VRD(ks - (NKS - 2), vl0_[ks - (NKS - 2)], vh0_[ks - (NKS - 2)], vl1_[ks - (NKS - 2)], vh1_[ks - (NKS - 2)]); \
                __builtin_amdgcn_sched_barrier(0); } } \
        else if (DOPV) { A_VRD(0, vl0_[0], vh0_[0], vl1_[0], vh1_[0]); A_VRD(1, vl0_[1], vh0_[1], vl1_[1], vh1_[1]); } \
        if (DOPV) { \
            _Pragma("unroll") for (int kk = 0; kk < 4; ++kk) { \
                const bf16x8 b0_ = (bf16x8){vl0_[kk][0], vl0_[kk][1], vl0_[kk][2], vl0_[kk][3], vh0_[kk][0], vh0_[kk][1], vh0_[kk][2], vh0_[kk][3]}; \
                const bf16x8 b1_ = (bf16x8){vl1_[kk][0], vl1_[kk][1], vl1_[kk][2], vl1_[kk][3], vh1_[kk][0], vh1_[kk][1], vh1_[kk][2], vh1_[kk][3]}; \
                o0 = MFMA32(PAp[kk], b0_, o0); o1 = MFMA32(PAp[kk], b1_, o1); \
                if (kk + 2 < 4) A_VRD(kk + 2, vl0_[kk + 2], vh0_[kk + 2], vl1_[kk + 2], vh1_[kk + 2]); \
                __builtin_amdgcn_sched_barrier(0); } } } while (0)
    const bool teamed = (GSZ == 256);
    const int xcd = BID & 7, slot = BID >> 3, team = slot >> 3, mem = slot & 7;
#ifdef PROBE_AT
    unsigned long long pacc = 0, pt0 = 0;
#define PT_BEG(C) do { if (PROBE_AT == (C)) pt0 = __builtin_amdgcn_s_memtime(); } while (0)
#define PT_END(C) do { if (PROBE_AT == (C)) pacc += __builtin_amdgcn_s_memtime() - pt0; } while (0)
#else
#define PT_BEG(C) do {} while (0)
#define PT_END(C) do {} while (0)
#endif
    const int nit = teamed ? 8 : 8 * ((NB * NH - BID + GSZ - 1) / GSZ);
#define A_UNIT(i, BH, QB) do { if (teamed) { BH = (xcd * 4 + team) * 8 + (i); QB = (mem + (i)) & 7; } else { BH = BID + ((i) >> 3) * GSZ; QB = 7 - ((i) & 7); } } while (0)
    bf16x8 qr[NKS];
#define A_PREFETCH(i) do { int bh_, qb_; A_UNIT(i, bh_, qb_); const size_t rb_ = (size_t)(bh_ >> 4) * SEQ; const int h_ = bh_ & 15; \
        gcb* Kh = K + rb_ * QP + h_ * QKD; gcb* Vh = V + rb_ * DM + h_ * 64; gcb* Qu_ = Q + (rb_ + qb_ * 256 + wid * 32) * QP + h_ * QKD; \
        unsigned qgo_; { int lq = lane; asm volatile("" : "+v"(lq)); qgo_ = (unsigned)((lq & 31) * QP + (lq >> 5) * 8); } \
        _Pragma("unroll") for (int ks = 0; ks < NKS; ++ks) qr[ks] = *(const __attribute__((address_space(1))) bf16x8*)(Qu_ + qgo_ + ks * 16); \
        A_DMAK(0, 0); A_DMAV(0, 0); A_DMAK(1, 1); } while (0)
    if (nit > 0) A_PREFETCH(0);
    for (int it = 0; it < nit; ++it) {
        int bh, qb; A_UNIT(it, bh, qb);
        const int b = bh >> 4, h = bh & 15; const size_t rowbase = (size_t)b * SEQ;
        gcb* Kh = K + rowbase * QP + h * QKD; gcb* Vh = V + rowbase * DM + h * 64;
        {
            const int q0 = qb * 256; const int NT = 4 * qb + 4;
            PT_BEG('U');
            const int qabs = q0 + wid * 32 + r32; const int Tw = 4 * qb + (wid >> 1);
            if (BIAS) *(LAS f32x4*)(lds + L_F + tid * 16) = *(const __attribute__((address_space(1))) f32x4*)((const __attribute__((address_space(1))) float*)Fc_ + (size_t)bh * SEQ + 4 * tid);
            A_DMAWAIT(); __syncthreads();
            f32x16 pc0, pc1, pn0, pn1, o0 = (f32x16)(0.0f), o1 = (f32x16)(0.0f);
            A_QK(pc0, pc1, 0, ((f32x16)(0.0f))); A_QK(pn0, pn1, 1, ((f32x16)(0.0f)));
            bf16x8 PAp[4], PAc[4]; float mrow, lrow = 0.f, fsc = 1.f; bool upd = false;
            { A_BIAS(0); if (NT == 4) A_MASK(0);
              float rm_; A_ROWMAX(rm_); mrow = rm_;
#pragma unroll
              for (int i = 0; i < 16; ++i) { pc0[i] -= mrow; pc1[i] -= mrow; }
              A_EXPPACK(); }
#pragma unroll
            for (int k4 = 0; k4 < 4; ++k4) PAp[k4] = PAc[k4];
            pc0 = pn0; pc1 = pn1;
            __syncthreads();
            A_DMAK(2, 0);
            A_DMAWAIT(); __syncthreads();
            PT_END('U');
            for (int t = 1; t < NT; ++t) {
                if (t + 2 < NT) A_DMAK(t + 2, t & 1);
                A_DMAV(t, t & 1);
                const bool band = (t >= NT - 4);
                const bool doqk = (t + 1 <= Tw), dopv = (t - 1 <= Tw), dova = (t <= Tw);
                A_MFMA(t, doqk, dopv);
                if (dova) { A_VALU(t, band); } else { upd = false; }
                if (upd) {
                    if (hi == 0) wsf[r32] = fsc;
                    asm volatile("" ::: "memory");
#pragma unroll
                    for (int g4 = 0; g4 < 4; ++g4) { const f32x4 a = *(const LAS f32x4*)(wsf + 8 * g4 + 4 * hi);
#pragma unroll
                        for (int j = 0; j < 4; ++j) { o0[4 * g4 + j] *= a[j]; o1[4 * g4 + j] *= a[j]; } }
                    asm volatile("" ::: "memory");
                }
                A_DMAWAIT(); __syncthreads();
                pc0 = pn0; pc1 = pn1;
#pragma unroll
                for (int k4 = 0; k4 < 4; ++k4) PAp[k4] = PAc[k4];
            }
            PT_BEG('U');
            { const int inx = (it + 1 < nit) ? it + 1 : it; A_PREFETCH(inx); }
            if (NT - 1 <= Tw) { A_PV((NT - 1) & 1); }
            lrow = xor_sum<32>(lrow);
            { int le = lane; asm volatile("" : "+v"(le));
              const int r32e = le & 31, hie = le >> 5;
              if (hie == 0) wsf[r32e] = 1.0f / lrow;
              asm volatile("" ::: "memory");
              LAS bf16* st0 = stg + (4 * hie) * 64 + r32e;
#pragma unroll
              for (int g4 = 0; g4 < 4; ++g4) { const f32x4 a = *(const LAS f32x4*)(wsf + 8 * g4 + 4 * hie);
#pragma unroll
                  for (int j = 0; j < 4; ++j) { const int i = 4 * g4 + j;
                      st0[(8 * g4 + j) * 64] = (bf16)f2bf(o0[i] * a[j]); st0[(8 * g4 + j) * 64 + 32] = (bf16)f2bf(o1[i] * a[j]); } }
              asm volatile("s_waitcnt lgkmcnt(0)" ::: "memory");
              const unsigned lo_ = (unsigned)((le >> 3) * DM + (le & 7) * 8); const LAS bf16* sr0 = stg + (le >> 3) * 64 + (le & 7) * 8;
#pragma unroll
              for (int i = 0; i < 4; ++i) { gb* Ow = O + (rowbase + q0 + wid * 32 + i * 8) * DM + h * 64; const u32x4 v = *(const LAS u32x4*)(sr0 + i * 8 * 64); *(__attribute__((address_space(1))) u32x4*)(Ow + lo_) = v; } }
            A_DMAWAIT(); __syncthreads();
            PT_END('U');
        }
    }
#ifdef PROBE_AT
    { const unsigned long long w0 = __builtin_amdgcn_s_memtime(); while (__builtin_amdgcn_s_memtime() - w0 < pacc) __builtin_amdgcn_s_sleep(4); }
#endif
#undef PT_BEG
#undef PT_END
#undef A_GLDS
#undef A_UNIT
#undef A_PREFETCH
#undef A_DMAK
#undef A_DMAV
#undef A_DMAWAIT
#undef A_QK
#undef A_PV
#undef A_VRD
#undef A_MASK
#undef A_ROWMAX
#undef A_EXPPACK
#undef A_VALU
#undef A_BIAS
#undef A_MFMA
#undef A_KRD
}

#define XB_TMO      128
#define XB_XCNT(j)  (256  + 64 * (j))
#define XB_XSUB(j)  (1280 + 64 * (j))
#define XB_XGEN(j)  (2304 + 64 * (j))
#define XB_TOP      3328
#define XB_TOPGEN   3392
#define XCD_BAR_WORDS 3456
#define XB_SPIN_CAP (1u << 18)

__device__ __forceinline__ unsigned xb_ld(unsigned* p)              { return __hip_atomic_load(p, __ATOMIC_RELAXED, __HIP_MEMORY_SCOPE_AGENT); }
__device__ __forceinline__ unsigned xb_add(unsigned* p, unsigned v) { return __hip_atomic_fetch_add(p, v, __ATOMIC_RELAXED, __HIP_MEMORY_SCOPE_AGENT); }
__device__ __forceinline__ unsigned xb_xcc_id() { return (unsigned)__builtin_amdgcn_s_getreg((3 << 11) | 20) & 0xFu; }
#define XB_SPIN(cond, bar) do { unsigned _sp = 0; while (cond) { __builtin_amdgcn_s_sleep(1); \
    if ((++_sp & 255u) == 0u) { if (xb_ld(&(bar)[XB_TMO])) break; if (_sp > XB_SPIN_CAP) { atomicAdd(&(bar)[XB_TMO], 1u); break; } } } } while (0)

struct XcdBarrier {
    unsigned* bar; unsigned x;
    volatile LAS unsigned* st;
};

__device__ __forceinline__ XcdBarrier xcd_barrier_post(unsigned* bar, volatile LAS unsigned* st, const int wv_) {
    XcdBarrier b; b.bar = bar; b.x = xb_xcc_id(); b.st = st;
    if (otid(wv_) == 0) (void)xb_add(&bar[XB_XCNT(b.x)], 1u);
    return b;
}
__device__ __forceinline__ void xcd_barrier_complete(unsigned* bar, unsigned x, unsigned& nloc, unsigned& nx) {
    const unsigned G = gridDim.x * gridDim.y * gridDim.z;
    unsigned sum, cnt, mine, sp = 0u;
    for (;;) {
        sum = 0u; cnt = 0u; mine = 0u;
#pragma unroll
        for (unsigned j = 0; j < 16; ++j) { const unsigned c = xb_ld(&bar[XB_XCNT(j)]); sum += c; cnt += (c > 0u) ? 1u : 0u; mine = (j == x) ? c : mine; }
        if (sum == G) break;
        __builtin_amdgcn_s_sleep(1);
        if ((++sp & 255u) == 0u) { if (xb_ld(&bar[XB_TMO])) break; if (sp > XB_SPIN_CAP) { atomicAdd(&bar[XB_TMO], 1u); break; } }
    }
    nloc = mine > 0u ? mine : 1u; nx = cnt > 0u ? cnt : 1u;
}

__device__ __forceinline__ void xcd_barrier(const XcdBarrier& b, const int wv_) {
    asm volatile("s_waitcnt vmcnt(0)" ::: "memory");
    __syncthreads();
    if (otid(wv_) == 0) {
        unsigned* bar = b.bar;
        __builtin_amdgcn_s_waitcnt(0);
        unsigned nloc = b.st[0], nx = b.st[1];
        if (nloc == 0u) { xcd_barrier_complete(bar, b.x, nloc, nx); b.st[0] = nloc; b.st[1] = nx; }
        const unsigned old = xb_add(&bar[XB_XSUB(b.x)], 1u);
        const unsigned gen = old / nloc;
        if (old + 1u == (gen + 1u) * nloc) {
            __builtin_amdgcn_fence(__ATOMIC_RELEASE, "agent");
            asm volatile("s_waitcnt vmcnt(0)" ::: "memory");
            const unsigned og = xb_add(&bar[XB_TOP], 1u);
            const unsigned tg = og / nx;
            if (og + 1u == (tg + 1u) * nx) xb_add(&bar[XB_TOPGEN], 1u);
            else XB_SPIN(xb_ld(&bar[XB_TOPGEN]) == tg, bar);
            __builtin_amdgcn_fence(__ATOMIC_ACQUIRE, "agent");
            xb_add(&bar[XB_XGEN(b.x)], 1u);
            asm volatile("s_waitcnt vmcnt(0)" ::: "memory");
        } else {
            XB_SPIN(xb_ld(&bar[XB_XGEN(b.x)]) == gen, bar);
            __builtin_amdgcn_fence(__ATOMIC_ACQUIRE, "agent");
            asm volatile("s_waitcnt vmcnt(0)" ::: "memory");
        }
    }
    __syncthreads();
}

__device__ __forceinline__ const float* inptr(LAS unsigned char* lds, int i) {
    unsigned off = PTR_OFF + 8 * i; asm volatile("" : "+v"(off));
    const u32x2 v = *(const LAS u32x2*)(lds + off);
    const unsigned lo = __builtin_amdgcn_readfirstlane(v.x), hi = __builtin_amdgcn_readfirstlane(v.y);
    return (const float*)(((unsigned long long)hi << 32) | lo);
}
__global__ void __launch_bounds__(NTHR, 2) trunk_fwd(Params p) {
    extern __shared__ __attribute__((aligned(16))) unsigned char lds_raw[];
    LAS unsigned char* lds = (LAS unsigned char*)lds_raw;
    cg::grid_group grid = cg::this_grid();
    const int wv_ = __builtin_amdgcn_readfirstlane(threadIdx.x >> 6);
#ifdef PROBE_CAT
    const unsigned long long tp0_ = __builtin_amdgcn_s_memrealtime();
#endif
#ifndef NO_PRO
    prologue(p, lds, wv_);
#endif
#ifdef PROBE_CAT
    if (PROBE_CAT == 'P') { const unsigned long long d_ = __builtin_amdgcn_s_memrealtime() - tp0_; const unsigned long long w0_ = __builtin_amdgcn_s_memrealtime(); while (__builtin_amdgcn_s_memrealtime() - w0_ < d_) __builtin_amdgcn_s_sleep(8); }
#endif
    { const int t0 = otid(wv_); if (t0 < 22) { const unsigned long long v = (t0 < 20) ? (unsigned long long)p.in[t0 < 20 ? t0 : 0] : (t0 == 20 ? (unsigned long long)p.out : (unsigned long long)p.ws);
        ((LAS unsigned long long*)(lds + PTR_OFF))[t0] = v; }
      if (t0 < 2) ((volatile LAS unsigned*)(lds + PTR_OFF + 256))[t0] = 0u; }
    if (blockIdx.x == 0) { unsigned* bw = (unsigned*)(p.ws + WS_CTL); for (int i = otid(wv_); i < XCD_BAR_WORDS; i += NTHR) __hip_atomic_store(bw + i, 0u, __ATOMIC_RELAXED, __HIP_MEMORY_SCOPE_AGENT); }
    __syncthreads();
    grid.sync();
    const XcdBarrier bar = xcd_barrier_post((unsigned*)(p.ws + WS_CTL), (volatile LAS unsigned*)(lds + PTR_OFF + 256), wv_);
#ifdef PROBE_CAT
    unsigned long long tprev_ = __builtin_amdgcn_s_memrealtime();
#define GSYNC(C) do { if ((C) == PROBE_CAT) { const unsigned long long d_ = __builtin_amdgcn_s_memrealtime() - tprev_; const unsigned long long w0_ = __builtin_amdgcn_s_memrealtime(); \
        while (__builtin_amdgcn_s_memrealtime() - w0_ < d_) __builtin_amdgcn_s_sleep(8); } xcd_barrier(bar, wv_); tprev_ = __builtin_amdgcn_s_memrealtime(); } while (0)
#else
#define GSYNC(C) xcd_barrier(bar, wv_)
#endif
#define WSP ((unsigned char*)inptr(lds, 21))
#define XRES ((float*)inptr(lds, 20))
#pragma nounroll
    for (int l = 0; l < DEPTH; ++l) {
        const int j = l >> 1; const bool fox = (l & 1) == 0;
#ifndef NO_NORM
        { unsigned char* ws = WSP; const float* modl = (const float*)(ws + WS_MOD) + (size_t)l * 16 * 6144;
          if (fox) norm_phase<2, true>((l == 0) ? (const void*)inptr(lds, I_X) : (const void*)(ws + WS_XB), l != 0, inptr(lds, I_GMIX) + l * DM, modl + 0, modl + 1024, (bf16*)(ws + WS_H), inptr(lds, I_FWIN) + (size_t)j * DM * 3088, inptr(lds, I_FBF) + j * 16, (float*)(ws + WS_LF), lds, wv_);
          else norm_phase<8, false>((const void*)(ws + WS_XB), true, inptr(lds, I_GMIX) + l * DM, modl + 0, modl + 1024, (bf16*)(ws + WS_H), nullptr, nullptr, nullptr, lds, wv_); }
#endif
        GSYNC('N');
        if (fox) {
#ifndef NO_CUM
            { unsigned char* ws = WSP; fox_cumsum((const float*)(ws + WS_LF), (float*)(ws + WS_CQ), lds, wv_); }
#endif
#ifndef NO_G1F
            { unsigned char* ws = WSP; const bf16* WinT = (const bf16*)(ws + WS_W + W_FOX + (size_t)j * W_FOX_STRIDE);
              pg8::Gemm g{(const bf16*)(ws + WS_H), WinT, M, 3072, DM}; pg8::StaticOrder S; S.init(M, 3072, ogrid(), obid());
              pg8::EpiQkvFox E{ws, 0.125f * LOG2E};
              pg8::gemm_phase<pg8::EpiQkvFox, pg8::StaticOrder, true, true>(lds, g, S, E, wv_); }
#endif
            GSYNC('G');
#ifndef NO_ATT5
            { unsigned char* ws = WSP; attn_phase<4, true>(lds, (const bf16*)(ws + WS_Q), (const bf16*)(ws + WS_K), (const bf16*)(ws + WS_V), (bf16*)(ws + WS_H), (const float*)(ws + WS_CQ), wv_); }
#ifdef PROBE_ATT2
            { unsigned char* ws = WSP; attn_phase<4, true>(lds, (const bf16*)(ws + WS_Q), (const bf16*)(ws + WS_K), (const bf16*)(ws + WS_V), (bf16*)(ws + WS_H), (const float*)(ws + WS_CQ), wv_); }
#endif
#endif
            GSYNC('A');
        } else {
#ifndef NO_GD
            { unsigned char* ws = WSP; const bf16* WdT = (const bf16*)(ws + WS_W + W_MLA + (size_t)j * W_MLA_STRIDE);
              pg8::Gemm g{(const bf16*)(ws + WS_H), WdT, M, 512, DM}; pg8::StaticOrder S; S.init(M, 512, ogrid(), obid());
              pg8::EpiMlaDown E{ws};
              pg8::gemm_phase<pg8::EpiMlaDown, pg8::StaticOrder, true, true>(lds, g, S, E, wv_); }
#endif
            GSYNC('H');
#ifndef NO_GQ
            { unsigned char* ws = WSP; const bf16* WuqT = (const bf16*)(ws + WS_W + W_MLA + (size_t)j * W_MLA_STRIDE) + (size_t)512 * 1024;
              int Kq = 256; asm volatile("" : "+s"(Kq));
              pg8::Gemm g{(const bf16*)(ws + WS_CQ), WuqT, M, 1536, Kq}; pg8::StaticOrder S; S.init(M, 1536, ogrid(), obid());
              pg8::EpiMlaQ E{ws, 0.10206207261596575f * LOG2E};
              pg8::gemm_phase<pg8::EpiMlaQ, pg8::StaticOrder, true, true>(lds, g, S, E, wv_); }
#endif
#ifndef NO_GKV
            { unsigned char* ws = WSP; const bf16* WukvT = (const bf16*)(ws + WS_W + W_MLA + (size_t)j * W_MLA_STRIDE) + (size_t)512 * 1024 + (size_t)1536 * 256;
              int Kkv = 128; asm volatile("" : "+s"(Kkv));
              pg8::Gemm g{(const bf16*)(ws + WS_CKV), WukvT, M, 2048, Kkv}; pg8::StaticOrder S; S.init(M, 2048, ogrid(), obid());
              pg8::EpiMlaKv E{ws};
              pg8::gemm_phase<pg8::EpiMlaKv, pg8::StaticOrder, true, true>(lds, g, S, E, wv_); }
#endif
            GSYNC('Q');
#ifndef NO_ATT6
            { unsigned char* ws = WSP; attn_phase<6, false>(lds, (const bf16*)(ws + WS_Q), (const bf16*)(ws + WS_K), (const bf16*)(ws + WS_V), (bf16*)(ws + WS_H), (const float*)nullptr, wv_); }
#ifdef PROBE_ATT2
            { unsigned char* ws = WSP; attn_phase<6, false>(lds, (const bf16*)(ws + WS_Q), (const bf16*)(ws + WS_K), (const bf16*)(ws + WS_V), (bf16*)(ws + WS_H), (const float*)nullptr, wv_); }
#endif
#endif
            GSYNC('B');
        }
#ifndef NO_GO
        { unsigned char* ws = WSP; const float* modl = (const float*)(ws + WS_MOD) + (size_t)l * 16 * 6144;
          const bf16* WoutT = fox ? (const bf16*)(ws + WS_W + W_FOX + (size_t)j * W_FOX_STRIDE) + (size_t)3072 * DM : (const bf16*)(ws + WS_W + W_MLA + (size_t)j * W_MLA_STRIDE + 3 * MiB);
          pg8::Gemm g{(const bf16*)(ws + WS_H), WoutT, M, DM, DM}; pg8::StaticOrder S; S.init(M, DM, ogrid(), obid());
          pg8::EpiResid E{(l == 0) ? inptr(lds, I_X) : (const float*)nullptr, (bf16*)(ws + WS_XB), modl + 2048};
          pg8::gemm_phase<pg8::EpiResid, pg8::StaticOrder, true, true>(lds, g, S, E, wv_); }
#endif
        GSYNC('O');
#ifndef NO_NORM2
        { unsigned char* ws = WSP; const float* modl = (const float*)(ws + WS_MOD) + (size_t)l * 16 * 6144;
          norm_phase<8, false>((const void*)(ws + WS_XB), true, inptr(lds, I_GMLP) + l * DM, modl + 3072, modl + 4096, (bf16*)(ws + WS_H), nullptr, nullptr, nullptr, lds, wv_); }
#endif
        GSYNC('M');
#ifndef NO_GU
        { unsigned char* ws = WSP; const bf16* W1T = (const bf16*)(ws + WS_W + W_MLP + (size_t)l * W_MLP_STRIDE);
          pg8::Gemm g{(const bf16*)(ws + WS_H), W1T, M, FF, DM}; pg8::StaticOrder S; S.init(M, FF, ogrid(), obid());
          pg8::EpiRelu2 E{ws};
          pg8::gemm_phase<pg8::EpiRelu2, pg8::StaticOrder, true, true>(lds, g, S, E, wv_); }
#endif
        GSYNC('U');
#ifndef NO_GDN
        { unsigned char* ws = WSP; const float* modl = (const float*)(ws + WS_MOD) + (size_t)l * 16 * 6144;
          const bf16* W2T = (const bf16*)(ws + WS_W + W_MLP + (size_t)l * W_MLP_STRIDE) + (size_t)FF * DM;
          pg8::Gemm g{(const bf16*)(ws + WS_BIG), W2T, M, DM, FF}; pg8::StaticOrder S; S.init(M, DM, ogrid(), obid());
          pg8::EpiResid E{(const float*)nullptr, (bf16*)(ws + WS_XB), modl + 5120};
          pg8::gemm_phase<pg8::EpiResid, pg8::StaticOrder, true, true>(lds, g, S, E, wv_); }
#endif
        GSYNC('D');
    }
    final_norm((const bf16*)(WSP + WS_XB), XRES, inptr(lds, I_GFIN), wv_);
#ifdef PROBE_CAT
    if (PROBE_CAT == 'F') { const unsigned long long d_ = __builtin_amdgcn_s_memrealtime() - tprev_; const unsigned long long w0_ = __builtin_amdgcn_s_memrealtime(); while (__builtin_amdgcn_s_memrealtime() - w0_ < d_) __builtin_amdgcn_s_sleep(8); }
#endif
}

extern "C" void kernel_launch(void* const* d_in, const int* in_sizes, int n_in, void* d_out, int out_size, void* d_ws, size_t ws_size, hipStream_t stream) {
    static int grid = 0;
    if (grid == 0) {
        if (n_in != 20 || in_sizes[0] != M * DM || out_size != M * DM || ws_size < WS_END) { fprintf(stderr, "kernel_launch: unexpected shapes (n_in %d, in0 %d, out %d, ws %zu)\n", n_in, n_in > 0 ? in_sizes[0] : -1, out_size, ws_size); grid = -1; return; }
        int dev = 0, cus = 0, per_cu = 0;
        if (hipGetDevice(&dev) != hipSuccess || hipDeviceGetAttribute(&cus, hipDeviceAttributeMultiprocessorCount, dev) != hipSuccess) { fprintf(stderr, "kernel_launch: device query failed\n"); grid = -1; return; }
        if (hipFuncSetAttribute((const void*)trunk_fwd, hipFuncAttributeMaxDynamicSharedMemorySize, LDS_BYTES) != hipSuccess) { fprintf(stderr, "kernel_launch: hipFuncSetAttribute failed\n"); grid = -1; return; }
        if (hipOccupancyMaxActiveBlocksPerMultiprocessor(&per_cu, (const void*)trunk_fwd, NTHR, LDS_BYTES) != hipSuccess || per_cu < 1) { fprintf(stderr, "kernel_launch: occupancy query gave %d\n", per_cu); per_cu = 1; }
        (void)hipGetLastError();
        grid = cus * per_cu;
    }
    if (grid < 0) return;
    Params prm{};
    for (int i = 0; i < 20; ++i) prm.in[i] = (const float*)d_in[i];
    prm.out = (float*)d_out; prm.ws = (unsigned char*)d_ws;
    void* args[] = {&prm};
    hipError_t e = hipLaunchCooperativeKernel((const void*)trunk_fwd, dim3(grid), dim3(NTHR), args, LDS_BYTES, stream);
    if (e != hipSuccess) fprintf(stderr, "kernel_launch: cooperative launch failed: %s (grid %d)\n", hipGetErrorString(e), grid);
}
```

```cpp
#include <hip/hip_runtime.h>
#include <hip/hip_cooperative_groups.h>
#include <cstdio>
#include <cstdint>
namespace cg = cooperative_groups;
#define LAS __attribute__((address_space(3)))
typedef unsigned short bf16;
typedef short bf16x8 __attribute__((ext_vector_type(8)));
typedef short s16x4 __attribute__((ext_vector_type(4)));
typedef float f32x16 __attribute__((ext_vector_type(16)));
typedef float f32x4 __attribute__((ext_vector_type(4)));
typedef float f32x2 __attribute__((ext_vector_type(2)));
typedef unsigned u32x4 __attribute__((ext_vector_type(4)));
typedef unsigned u32x2 __attribute__((ext_vector_type(2)));

constexpr int NB = 16, SEQ = 2048, DM = 1024, NH = 16, FF = 4096, DEPTH = 4;
constexpr int M = NB * SEQ;
constexpr int NTHR = 512, NWAVE = 8;
constexpr float EPS = 1e-6f, LOG2E = 1.4426950408889634f;
constexpr size_t MiB = 1u << 20;
constexpr size_t WS_BIG = 0;
constexpr size_t WS_Q = 0, WS_K = 96 * MiB, WS_V = 192 * MiB;
constexpr size_t WS_KR = 96 * MiB + 64 * MiB;
constexpr size_t WS_H = 256 * MiB;
constexpr size_t WS_CQ = 320 * MiB, WS_CKV = 336 * MiB;
constexpr size_t WS_W = 344 * MiB;
constexpr size_t W_FOX = 0, W_FOX_STRIDE = 8 * MiB;
constexpr size_t W_MLA = 16 * MiB, W_MLA_STRIDE = 5 * MiB;
constexpr size_t W_MLP = 26 * MiB, W_MLP_STRIDE = 16 * MiB;
constexpr size_t WS_MOD = 436 * MiB;
constexpr size_t WS_CS = 438 * MiB;
constexpr size_t WS_LF = 442 * MiB;
constexpr size_t WS_SSQQ = 444 * MiB, WS_SSQKV = 445 * MiB;
constexpr size_t WS_CTL = 446 * MiB;
constexpr size_t WS_XB = 447 * MiB;
constexpr size_t WS_END = 511 * MiB;
static_assert(WS_W + W_MLP + 4 * W_MLP_STRIDE <= WS_MOD, "weights fit");
constexpr int LDS_BYTES = 135168;

template <int MASK> __device__ __forceinline__ float xor_sum(float v) {
    if constexpr (MASK == 32) return v + __shfl_xor(v, 32);
    else return v + __builtin_bit_cast(float, __builtin_amdgcn_ds_swizzle(__builtin_bit_cast(int, v), (MASK << 10) | 0x1F));
}
template <int MASK> __device__ __forceinline__ float xor_get(float v, bool upper) {
    if constexpr (MASK == 32) return __shfl_xor(v, 32);
    else return __builtin_bit_cast(float, __builtin_amdgcn_ds_swizzle(__builtin_bit_cast(int, v), (MASK << 10) | 0x1F));
}
__device__ __forceinline__ float wave_sum(float v) { v = xor_sum<1>(v); v = xor_sum<2>(v); v = xor_sum<4>(v); v = xor_sum<8>(v); v = xor_sum<16>(v); v = xor_sum<32>(v); return v; }
namespace pg8 {
#define PG8_LAS __attribute__((address_space(3)))
typedef unsigned short bf16_t;
typedef short bf16x8 __attribute__((ext_vector_type(8)));
typedef float f32x4 __attribute__((ext_vector_type(4)));
typedef unsigned u32x4 __attribute__((ext_vector_type(4)));
constexpr int BM = 256, BK = 64, HALF = 128, HTB = HALF * BK * 2  , STAGE_BYTES = 8 * HTB, NXCD = 8, WGM = 8;

__host__ __device__ __forceinline__ int lds_byte(int r, int c) { const int st = (r >> 4) * 2 + (c >> 5), rr = r & 15, cc = c & 31, ob = rr * 64 + cc * 2; return st * 1024 + (ob ^ (((ob >> 9) & 1) << 5)); }
__host__ __device__ __forceinline__ void stage_rc(int b, int& R, int& C) { const int st = b / 1024, sb = b % 1024, swz = sb ^ (((sb >> 9) & 1) << 5); R = (st >> 1) * 16 + swz / 64; C = (st & 1) * 32 + (swz % 64) / 2; }
__host__ __device__ __forceinline__ int perm32(int rho) { const int n = rho >> 4, i = rho & 15; return 8 * (i >> 2) + 4 * n + (i & 3); }

struct Unit { int pm, pn; };
struct Gemm { const bf16_t* A; const bf16_t* Bt; int M, N, K; };

struct StaticOrder {
    int nM, nN, nwg, G, c;
    __host__ __device__ void init(int M, int N, int G_, int c_) { nM = M / BM; nN = N / BM; nwg = nM * nN; G = G_; c = c_; }
    __host__ __device__ bool next(int i, Unit& u) const {
        const long L = (long)i * G + c; if (L >= nwg) return false;
        int wgid = (int)L; { const int q = nwg / NXCD, r = nwg % NXCD, xcd = wgid % NXCD, off = wgid / NXCD; wgid = (xcd < r ? xcd * (q + 1) : r * (q + 1) + (xcd - r) * q) + off; }
        const int nig = WGM * nN, gid = wgid / nig, fm = gid * WGM, gsz = (nM - fm) < WGM ? (nM - fm) : WGM;
        u.pm = fm + ((wgid % nig) % gsz); u.pn = (wgid % nig) / gsz; return true;
    }
    __device__ __forceinline__ void a_ready(const Unit&) const {}
    __device__ __forceinline__ void done(const Unit&) const {}
};

__device__ __forceinline__ unsigned cvt_pk_bf16(float lo, float hi) { unsigned r; asm volatile("v_cvt_pk_bf16_f32 %0, %1, %2" : "=v"(r) : "v"(lo), "v"(hi)); return r; }
typedef float f32x2 __attribute__((ext_vector_type(2)));
typedef unsigned u32x2 __attribute__((ext_vector_type(2)));
#define GAS __attribute__((address_space(1)))
typedef GAS bf16_t gbf16; typedef GAS float gf32; typedef GAS unsigned char gu8;
constexpr float RMS_EPS = 1e-6f;
__device__ __forceinline__ u32x4 pack8(const f32x4& v0, const f32x4& v1) { u32x4 w; w.x = cvt_pk_bf16(v0[0], v0[1]); w.y = cvt_pk_bf16(v0[2], v0[3]); w.z = cvt_pk_bf16(v1[0], v1[1]); w.w = cvt_pk_bf16(v1[2], v1[3]); return w; }
__device__ __forceinline__ u32x2 pack4(const f32x4& v) { u32x2 w; w.x = cvt_pk_bf16(v[0], v[1]); w.y = cvt_pk_bf16(v[2], v[3]); return w; }

struct EpiQkvFox {
    static constexpr bool PERM = true, AFTER_DRAIN = false;
    unsigned char* ws; float qscale;
    __device__ __forceinline__ void operator()(const f32x4 (&acc)[2][2][4][2], const Unit& u, int wr, int wc, int fr, int fq) const {
        gbf16* Q = (gbf16*)((gu8*)ws + WS_Q); gbf16* Kp = (gbf16*)((gu8*)ws + WS_K); gbf16* V = (gbf16*)((gu8*)ws + WS_V);
        const int row0 = u.pm * BM + wr * 64 + fr;
        const int t = u.pn >> 2;
        const int cin0 = (u.pn & 3) * BM + wc * 32 + 8 * fq;
        const float sc = (t == 0) ? qscale : 1.f;
#pragma unroll
        for (int ai = 0; ai < 2; ++ai)
#pragma unroll
            for (int m = 0; m < 4; ++m) { const unsigned row = (unsigned)(row0 + ai * HALF + m * 16);
#pragma unroll
                for (int bj = 0; bj < 2; ++bj) { const int cin = cin0 + bj * HALF;
                    gbf16* dst = (t == 2) ? (V + row * 1024 + cin) : ((t == 0 ? Q : Kp) + row * 1024 + cin);
                    *(GAS u32x4*)dst = pack8(acc[ai][bj][m][0] * sc, acc[ai][bj][m][1] * sc); } }
    }
};
struct EpiRelu2 {
    static constexpr bool PERM = true, AFTER_DRAIN = false;
    unsigned char* ws;
    __device__ __forceinline__ void operator()(const f32x4 (&acc)[2][2][4][2], const Unit& u, int wr, int wc, int fr, int fq) const {
        gbf16* H = (gbf16*)((gu8*)ws + WS_BIG);
        const int row0 = u.pm * BM + wr * 64 + fr; const int col0 = u.pn * BM + wc * 32 + 8 * fq;
#pragma unroll
        for (int ai = 0; ai < 2; ++ai)
#pragma unroll
            for (int m = 0; m < 4; ++m) { gbf16* rowp = H + (unsigned)(row0 + ai * HALF + m * 16) * 4096u + (unsigned)col0;
#pragma unroll
                for (int bj = 0; bj < 2; ++bj) { f32x4 v0 = acc[ai][bj][m][0], v1 = acc[ai][bj][m][1];
#pragma unroll
                    for (int j = 0; j < 4; ++j) { const float a = fmaxf(v0[j], 0.f), b = fmaxf(v1[j], 0.f); v0[j] = a * a; v1[j] = b * b; }
                    *(GAS u32x4*)(rowp + bj * HALF) = pack8(v0, v1); } }
    }
};
struct EpiResid {
    static constexpr bool PERM = true, AFTER_DRAIN = false;
    const float* base32_; bf16_t* xb_; const float* gate_;
    __device__ __forceinline__ void operator()(const f32x4 (&acc)[2][2][4][2], const Unit& u, int wr, int wc, int fr, int fq) const {
        const gf32* base32 = (const gf32*)base32_; gbf16* xb = (gbf16*)xb_; const gf32* gate = (const gf32*)gate_;
        const int row0 = u.pm * BM + wr * 64 + fr; const int col0 = u.pn * BM + wc * 32 + 8 * fq;
        const gf32* gp = gate + (size_t)(u.pm >> 3) * 6144 + col0;
        f32x4 gv[2][2];
#pragma unroll
        for (int bj = 0; bj < 2; ++bj)
#pragma unroll
            for (int n = 0; n < 2; ++n) gv[bj][n] = *(const GAS f32x4*)(gp + bj * HALF + n * 4);
#pragma unroll
        for (int ai = 0; ai < 2; ++ai)
#pragma unroll
            for (int m = 0; m < 4; ++m) { const unsigned off = (unsigned)(row0 + ai * HALF + m * 16) * 1024u + (unsigned)col0;
#pragma unroll
                for (int bj = 0; bj < 2; ++bj) { f32x4 b0, b1;
                    if (base32_) { b0 = *(const GAS f32x4*)(base32 + off + bj * HALF); b1 = *(const GAS f32x4*)(base32 + off + bj * HALF + 4); }
                    else { const u32x4 w = *(const GAS u32x4*)(xb + off + bj * HALF);
                        b0 = (f32x4){__builtin_bit_cast(float, w.x << 16), __builtin_bit_cast(float, w.x & 0xffff0000u), __builtin_bit_cast(float, w.y << 16), __builtin_bit_cast(float, w.y & 0xffff0000u)};
                        b1 = (f32x4){__builtin_bit_cast(float, w.z << 16), __builtin_bit_cast(float, w.z & 0xffff0000u), __builtin_bit_cast(float, w.w << 16), __builtin_bit_cast(float, w.w & 0xffff0000u)}; }
                    *(GAS u32x4*)(xb + off + bj * HALF) = pack8(b0 + gv[bj][0] * acc[ai][bj][m][0], b1 + gv[bj][1] * acc[ai][bj][m][1]); } }
    }
};
struct EpiMlaKv {
    static constexpr bool PERM = true, AFTER_DRAIN = false;
    unsigned char* ws;
    __device__ __forceinline__ void operator()(const f32x4 (&acc)[2][2][4][2], const Unit& u, int wr, int wc, int fr, int fq) const {
        const gf32* ssq = (const gf32*)((gu8*)ws + WS_SSQKV); gbf16* Kp = (gbf16*)((gu8*)ws + WS_K); gbf16* V = (gbf16*)((gu8*)ws + WS_V);
        const int row0 = u.pm * BM + wr * 64 + fr;
        const int t = u.pn >> 2; const int cin0 = (u.pn & 3) * BM + wc * 32 + 8 * fq;
#pragma unroll
        for (int ai = 0; ai < 2; ++ai)
#pragma unroll
            for (int m = 0; m < 4; ++m) { const unsigned row = (unsigned)(row0 + ai * HALF + m * 16);
                const f32x4 s4 = *(const GAS f32x4*)(ssq + row * 4);
                const float rs = __builtin_amdgcn_rsqf(((s4[0] + s4[1]) + (s4[2] + s4[3])) * (1.0f / 128.0f) + RMS_EPS);
#pragma unroll
                for (int bj = 0; bj < 2; ++bj) { const int cin = cin0 + bj * HALF;
                    gbf16* dst = t ? (V + row * 1024 + cin) : (Kp + row * 1024 + cin);
                    *(GAS u32x4*)dst = pack8(acc[ai][bj][m][0] * rs, acc[ai][bj][m][1] * rs); }
                asm volatile("" ::: "memory"); }
    }
};
struct EpiMlaQ {
    static constexpr bool PERM = false, AFTER_DRAIN = false;
    unsigned char* ws; float qscale;
    __device__ __forceinline__ void operator()(const f32x4 (&acc)[2][2][4][2], const Unit& u, int wr, int wc, int fr, int fq) const {
        const gf32* ssq = (const gf32*)((gu8*)ws + WS_SSQQ); const gf32* cst = (const gf32*)((gu8*)ws + WS_CS); gbf16* Q = (gbf16*)((gu8*)ws + WS_Q);
        const int row0 = u.pm * BM + wr * 64 + fr;
#pragma unroll
        for (int ai = 0; ai < 2; ++ai)
#pragma unroll
            for (int m = 0; m < 4; ++m) { const unsigned row = (unsigned)(row0 + ai * HALF + m * 16);
                const f32x4 s4 = *(const GAS f32x4*)(ssq + row * 4);
                const float rs = qscale * __builtin_amdgcn_rsqf(((s4[0] + s4[1]) + (s4[2] + s4[3])) * (1.0f / 256.0f) + RMS_EPS);
                if (u.pn < 4) {
#pragma unroll
                    for (int bj = 0; bj < 2; ++bj)
#pragma unroll
                        for (int n = 0; n < 2; ++n) { const int cin = u.pn * BM + bj * HALF + wc * 32 + n * 16 + 4 * fq;
                            *(GAS u32x2*)(Q + row * 1536 + (cin >> 6) * 96 + (cin & 63)) = pack4(acc[ai][bj][m][n] * rs); }
                } else {
                    const f32x4 cs = *(const GAS f32x4*)(cst + row * 32 + 4 * fq), sn = *(const GAS f32x4*)(cst + row * 32 + 16 + 4 * fq);
#pragma unroll
                    for (int bj = 0; bj < 2; ++bj) { const int head = ((u.pn - 4) * BM + bj * HALF + wc * 32) >> 5;
                        const f32x4 x1 = acc[ai][bj][m][0] * rs, x2 = acc[ai][bj][m][1] * rs;
                        gbf16* dst = Q + row * 1536 + head * 96 + 64 + 4 * fq;
                        *(GAS u32x2*)dst = pack4(x1 * cs - x2 * sn); *(GAS u32x2*)(dst + 16) = pack4(x2 * cs + x1 * sn); }
                }
                asm volatile("" ::: "memory");
            }
    }
};
struct EpiMlaDown {
    static constexpr bool PERM = false, AFTER_DRAIN = false;
    unsigned char* ws;
    __device__ __forceinline__ void operator()(const f32x4 (&acc)[2][2][4][2], const Unit& u, int wr, int wc, int fr, int fq) const {
        gbf16* cq = (gbf16*)((gu8*)ws + WS_CQ); gbf16* ckv = (gbf16*)((gu8*)ws + WS_CKV); gf32* ssqq = (gf32*)((gu8*)ws + WS_SSQQ); gf32* ssqkv = (gf32*)((gu8*)ws + WS_SSQKV); const gf32* cst = (const gf32*)((gu8*)ws + WS_CS); gbf16* Kp = (gbf16*)((gu8*)ws + WS_K);
        const int row0 = u.pm * BM + wr * 64 + fr;
#pragma unroll
        for (int ai = 0; ai < 2; ++ai)
#pragma unroll
            for (int m = 0; m < 4; ++m) { const unsigned row = (unsigned)(row0 + ai * HALF + m * 16);
                if (u.pn == 0) {
                    float ss = 0.f;
#pragma unroll
                    for (int bj = 0; bj < 2; ++bj)
#pragma unroll
                        for (int n = 0; n < 2; ++n) { const f32x4 v = acc[ai][bj][m][n]; ss += (v[0] * v[0] + v[1] * v[1]) + (v[2] * v[2] + v[3] * v[3]);
                            *(GAS u32x2*)(cq + row * 256 + bj * HALF + wc * 32 + n * 16 + 4 * fq) = pack4(v); }
                    ss = xor_sum<16>(ss); ss = xor_sum<32>(ss);
                    if (fq == 0) ssqq[row * 4 + wc] = ss;
                } else {
                    float ss = 0.f;
#pragma unroll
                    for (int n = 0; n < 2; ++n) { const f32x4 v = acc[ai][0][m][n]; ss += (v[0] * v[0] + v[1] * v[1]) + (v[2] * v[2] + v[3] * v[3]);
                        *(GAS u32x2*)(ckv + row * 128 + wc * 32 + n * 16 + 4 * fq) = pack4(v); }
                    ss = xor_sum<16>(ss); ss = xor_sum<32>(ss);
                    if (fq == 0) ssqkv[row * 4 + wc] = ss;
                    if (wc == 0) {
                        const f32x4 cs = *(const GAS f32x4*)(cst + row * 32 + 4 * fq), sn = *(const GAS f32x4*)(cst + row * 32 + 16 + 4 * fq);
                        const f32x4 x1 = acc[ai][1][m][0], x2 = acc[ai][1][m][1];
                        const u32x2 o1 = pack4(x1 * cs - x2 * sn), o2 = pack4(x2 * cs + x1 * sn);
                        gbf16* dst = (gbf16*)((gu8*)ws + WS_KR) + row * 32 + 4 * fq;
                        *(GAS u32x2*)dst = o1; *(GAS u32x2*)(dst + 16) = o2;
                    }
                }
            }
    }
};

template <class Epi, class Sched, bool ALIGN_EPI = false, bool SP2 = false>
__device__ __forceinline__ void gemm_phase(PG8_LAS unsigned char* lds, const Gemm g, const Sched& S, const Epi& E, const int wv_) {
    int tid_; asm volatile("v_mbcnt_lo_u32_b32 %0, -1, 0\n\tv_mbcnt_hi_u32_b32 %0, -1, %0" : "=v"(tid_)); tid_ += wv_ * 64;
    const int tid = tid_, wid = __builtin_amdgcn_readfirstlane(tid >> 6), lane = tid & 63, wr = wid >> 2, wc = wid & 3, fr = lane & 15, fq = lane >> 4;
    const int K = g.K, nt = K / BK;
    unsigned voffA[2], voffB[2];
#pragma unroll
    for (int i = 0; i < 2; ++i) { int R, C; stage_rc(tid * 16 + i * 8192, R, C); const int Rb = Epi::PERM ? ((R & ~31) + perm32(R & 31)) : R;
        voffA[i] = (unsigned)(R * K + C) * 2u; voffB[i] = (unsigned)(Rb * K + C) * 2u; }
    const size_t kstep = (size_t)(BK * 2);
    const size_t hstep = (size_t)HALF * K * 2;
    const size_t tstep = 2 * hstep;
    const unsigned ldsw = (unsigned)wid * 1024u;
    const int aoff = lds_byte(wr * 64 + fr, fq * 8), boff = lds_byte(wc * 32 + fr, fq * 8);
#define PG8_SA(b, h) (((b) * 2 + (h)) * HTB)
#define PG8_SB(b, h) ((4 + (b) * 2 + (h)) * HTB)
#define PG8_STAGE(bufoff, gbase, voff) do { _Pragma("unroll") for (int _i = 0; _i < 2; ++_i) \
        __builtin_amdgcn_global_load_lds((const unsigned*)((const char*)(gbase) + (voff)[_i]), (PG8_LAS unsigned*)(lds + (bufoff) + ldsw + _i * 8192), 16, 0, 0); } while (0)
#define PG8_LDA(dst, b, h) do { _Pragma("unroll") for (int m = 0; m < 4; ++m) _Pragma("unroll") for (int k = 0; k < 2; ++k) dst[m][k] = *(const PG8_LAS bf16x8*)(lds + PG8_SA(b, h) + aoff + m * 2048 + k * 1024); } while (0)
#define PG8_LDB(dst, b, h) do { _Pragma("unroll") for (int n = 0; n < 2; ++n) _Pragma("unroll") for (int k = 0; k < 2; ++k) dst[n][k] = *(const PG8_LAS bf16x8*)(lds + PG8_SB(b, h) + boff + n * 2048 + k * 1024); } while (0)
#define PG8_MMA(ai, bj, At, Bt) do { __builtin_amdgcn_s_setprio(1); _Pragma("unroll") for (int m = 0; m < 4; ++m) _Pragma("unroll") for (int n = 0; n < 2; ++n) _Pragma("unroll") for (int k = 0; k < 2; ++k) \
        acc[ai][bj][m][n] = __builtin_amdgcn_mfma_f32_16x16x32_bf16(Bt[n][k], At[m][k], acc[ai][bj][m][n], 0, 0, 0); __builtin_amdgcn_s_setprio(0); } while (0)
#define PG8_WAIT_V(n) asm volatile("s_waitcnt vmcnt(" #n ")" ::: "memory")
#define PG8_WAIT_L(n) asm volatile("s_waitcnt lgkmcnt(" #n ")" ::: "memory")
#define PG8_BAR __builtin_amdgcn_s_barrier()
#define PG8_SCHED __builtin_amdgcn_sched_barrier(0)
    Unit cur, nxt; int ui = 0;
    if (!S.next(0, cur)) return;
    f32x4 acc[2][2][4][2];
#pragma unroll
    for (int a = 0; a < 2; ++a)
#pragma unroll
        for (int b = 0; b < 2; ++b)
#pragma unroll
            for (int m = 0; m < 4; ++m)
#pragma unroll
                for (int n = 0; n < 2; ++n) acc[a][b][m][n] = (f32x4){0.f, 0.f, 0.f, 0.f};
    bf16x8 At[4][2], B0[2][2], B1[2][2];
    const char* cA = (const char*)g.A + (size_t)cur.pm * tstep; const char* cB = (const char*)g.Bt + (size_t)cur.pn * tstep;
    S.a_ready(cur);
    if constexpr (SP2) {
        PG8_STAGE(PG8_SB(0, 0), cB, voffB); PG8_STAGE(PG8_SB(0, 1), cB + hstep, voffB); PG8_STAGE(PG8_SA(0, 0), cA, voffA); PG8_STAGE(PG8_SA(0, 1), cA + hstep, voffA);
        if (wr == 1) PG8_BAR;
        PG8_WAIT_V(2); PG8_BAR;
        PG8_STAGE(PG8_SB(1, 0), cB + kstep, voffB); PG8_STAGE(PG8_SA(1, 0), cA + kstep, voffA); PG8_STAGE(PG8_SB(1, 1), cB + hstep + kstep, voffB);
        PG8_WAIT_V(6); PG8_BAR;
    } else {
        PG8_STAGE(PG8_SB(0, 0), cB, voffB); PG8_STAGE(PG8_SA(0, 0), cA, voffA); PG8_STAGE(PG8_SB(0, 1), cB + hstep, voffB); PG8_STAGE(PG8_SA(0, 1), cA + hstep, voffA);
        if (wr == 1) PG8_BAR;
        PG8_WAIT_V(4); PG8_BAR;
        PG8_STAGE(PG8_SB(1, 0), cB + kstep, voffB); PG8_STAGE(PG8_SA(1, 0), cA + kstep, voffA); PG8_STAGE(PG8_SB(1, 1), cB + hstep + kstep, voffB);
        PG8_WAIT_V(6); PG8_BAR;
    }
    for (;;) {
        const bool has_next = S.next(ui + 1, nxt);
        const char* nA = has_next ? (const char*)g.A + (size_t)nxt.pm * tstep : cA; const char* nB = has_next ? (const char*)g.Bt + (size_t)nxt.pn * tstep : cB;
        for (int t = 0; t < nt; t += 2) {
            const bool last = (t == nt - 2);
            const char* a1 = cA + (size_t)(t + 1) * kstep;
            const char* a2 = last ? nA : cA + (size_t)(t + 2) * kstep; const char* b2 = last ? nB : cB + (size_t)(t + 2) * kstep;
            const char* a3 = a2 + kstep; const char* b3 = b2 + kstep;
            if (last && has_next) S.a_ready(nxt);
            if constexpr (SP2) {
            PG8_LDB(B0, 0, 0); PG8_LDB(B1, 0, 1); PG8_SCHED; PG8_LDA(At, 0, 0); PG8_STAGE(PG8_SA(1, 1), a1 + hstep, voffA);
            PG8_WAIT_V(8); PG8_WAIT_L(0); PG8_BAR; PG8_MMA(0, 0, At, B0); PG8_MMA(0, 1, At, B1); PG8_BAR; PG8_SCHED;
            PG8_LDA(At, 0, 1); PG8_STAGE(PG8_SB(0, 0), b2, voffB); PG8_STAGE(PG8_SB(0, 1), b2 + hstep, voffB); PG8_STAGE(PG8_SA(0, 0), a2, voffA);
            PG8_WAIT_V(8); PG8_WAIT_L(0); PG8_BAR; PG8_MMA(1, 0, At, B0); PG8_MMA(1, 1, At, B1); PG8_BAR; PG8_SCHED;
            PG8_LDB(B0, 1, 0); PG8_LDB(B1, 1, 1); PG8_SCHED; PG8_LDA(At, 1, 0); PG8_STAGE(PG8_SA(0, 1), a2 + hstep, voffA);
            PG8_WAIT_V(8); PG8_WAIT_L(0); PG8_BAR; PG8_MMA(0, 0, At, B0); PG8_MMA(0, 1, At, B1); PG8_BAR; PG8_SCHED;
            PG8_LDA(At, 1, 1); PG8_STAGE(PG8_SB(1, 0), b3, voffB); PG8_STAGE(PG8_SB(1, 1), b3 + hstep, voffB); PG8_STAGE(PG8_SA(1, 0), a3, voffA);
            PG8_WAIT_V(8); PG8_WAIT_L(0); PG8_BAR; PG8_MMA(1, 0, At, B0); PG8_MMA(1, 1, At, B1); PG8_BAR; PG8_SCHED;
            } else {
            PG8_LDB(B0, 0, 0); PG8_SCHED; PG8_LDA(At, 0, 0); PG8_STAGE(PG8_SA(1, 1), a1 + hstep, voffA);
            PG8_WAIT_L(8); PG8_BAR; PG8_WAIT_L(0); PG8_MMA(0, 0, At, B0); PG8_BAR; PG8_SCHED;
            PG8_LDB(B1, 0, 1); PG8_STAGE(PG8_SB(0, 0), b2, voffB);
            PG8_BAR; PG8_WAIT_L(0); PG8_MMA(0, 1, At, B1); PG8_BAR;
            PG8_LDA(At, 0, 1); PG8_STAGE(PG8_SA(0, 0), a2, voffA);
            PG8_BAR; PG8_WAIT_L(0); PG8_MMA(1, 0, At, B0); PG8_BAR; PG8_SCHED;
            PG8_STAGE(PG8_SB(0, 1), b2 + hstep, voffB);
            PG8_WAIT_V(6); PG8_BAR; PG8_MMA(1, 1, At, B1); PG8_BAR;
            PG8_LDB(B0, 1, 0); PG8_SCHED; PG8_LDA(At, 1, 0); PG8_STAGE(PG8_SA(0, 1), a2 + hstep, voffA);
            PG8_WAIT_L(8); PG8_BAR; PG8_WAIT_L(0); PG8_MMA(0, 0, At, B0); PG8_BAR; PG8_SCHED;
            PG8_LDB(B1, 1, 1); PG8_STAGE(PG8_SB(1, 0), b3, voffB);
            PG8_BAR; PG8_WAIT_L(0); PG8_MMA(0, 1, At, B1); PG8_BAR;
            PG8_LDA(At, 1, 1); PG8_STAGE(PG8_SA(1, 0), a3, voffA);
            PG8_BAR; PG8_WAIT_L(0); PG8_MMA(1, 0, At, B0); PG8_BAR; PG8_SCHED;
            PG8_STAGE(PG8_SB(1, 1), b3 + hstep, voffB);
            PG8_WAIT_V(6); PG8_BAR; PG8_MMA(1, 1, At, B1); PG8_BAR;
            }
        }
        if constexpr (ALIGN_EPI) { if (wr == 0) PG8_BAR; }
        if constexpr (!Epi::AFTER_DRAIN) { E(acc, cur, wr, wc, fr, fq); S.done(cur); }
        if (!has_next) break;
#pragma unroll
        for (int a = 0; a < 2; ++a)
#pragma unroll
            for (int b = 0; b < 2; ++b)
#pragma unroll
                for (int m = 0; m < 4; ++m)
#pragma unroll
                    for (int n = 0; n < 2; ++n) acc[a][b][m][n] = (f32x4){0.f, 0.f, 0.f, 0.f};
        cur = nxt; cA = nA; cB = nB; ++ui;
        if constexpr (ALIGN_EPI) { if (wr == 1) PG8_BAR; }
    }
    PG8_WAIT_V(0);
    if constexpr (!ALIGN_EPI) { if (wr == 0) PG8_BAR; }
    PG8_BAR;
    if constexpr (Epi::AFTER_DRAIN) { E.fused(acc, cur, wr, wc, fr, fq, lds, wid, lane); S.done(cur); }
#undef PG8_SA
#undef PG8_SB
#undef PG8_STAGE
#undef PG8_LDA
#undef PG8_LDB
#undef PG8_MMA
#undef PG8_WAIT_V
#undef PG8_WAIT_L
#undef PG8_BAR
#undef PG8_SCHED
}
}

__device__ __forceinline__ int olane() { int l; asm volatile("v_mbcnt_lo_u32_b32 %0, -1, 0\n\tv_mbcnt_hi_u32_b32 %0, -1, %0" : "=v"(l)); return l; }
__device__ __forceinline__ int otid(int wv) { return wv * 64 + olane(); }
__device__ __forceinline__ int obid() { int b = blockIdx.x; asm volatile("" : "+s"(b)); return b; }
__device__ __forceinline__ int ogrid() { int g = gridDim.x; asm volatile("" : "+s"(g)); return g; }
__device__ __forceinline__ unsigned f2bf(float f) { unsigned u = __builtin_bit_cast(unsigned, f); return (u + 0x7fffu + ((u >> 16) & 1u)) >> 16; }
__device__ __forceinline__ unsigned pk2(float lo, float hi) { return f2bf(lo) | (f2bf(hi) << 16); }
__device__ __forceinline__ float bf2f(unsigned b) { return __builtin_bit_cast(float, b << 16); }

__device__ __forceinline__ void transpose_item(const float* W, int ld, int K, int N, bf16* WT, int map, int drow0, const float* gk, LAS float* scr, int item, int lane) {
    const int nblk = N / 32, kb = item / nblk, nb = item % nblk, k0 = 64 * kb, n0 = 32 * nb;
    int drow;
    if (map == 1) { const int hd = n0 / 96, d = n0 % 96; drow = (d < 64) ? hd * 64 + d : 1024 + hd * 32 + (d - 64); }
    else if (map == 2) { const int hd = n0 / 128, d = n0 % 128; drow = (d < 64) ? hd * 64 + d : 1024 + hd * 64 + (d - 64); }
    else drow = drow0 + n0;
    { const int kr = lane >> 3, c4 = lane & 7; f32x4 t[8];
#pragma unroll
      for (int i = 0; i < 8; ++i) t[i] = *(const f32x4*)(W + (size_t)(k0 + 8 * i + kr) * ld + n0 + 4 * c4);
#pragma unroll
      for (int i = 0; i < 8; ++i) { const int kk = 8 * i + kr; f32x4 v = t[i]; if (gk) v = v * gk[k0 + kk];
          LAS float* d = scr + kk * 33 + 4 * c4; d[0] = v[0]; d[1] = v[1]; d[2] = v[2]; d[3] = v[3]; } }
    asm volatile("s_waitcnt lgkmcnt(0)" ::: "memory");
    const int c = lane & 7;
#pragma unroll
    for (int j = 0; j < 4; ++j) { const int n = (lane >> 3) + 8 * j; const LAS float* s = scr + (8 * c) * 33 + n;
        u32x4 o; o.x = pk2(s[0 * 33], s[1 * 33]); o.y = pk2(s[2 * 33], s[3 * 33]); o.z = pk2(s[4 * 33], s[5 * 33]); o.w = pk2(s[6 * 33], s[7 * 33]);
        *(u32x4*)(WT + (size_t)(drow + n) * K + k0 + 8 * c) = o; }
    asm volatile("s_waitcnt lgkmcnt(0)" ::: "memory");
}

struct Params { const float* in[20]; float* out; unsigned char* ws; };
enum { I_X = 0, I_C, I_POS, I_ADAW, I_ADAB, I_GMIX, I_GMLP, I_FWIN, I_FBF, I_FWOUT, I_MDQ, I_MQG, I_MUQ, I_MDKV, I_MKVG, I_MUKV, I_MOUT, I_W1, I_W2, I_GFIN };

__device__ __forceinline__ void prologue(const Params& p, LAS unsigned char* lds, const int wv_) {
    const int BID = obid(), GSZ = ogrid(); const int tid_ = otid(wv_);
    const int tid = tid_, lane = tid & 63, wave = __builtin_amdgcn_readfirstlane(tid >> 6);
    unsigned char* ws = p.ws;
    {
        LAS float* cact = (LAS float*)lds;
        LAS float* part = (LAS float*)(lds + 65536);
        const float* c = p.in[I_C];
        for (int idx = tid; idx < NB * DM; idx += NTHR) { const int b = idx >> 10, k = idx & 1023; const float v = c[idx]; cact[k * 16 + b] = v / (1.0f + __expf(-v)); }
        __syncthreads();
        float* mod = (float*)(ws + WS_MOD);
        for (int item = BID; item < 256; item += GSZ) {
            const int l = item >> 6, n0 = (item & 63) * 96, cg = tid % 24, ks = tid / 24; const bool act = tid < 384;
            f32x4 acc[16];
#pragma unroll
            for (int b = 0; b < 16; ++b) acc[b] = (f32x4){0.f, 0.f, 0.f, 0.f};
            if (act) {
                const float* wp = p.in[I_ADAW] + ((size_t)l * DM + ks * 64) * 6144 + n0 + 4 * cg;
                const LAS f32x4* cp = (const LAS f32x4*)(cact + ks * 64 * 16);
#pragma unroll 4
                for (int k = 0; k < 64; ++k) { const f32x4 w = *(const f32x4*)(wp + (size_t)k * 6144);
                    const f32x4 c0 = cp[k * 4 + 0], c1 = cp[k * 4 + 1], c2 = cp[k * 4 + 2], c3 = cp[k * 4 + 3];
                    acc[0] += w * c0[0]; acc[1] += w * c0[1]; acc[2] += w * c0[2]; acc[3] += w * c0[3];
                    acc[4] += w * c1[0]; acc[5] += w * c1[1]; acc[6] += w * c1[2]; acc[7] += w * c1[3];
                    acc[8] += w * c2[0]; acc[9] += w * c2[1]; acc[10] += w * c2[2]; acc[11] += w * c2[3];
                    acc[12] += w * c3[0]; acc[13] += w * c3[1]; acc[14] += w * c3[2]; acc[15] += w * c3[3]; }
            }
#pragma unroll
            for (int half = 0; half < 2; ++half) {
                if (act) {
#pragma unroll
                    for (int b8 = 0; b8 < 8; ++b8) *(LAS f32x4*)(part + (ks * 8 + b8) * 96 + 4 * cg) = acc[half * 8 + b8]; }
                __syncthreads();
                for (int o = tid; o < 8 * 96; o += NTHR) { const int b8 = o / 96, cc = o % 96; float s = 0.f;
#pragma unroll
                    for (int k2 = 0; k2 < 16; ++k2) s += part[(k2 * 8 + b8) * 96 + cc];
                    mod[((size_t)l * 16 + half * 8 + b8) * 6144 + n0 + cc] = s + p.in[I_ADAB][(size_t)l * 6144 + n0 + cc]; }
                __syncthreads();
            }
        }
    }
    __syncthreads();
    {
        const int* pos = (const int*)p.in[I_POS]; float* cst = (float*)(ws + WS_CS);
        for (size_t idx = (size_t)BID * NTHR + tid; idx < (size_t)M * 16; idx += (size_t)GSZ * NTHR) {
            const int tok = (int)(idx >> 4), i = (int)(idx & 15);
            const float invf = exp2f(-(float)i * (13.287712379549449f / 16.0f));
            const float ang = (float)pos[tok] * invf;
            double rev = (double)ang * 0.15915494309189535; rev -= __builtin_rint(rev);
            const float rf = (float)rev;
            cst[(size_t)tok * 32 + i] = __builtin_amdgcn_cosf(rf); cst[(size_t)tok * 32 + 16 + i] = __builtin_amdgcn_sinf(rf);
        }
    }
    for (int j = 0; j < 2; ++j) { u32x4* z = (u32x4*)(ws + WS_W + W_MLA + j * W_MLA_STRIDE + (size_t)416 * 1024 * 2);
        for (int idx = BID * NTHR + tid; idx < 96 * 1024 * 2 / 16; idx += GSZ * NTHR) z[idx] = (u32x4){0u, 0u, 0u, 0u}; }
    {
        LAS float* scr = (LAS float*)(lds + wave * 16384);
        const int gw = BID * NWAVE + wave, NGW = GSZ * NWAVE;
        constexpr int N_MLP = 4 * 4096, N_FOX = 2 * 2048, N_MLA = 2 * 1040;
        for (int it = gw; it < N_MLP + N_FOX + N_MLA; it += NGW) {
            int r = it;
            if (r < N_MLP) { const int l = r >> 12, rr = r & 4095; bf16* wb = (bf16*)(ws + WS_W + W_MLP + (size_t)l * W_MLP_STRIDE);
                if (rr < 2048) transpose_item(p.in[I_W1] + (size_t)l * DM * FF, FF, DM, FF, wb, 0, 0, nullptr, scr, rr, lane);
                else transpose_item(p.in[I_W2] + (size_t)l * DM * FF, DM, FF, DM, wb + (size_t)FF * DM, 0, 0, nullptr, scr, rr - 2048, lane);
                continue; }
            r -= N_MLP;
            if (r < N_FOX) { const int j = r >> 11, rr = r & 2047; bf16* wb = (bf16*)(ws + WS_W + W_FOX + (size_t)j * W_FOX_STRIDE);
                if (rr < 1536) transpose_item(p.in[I_FWIN] + (size_t)j * DM * 3088, 3088, DM, 3072, wb, 0, 0, nullptr, scr, rr, lane);
                else transpose_item(p.in[I_FWOUT] + (size_t)j * DM * DM, DM, DM, DM, wb + (size_t)3072 * DM, 0, 0, nullptr, scr, rr - 1536, lane);
                continue; }
            r -= N_FOX;
            { const int j = r / 1040, rr = r % 1040; bf16* wb = (bf16*)(ws + WS_W + W_MLA + (size_t)j * W_MLA_STRIDE);
                if (rr < 128) transpose_item(p.in[I_MDQ] + (size_t)j * DM * 256, 256, DM, 256, wb, 0, 0, nullptr, scr, rr, lane);
                else if (rr < 208) transpose_item(p.in[I_MDKV] + (size_t)j * DM * 160, 160, DM, 160, wb, 0, 256, nullptr, scr, rr - 128, lane);
                else if (rr < 400) transpose_item(p.in[I_MUQ] + (size_t)j * 256 * 1536, 1536, 256, 1536, wb + (size_t)512 * 1024, 1, 0, p.in[I_MQG] + j * 256, scr, rr - 208, lane);
                else if (rr < 528) transpose_item(p.in[I_MUKV] + (size_t)j * 128 * 2048, 2048, 128, 2048, wb + (size_t)512 * 1024 + (size_t)1536 * 256, 2, 0, p.in[I_MKVG] + j * 128, scr, rr - 400, lane);
                else transpose_item(p.in[I_MOUT] + (size_t)j * DM * DM, DM, DM, DM, (bf16*)((unsigned char*)wb + 3 * MiB), 0, 0, nullptr, scr, rr - 528, lane);
            }
        }
    }
}

template <int NR, bool gates>
__device__ __forceinline__ void norm_phase(const void* xv, const bool xbf, const float* g, const float* sh0, const float* sc0, bf16* hout, const float* wfsrc, const float* bfv, float* lf, LAS unsigned char* lds, const int wv_) {
    const int BID = obid(), GSZ = ogrid(); const int tid_ = otid(wv_);
    const int tid = tid_, lane = tid & 63, wave = __builtin_amdgcn_readfirstlane(tid >> 6);
    LAS float* wfs = (LAS float*)lds;
    if constexpr (gates) {
        for (int idx = tid; idx < 16 * 1024; idx += NTHR) { const int k = idx >> 4, j = idx & 15; wfs[j * 1024 + k] = wfsrc[(size_t)k * 3088 + 3072 + j]; }
        __syncthreads();
    }
    const int gw = BID * NWAVE + wave, NGW = GSZ * NWAVE;
    for (int row0 = gw * NR; row0 < M; row0 += NGW * NR) {
        const int b = row0 >> 11;
        f32x4 v[NR][4]; float ss[NR];
        if (xbf) {
#pragma unroll
            for (int r = 0; r < NR; ++r) { const u32x2* xr = (const u32x2*)((const bf16*)xv + (size_t)(row0 + r) * DM) + lane;
#pragma unroll
                for (int j = 0; j < 4; ++j) { const u32x2 w = xr[64 * j];
                    v[r][j] = (f32x4){__builtin_bit_cast(float, w.x << 16), __builtin_bit_cast(float, w.x & 0xffff0000u), __builtin_bit_cast(float, w.y << 16), __builtin_bit_cast(float, w.y & 0xffff0000u)}; } }
        } else {
#pragma unroll
            for (int r = 0; r < NR; ++r) { const f32x4* xr = (const f32x4*)((const float*)xv + (size_t)(row0 + r) * DM) + lane;
#pragma unroll
                for (int j = 0; j < 4; ++j) v[r][j] = xr[64 * j]; }
        }
#pragma unroll
        for (int r = 0; r < NR; ++r) { float s = 0.f;
#pragma unroll
            for (int j = 0; j < 4; ++j) s += (v[r][j][0] * v[r][j][0] + v[r][j][1] * v[r][j][1]) + (v[r][j][2] * v[r][j][2] + v[r][j][3] * v[r][j][3]);
            ss[r] = s; }
#pragma unroll
        for (int r = 0; r < NR; ++r) ss[r] = wave_sum(ss[r]);
        const f32x4* gp = (const f32x4*)g + lane; const f32x4* shp = (const f32x4*)(sh0 + (size_t)b * 6144) + lane; const f32x4* scp = (const f32x4*)(sc0 + (size_t)b * 6144) + lane;
#pragma unroll
        for (int j = 0; j < 4; ++j) { const f32x4 aa = gp[64 * j] * (scp[64 * j] + 1.0f), sh = shp[64 * j];
#pragma unroll
            for (int r = 0; r < NR; ++r) { const float rstd = __builtin_amdgcn_rsqf(ss[r] * (1.0f / DM) + EPS);
                v[r][j] = (v[r][j] * rstd) * aa + sh;
                u32x2 w; w.x = pk2(v[r][j][0], v[r][j][1]); w.y = pk2(v[r][j][2], v[r][j][3]); ((u32x2*)(hout + (size_t)(row0 + r) * DM) + lane)[64 * j] = w; } }
        if constexpr (gates) {
            static_assert(NR == 2, "the gate path pairs two rows in f32x2");
            f32x2 vv[4][4], z[16];
#pragma unroll
            for (int jj = 0; jj < 4; ++jj)
#pragma unroll
                for (int e = 0; e < 4; ++e) vv[jj][e] = (f32x2){v[0][jj][e], v[1][jj][e]};
#pragma unroll
            for (int jg = 0; jg < 16; ++jg) {
                f32x2 acc = (f32x2){0.f, 0.f};
#pragma unroll
                for (int jj = 0; jj < 4; ++jj) { const f32x4 w = *(const LAS f32x4*)(wfs + jg * 1024 + 256 * jj + 4 * lane);
                    acc += (vv[jj][0] * w[0] + vv[jj][1] * w[1]) + (vv[jj][2] * w[2] + vv[jj][3] * w[3]); }
                z[jg] = acc;
                if (jg & 1) asm volatile("" ::: "memory"); }
            const bool b5 = (lane & 32) != 0, b4 = (lane & 16) != 0, b3 = (lane & 8) != 0, b2 = (lane & 4) != 0;
            f32x2 a8[8], a4[4], a2[2], a1;
#pragma unroll
            for (int i = 0; i < 8; ++i) { const f32x2 send = b5 ? z[i] : z[i + 8], keep = b5 ? z[i + 8] : z[i]; a8[i] = keep + (f32x2){xor_get<32>(send[0], b5), xor_get<32>(send[1], b5)}; }
#pragma unroll
            for (int i = 0; i < 4; ++i) { const f32x2 send = b4 ? a8[i] : a8[i + 4], keep = b4 ? a8[i + 4] : a8[i]; a4[i] = keep + (f32x2){xor_get<16>(send[0], b4), xor_get<16>(send[1], b4)}; }
#pragma unroll
            for (int i = 0; i < 2; ++i) { const f32x2 send = b3 ? a4[i] : a4[i + 2], keep = b3 ? a4[i + 2] : a4[i]; a2[i] = keep + (f32x2){xor_get<8>(send[0], b3), xor_get<8>(send[1], b3)}; }
            { const f32x2 send = b2 ? a2[0] : a2[1], keep = b2 ? a2[1] : a2[0]; a1 = keep + (f32x2){xor_get<4>(send[0], b2), xor_get<4>(send[1], b2)}; }
            a1 = (f32x2){xor_sum<2>(a1[0]), xor_sum<2>(a1[1])}; a1 = (f32x2){xor_sum<1>(a1[0]), xor_sum<1>(a1[1])};
            const int gate = (b5 ? 8 : 0) + (b4 ? 4 : 0) + (b3 ? 2 : 0) + (b2 ? 1 : 0);
            if ((lane & 3) == 0) { const float bb = bfv[gate];
#pragma unroll
                for (int r = 0; r < NR; ++r) { const float zz = a1[r] + bb; lf[(size_t)(row0 + r) * 16 + gate] = fminf(zz, 0.f) - __logf(1.0f + __expf(-fabsf(zz))); } }
        }
    }
}

__device__ __forceinline__ void final_norm(const bf16* xb, float* out, const float* g, const int wv_) {
    constexpr int NR = 4;
    const int BID = obid(), GSZ = ogrid(); const int tid_ = otid(wv_);
    const int tid = tid_, lane = tid & 63, wave = __builtin_amdgcn_readfirstlane(tid >> 6);
    const int gw = BID * NWAVE + wave, NGW = GSZ * NWAVE;
    for (int row0 = gw * NR; row0 < M; row0 += NGW * NR) {
        f32x4 v[NR][4]; float ss[NR];
#pragma unroll
        for (int r = 0; r < NR; ++r) { const u32x2* xr = (const u32x2*)(xb + (size_t)(row0 + r) * DM) + lane;
#pragma unroll
            for (int j = 0; j < 4; ++j) { const u32x2 w = xr[64 * j];
                v[r][j] = (f32x4){__builtin_bit_cast(float, w.x << 16), __builtin_bit_cast(float, w.x & 0xffff0000u), __builtin_bit_cast(float, w.y << 16), __builtin_bit_cast(float, w.y & 0xffff0000u)}; } }
#pragma unroll
        for (int r = 0; r < NR; ++r) { float s = 0.f;
#pragma unroll
            for (int j = 0; j < 4; ++j) s += (v[r][j][0] * v[r][j][0] + v[r][j][1] * v[r][j][1]) + (v[r][j][2] * v[r][j][2] + v[r][j][3] * v[r][j][3]);
            ss[r] = wave_sum(s); }
        const f32x4* gp = (const f32x4*)g + lane;
#pragma unroll
        for (int j = 0; j < 4; ++j) { const f32x4 gg = gp[64 * j];
#pragma unroll
            for (int r = 0; r < NR; ++r) { const float rstd = __builtin_amdgcn_rsqf(ss[r] * (1.0f / DM) + EPS); ((f32x4*)(out + (size_t)(row0 + r) * DM) + lane)[64 * j] = (v[r][j] * rstd) * gg; } }
    }
}

__device__ __forceinline__ void fox_cumsum(const float* lf, float* Fc, LAS unsigned char* lds, const int wv_) {
    const int BID = obid(), GSZ = ogrid(); const int tid_ = otid(wv_);
    const int tid = tid_, lane = tid & 63, wave = __builtin_amdgcn_readfirstlane(tid >> 6);
    LAS float* wtot = (LAS float*)lds;
    for (int bh = BID; bh < NB * NH; bh += GSZ) {
        const int b = bh >> 4, h = bh & 15; const int s0 = 4 * tid;
        float a[4];
#pragma unroll
        for (int i = 0; i < 4; ++i) a[i] = lf[((size_t)(b * SEQ + s0 + i)) * 16 + h];
        a[1] += a[0]; a[2] += a[1]; a[3] += a[2];
        float xs = a[3];
#pragma unroll
        for (int off = 1; off < 64; off <<= 1) { const float t = __shfl_up(xs, off); if (lane >= off) xs += t; }
        if (lane == 63) wtot[wave] = xs;
        __syncthreads();
        float base = 0.f;
#pragma unroll
        for (int w = 0; w < NWAVE; ++w) { const float t = wtot[w]; if (w < wave) base += t; }
        const float excl = xs - a[3] + base;
        *(f32x4*)(Fc + (size_t)bh * SEQ + s0) = (f32x4){(a[0] + excl) * LOG2E, (a[1] + excl) * LOG2E, (a[2] + excl) * LOG2E, (a[3] + excl) * LOG2E};
        __syncthreads();
    }
}

constexpr int PTR_OFF = 131072;
__device__ __forceinline__ int crow(int r, int hi) { return (r & 3) + 8 * (r >> 2) + 4 * hi; }
__device__ __forceinline__ unsigned cvtpk(float lo, float hi) { typedef __bf16 bf16x2_t __attribute__((ext_vector_type(2))); f32x2 v = {lo, hi}; bf16x2_t b = __builtin_convertvector(v, bf16x2_t); return __builtin_bit_cast(unsigned, b); }
typedef short v4i16_t __attribute__((ext_vector_type(4)));
__device__ __forceinline__ s16x4 vtr(const LAS unsigned char* p) { return __builtin_bit_cast(s16x4, __builtin_amdgcn_ds_read_tr16_b64_v4i16((LAS v4i16_t*)p)); }
#define MFMA32(a, b, c) __builtin_amdgcn_mfma_f32_32x32x16_bf16((a), (b), (c), 0, 0, 0)

template <int NKS, bool BIAS, bool SPLITK>
__device__ __forceinline__ void attn_phase(LAS unsigned char* lds, const bf16* Q_, const bf16* K_, const bf16* V_, bf16* O_, const float* Fc_, const bf16* KR_, const int wv_) {
    constexpr int QKD = 16 * NKS, QP = 16 * QKD, RS = QKD * 2 + 16, KCH = QKD / 8, NKC = 64 * KCH;
    constexpr int KB_BYTES = 64 * RS, L_K = 0, L_V = 2 * KB_BYTES, L_WS = L_V + 2 * 8192, L_ST = L_WS + NWAVE * 128, L_F = L_ST + NWAVE * 4096;
    constexpr float THR = 20.0f;
    static_assert(L_F + SEQ * 4 <= PTR_OFF, "attention LDS");
    typedef __attribute__((address_space(1))) const bf16 gcb; typedef __attribute__((address_space(1))) bf16 gb;
    gcb* Q = (gcb*)Q_; gcb* K = (gcb*)K_; gcb* V = (gcb*)V_; gb* O = (gb*)O_;
    const int BID = obid(), GSZ = ogrid(); const int tid_ = otid(wv_);
    const int tid = tid_, lane = tid & 63, r32 = lane & 31, hi = lane >> 5; const int wid = __builtin_amdgcn_readfirstlane(tid >> 6);
    LAS float* wsf = (LAS float*)(lds + L_WS) + wid * 32;
    LAS bf16* stg = (LAS bf16*)(lds + L_ST) + wid * 2048;
    constexpr int KCP = KCH + 1, NCHK = 64 * KCP; static_assert(NCHK % 64 == 0 && NCHK <= 1024, "K image is a whole number of 1 KiB pieces");
    const bool has1 = (wid + 8) * 64 < NCHK;
    const int ca = wid * 64 + lane, cb = has1 ? ca + 512 : ca;
    constexpr int KP = SPLITK ? 1024 : QP, KHD = SPLITK ? 64 : QKD;
    const int cha = ca % KCP, chb = cb % KCP; const bool isr0 = SPLITK && cha >= 8 && cha < KCH, isr1 = SPLITK && chb >= 8 && chb < KCH;
    const unsigned kgo0 = isr0 ? (unsigned)((ca / KCP) * 32 + (cha - 8) * 8) : (unsigned)((ca / KCP) * KP + (cha < KCH ? cha : 0) * 8);
    const unsigned kgo1 = isr1 ? (unsigned)((cb / KCP) * 32 + (chb - 8) * 8) : (unsigned)((cb / KCP) * KP + (chb < KCH ? chb : 0) * 8);
    const int vr = ca >> 3, vp = ca & 7; const unsigned vgo = (unsigned)(vr * DM + ((((vp >> 2) ^ ((vr >> 1) & 1)) << 2) | (vp & 3)) * 8);
    const int kd0 = wid * 1024, kd1 = (wid + 8) * 1024, vd = wid * 1024;
    const int kfb = r32 * RS + hi * 16;
    const int i16 = lane & 15, qq = i16 >> 2, pp = i16 & 3, blk = (lane >> 4) & 1, swz = (qq >> 1) & 1;
    const int vfb0 = (4 * hi + qq) * 128 + 32 * blk + 8 * pp + swz * 64, vfb1 = (4 * hi + qq) * 128 + 32 * blk + 8 * pp + (swz ^ 1) * 64;
#define A_GLDS(GP, LOFF) do { unsigned keep_; const unsigned ldst_ = (unsigned)__builtin_amdgcn_readfirstlane((int)(unsigned)(size_t)(lds + (LOFF))); \
        asm volatile("s_mov_b32 %0, m0\n\ts_mov_b32 m0, %2\n\ts_nop 0\n\tglobal_load_lds_dwordx4 %1, off\n\ts_mov_b32 m0, %0" : "=&s"(keep_) : "v"(GP), "s"(ldst_) : "memory"); } while (0)
#define A_DMAK(t, buf) do { gcb* Kt_ = Kh + (size_t)((unsigned)(t) * 64u) * KP; asm volatile("" : "+s"(Kt_)); gcb* Rt_ = Rh + (size_t)((unsigned)(t) * 64u) * 32; asm volatile("" : "+s"(Rt_)); \
        A_GLDS((isr0 ? Rt_ : Kt_) + kgo0, L_K + (buf) * KB_BYTES + kd0); \
        if (has1) A_GLDS((isr1 ? Rt_ : Kt_) + kgo1, L_K + (buf) * KB_BYTES + kd1); } while (0)
#define A_DMAV(t, buf) do { gcb* Vt_ = Vh + (size_t)((unsigned)(t) * 64u) * DM; asm volatile("" : "+s"(Vt_)); A_GLDS(Vt_ + vgo, L_V + (buf) * 8192 + vd); } while (0)
#define A_DMAWAIT() asm volatile("s_waitcnt vmcnt(0)" ::: "memory")
#define A_QK(P0, P1, buf, CINIT) do { const LAS unsigned char* Kl_ = lds + L_K + (buf) * KB_BYTES + kfb; \
        bf16x8 a0_ = *(const LAS bf16x8*)(Kl_), a1_ = *(const LAS bf16x8*)(Kl_ + 32 * RS); \
        _Pragma("unroll") for (int ks = 0; ks < NKS; ++ks) { bf16x8 n0_ = a0_, n1_ = a1_; \
            if (ks + 1 < NKS) { n0_ = *(const LAS bf16x8*)(Kl_ + (ks + 1) * 32); n1_ = *(const LAS bf16x8*)(Kl_ + 32 * RS + (ks + 1) * 32); } \
            if (ks == 0) { P0 = MFMA32(a0_, qr[0], CINIT); P1 = MFMA32(a1_, qr[0], CINIT); } else { P0 = MFMA32(a0_, qr[ks], P0); P1 = MFMA32(a1_, qr[ks], P1); } \
            a0_ = n0_; a1_ = n1_; } } while (0)
#define A_VRD(kk, L0, H0, L1, H1) do { L0 = vtr(Vl_ + vfb0 + (kk) * 2048); H0 = vtr(Vl_ + vfb0 + (kk) * 2048 + 1024); L1 = vtr(Vl_ + vfb1 + (kk) * 2048); H1 = vtr(Vl_ + vfb1 + (kk) * 2048 + 1024); } while (0)
#define A_PV(buf) do { const LAS unsigned char* Vl_ = lds + L_V + (buf) * 8192; s16x4 l0_, h0_, l1_, h1_; A_VRD(0, l0_, h0_, l1_, h1_); \
        _Pragma("unroll") for (int kk = 0; kk < 4; ++kk) { s16x4 nl0_ = l0_, nh0_ = h0_, nl1_ = l1_, nh1_ = h1_; \
            if (kk + 1 < 4) A_VRD(kk + 1, nl0_, nh0_, nl1_, nh1_); \
            const bf16x8 b0_ = (bf16x8){l0_[0], l0_[1], l0_[2], l0_[3], h0_[0], h0_[1], h0_[2], h0_[3]}, b1_ = (bf16x8){l1_[0], l1_[1], l1_[2], l1_[3], h1_[0], h1_[1], h1_[2], h1_[3]}; \
            o0 = MFMA32(PAp[kk], b0_, o0); o1 = MFMA32(PAp[kk], b1_, o1); \
            l0_ = nl0_; h0_ = nh0_; l1_ = nl1_; h1_ = nh1_; } } while (0)
#define A_MASK(t) do { const int kb0_ = 64 * (t) + 4 * hi; \
        _Pragma("unroll") for (int i = 0; i < 16; ++i) { const int kv_ = kb0_ + (i & 3) + 8 * (i >> 2); if (kv_ > qabs) pc0[i] = -INFINITY; if (kv_ + 32 > qabs) pc1[i] = -INFINITY; } } while (0)
#define A_ROWMAX(RM) do { float a_ = __builtin_fmaxf(__builtin_fmaxf(pc0[0], pc0[1]), pc1[0]), b_ = __builtin_fmaxf(__builtin_fmaxf(pc0[2], pc0[3]), pc1[1]); a_ = __builtin_fmaxf(__builtin_fmaxf(a_, pc1[2]), pc1[3]); \
        _Pragma("unroll") for (int r = 4; r < 16; r += 4) { a_ = __builtin_fmaxf(__builtin_fmaxf(a_, pc0[r]), pc0[r + 1]); b_ = __builtin_fmaxf(__builtin_fmaxf(b_, pc0[r + 2]), pc0[r + 3]); \
            a_ = __builtin_fmaxf(__builtin_fmaxf(a_, pc1[r]), pc1[r + 1]); b_ = __builtin_fmaxf(__builtin_fmaxf(b_, pc1[r + 2]), pc1[r + 3]); } \
        RM = __builtin_fmaxf(a_, b_); { auto rr_ = __builtin_amdgcn_permlane32_swap(__float_as_uint(RM), __float_as_uint(RM), false, false); RM = __builtin_fmaxf(__uint_as_float(rr_[0]), __uint_as_float(rr_[1])); } } while (0)
#define A_EXPPACK() do { float ls_ = 0.f; \
        _Pragma("unroll") for (int i = 0; i < 16; ++i) { pc0[i] = __builtin_amdgcn_exp2f(pc0[i]); pc1[i] = __builtin_amdgcn_exp2f(pc1[i]); ls_ += pc0[i] + pc1[i]; } \
        lrow += ls_; u32x4 w_; \
        w_ = (u32x4){cvtpk(pc0[0], pc0[1]), cvtpk(pc0[2], pc0[3]), cvtpk(pc0[4], pc0[5]), cvtpk(pc0[6], pc0[7])}; PAc[0] = __builtin_bit_cast(bf16x8, w_); \
        w_ = (u32x4){cvtpk(pc0[8], pc0[9]), cvtpk(pc0[10], pc0[11]), cvtpk(pc0[12], pc0[13]), cvtpk(pc0[14], pc0[15])}; PAc[1] = __builtin_bit_cast(bf16x8, w_); \
        w_ = (u32x4){cvtpk(pc1[0], pc1[1]), cvtpk(pc1[2], pc1[3]), cvtpk(pc1[4], pc1[5]), cvtpk(pc1[6], pc1[7])}; PAc[2] = __builtin_bit_cast(bf16x8, w_); \
        w_ = (u32x4){cvtpk(pc1[8], pc1[9]), cvtpk(pc1[10], pc1[11]), cvtpk(pc1[12], pc1[13]), cvtpk(pc1[14], pc1[15])}; PAc[3] = __builtin_bit_cast(bf16x8, w_); } while (0)
#define A_BIAS(t) do { if (BIAS) { const LAS float* fb_ = (const LAS float*)(lds + L_F) + 64 * (t) + 4 * hi; \
        _Pragma("unroll") for (int g4 = 0; g4 < 4; ++g4) { const f32x4 b0_ = *(const LAS f32x4*)(fb_ + 8 * g4), b1_ = *(const LAS f32x4*)(fb_ + 8 * g4 + 32); \
            _Pragma("unroll") for (int j = 0; j < 4; ++j) { pc0[4 * g4 + j] -= b0_[j]; pc1[4 * g4 + j] -= b1_[j]; } } } } while (0)
#define A_VALU(t, BAND) do { A_BIAS(t); if (BAND) A_MASK(t); float rm_; A_ROWMAX(rm_); rm_ -= mrow; upd = __any(rm_ > THR); \
        if (upd) { const float dl_ = __builtin_fmaxf(rm_, 0.f); mrow += dl_; \
            fsc = __builtin_amdgcn_exp2f(-dl_); lrow *= fsc; } \
        _Pragma("unroll") for (int i = 0; i < 16; ++i) { pc0[i] -= mrow; pc1[i] -= mrow; } \
        A_EXPPACK(); } while (0)
#define A_KRD(ks) do { kf_[2 * (ks)] = *(const LAS bf16x8*)(Kl_ + (ks) * 32); kf_[2 * (ks) + 1] = *(const LAS bf16x8*)(Kl_ + 32 * RS + (ks) * 32); } while (0)
#define A_MFMA(t, DOQK, DOPV) do { const LAS unsigned char* Kl_ = lds + L_K + (((t) + 1) & 1) * KB_BYTES + kfb; const LAS unsigned char* Vl_ = lds + L_V + (((t) - 1) & 1) * 8192; \
        s16x4 vl0_[4], vh0_[4], vl1_[4], vh1_[4]; \
        if (DOQK) { bf16x8 kf_[2 * NKS]; \
            A_KRD(0); A_KRD(1); \
            __builtin_amdgcn_sched_barrier(0); \
            _Pragma("unroll") for (int ks = 0; ks < NKS; ++ks) { \
                if (ks == 0) { pn0 = MFMA32(kf_[0], qr[0], ((f32x16)(0.0f))); pn1 = MFMA32(kf_[1], qr[0], ((f32x16)(0.0f))); } \
                else { pn0 = MFMA32(kf_[2 * ks], qr[ks], pn0); pn1 = MFMA32(kf_[2 * ks + 1], qr[ks], pn1); } \
                if (ks + 2 < NKS) A_KRD(ks + 2); \
                if (ks >= NKS - 2) A_VRD(ks - (NKS - 2), vl0_[ks - (NKS - 2)], vh0_[ks - (NKS - 2)], vl1_[ks - (NKS - 2)], vh1_[ks - (NKS - 2)]); \
                __builtin_amdgcn_sched_barrier(0); } } \
        else if (DOPV) { A_VRD(0, vl0_[0], vh0_[0], vl1_[0], vh1_[0]); A_VRD(1, vl0_[1], vh0_[1], vl1_[1], vh1_[1]); } \
        if (DOPV) { \
            _Pragma("unroll") for (int kk = 0; kk < 4; ++kk) { \
                const bf16x8 b0_ = (bf16x8){vl0_[kk][0], vl0_[kk][1], vl0_[kk][2], vl0_[kk][3], vh0_[kk][0], vh0_[kk][1], vh0_[kk][2], vh0_[kk][3]}; \
                const bf16x8 b1_ = (bf16x8){vl1_[kk][0], vl1_[kk][1], vl1_[kk][2], vl1_[kk][3], vh1_[kk][0], vh1_[kk][1], vh1_[kk][2], vh1_[kk][3]}; \
                o0 = MFMA32(PAp[kk], b0_, o0); o1 = MFMA32(PAp[kk], b1_, o1); \
                if (kk + 2 < 4) A_VRD(kk + 2, vl0_[kk + 2], vh0_[kk + 2], vl1_[kk + 2], vh1_[kk + 2]); \
                __builtin_amdgcn_sched_barrier(0); } } } while (0)
    const bool teamed = (GSZ == 256);
    const int xcd = BID & 7, slot = BID >> 3, team = slot >> 3, mem = slot & 7;
#ifdef PROBE_AT
    unsigned long long pacc = 0, pt0 = 0;
#define PT_BEG(C) do { if (PROBE_AT == (C)) pt0 = __builtin_amdgcn_s_memtime(); } while (0)
#define PT_END(C) do { if (PROBE_AT == (C)) pacc += __builtin_amdgcn_s_memtime() - pt0; } while (0)
#else
#define PT_BEG(C) do {} while (0)
#define PT_END(C) do {} while (0)
#endif
    const int nit = teamed ? 8 : 8 * ((NB * NH - BID + GSZ - 1) / GSZ);
#define A_UNIT(i, BH, QB) do { if (teamed) { BH = (xcd * 4 + team) * 8 + (i); QB = (mem + (i)) & 7; } else { BH = BID + ((i) >> 3) * GSZ; QB = 7 - ((i) & 7); } } while (0)
    bf16x8 qr[NKS];
#define A_PREFETCH(i) do { int bh_, qb_; A_UNIT(i, bh_, qb_); const size_t rb_ = (size_t)(bh_ >> 4) * SEQ; const int h_ = bh_ & 15; \
        gcb* Kh = K + rb_ * KP + h_ * KHD; gcb* Rh = SPLITK ? (gcb*)KR_ + rb_ * 32 : Kh; gcb* Vh = V + rb_ * DM + h_ * 64; gcb* Qu_ = Q + (rb_ + qb_ * 256 + wid * 32) * QP + h_ * QKD; \
        unsigned qgo_; { int lq = lane; asm volatile("" : "+v"(lq)); qgo_ = (unsigned)((lq & 31) * QP + (lq >> 5) * 8); } \
        _Pragma("unroll") for (int ks = 0; ks < NKS; ++ks) qr[ks] = *(const __attribute__((address_space(1))) bf16x8*)(Qu_ + qgo_ + ks * 16); \
        A_DMAK(0, 0); A_DMAV(0, 0); A_DMAK(1, 1); } while (0)
    if (nit > 0) A_PREFETCH(0);
    for (int it = 0; it < nit; ++it) {
        int bh, qb; A_UNIT(it, bh, qb);
        const int b = bh >> 4, h = bh & 15; const size_t rowbase = (size_t)b * SEQ;
        gcb* Kh = K + rowbase * KP + h * KHD; gcb* Rh = SPLITK ? (gcb*)KR_ + rowbase * 32 : Kh; gcb* Vh = V + rowbase * DM + h * 64;
        {
            const int q0 = qb * 256; const int NT = 4 * qb + 4;
            PT_BEG('U');
            const int qabs = q0 + wid * 32 + r32; const int Tw = 4 * qb + (wid >> 1);
            if (BIAS) *(LAS f32x4*)(lds + L_F + tid * 16) = *(const __attribute__((address_space(1))) f32x4*)((const __attribute__((address_space(1))) float*)Fc_ + (size_t)bh * SEQ + 4 * tid);
            A_DMAWAIT(); __syncthreads();
            f32x16 pc0, pc1, pn0, pn1, o0 = (f32x16)(0.0f), o1 = (f32x16)(0.0f);
            A_QK(pc0, pc1, 0, ((f32x16)(0.0f))); A_QK(pn0, pn1, 1, ((f32x16)(0.0f)));
            bf16x8 PAp[4], PAc[4]; float mrow, lrow = 0.f, fsc = 1.f; bool upd = false;
            { A_BIAS(0); if (NT == 4) A_MASK(0);
              float rm_; A_ROWMAX(rm_); mrow = rm_;
#pragma unroll
              for (int i = 0; i < 16; ++i) { pc0[i] -= mrow; pc1[i] -= mrow; }
              A_EXPPACK(); }
#pragma unroll
            for (int k4 = 0; k4 < 4; ++k4) PAp[k4] = PAc[k4];
            pc0 = pn0; pc1 = pn1;
            __syncthreads();
            A_DMAK(2, 0);
            A_DMAWAIT(); __syncthreads();
            PT_END('U');
            for (int t = 1; t < NT; ++t) {
                if (t + 2 < NT) A_DMAK(t + 2, t & 1);
                A_DMAV(t, t & 1);
                const bool band = (t >= NT - 4);
                const bool doqk = (t + 1 <= Tw), dopv = (t - 1 <= Tw), dova = (t <= Tw);
                A_MFMA(t, doqk, dopv);
                if (dova) { A_VALU(t, band); } else { upd = false; }
                if (upd) {
                    if (hi == 0) wsf[r32] = fsc;
                    asm volatile("" ::: "memory");
#pragma unroll
                    for (int g4 = 0; g4 < 4; ++g4) { const f32x4 a = *(const LAS f32x4*)(wsf + 8 * g4 + 4 * hi);
#pragma unroll
                        for (int j = 0; j < 4; ++j) { o0[4 * g4 + j] *= a[j]; o1[4 * g4 + j] *= a[j]; } }
                    asm volatile("" ::: "memory");
                }
                A_DMAWAIT(); __syncthreads();
                pc0 = pn0; pc1 = pn1;
#pragma unroll
                for (int k4 = 0; k4 < 4; ++k4) PAp[k4] = PAc[k4];
            }
            PT_BEG('U');
            { const int inx = (it + 1 < nit) ? it + 1 : it; A_PREFETCH(inx); }
            if (NT - 1 <= Tw) { A_PV((NT - 1) & 1); }
            lrow = xor_sum<32>(lrow);
            { int le = lane; asm volatile("" : "+v"(le));
              const int r32e = le & 31, hie = le >> 5;
              if (hie == 0) wsf[r32e] = 1.0f / lrow;
              asm volatile("" ::: "memory");
              LAS bf16* st0 = stg + (4 * hie) * 64 + r32e;
#pragma unroll
              for (int g4 = 0; g4 < 4; ++g4) { const f32x4 a = *(const LAS f32x4*)(wsf + 8 * g4 + 4 * hie);
#pragma unroll
                  for (int j = 0; j < 4; ++j) { const int i = 4 * g4 + j;
                      st0[(8 * g4 + j) * 64] = (bf16)f2bf(o0[i] * a[j]); st0[(8 * g4 + j) * 64 + 32] = (bf16)f2bf(o1[i] * a[j]); } }
              asm volatile("s_waitcnt lgkmcnt(0)" ::: "memory");
              const unsigned lo_ = (unsigned)((le >> 3) * DM + (le & 7) * 8); const LAS bf16* sr0 = stg + (le >> 3) * 64 + (le & 7) * 8;
#pragma unroll
              for (int i = 0; i < 4; ++i) { gb* Ow = O + (rowbase + q0 + wid * 32 + i * 8) * DM + h * 64; const u32x4 v = *(const LAS u32x4*)(sr0 + i * 8 * 64); *(__attribute__((address_space(1))) u32x4*)(Ow + lo_) = v; } }
            A_DMAWAIT(); __syncthreads();
            PT_END('U');
        }
    }
#ifdef PROBE_AT
    { const unsigned long long w0 = __builtin_amdgcn_s_memtime(); while (__builtin_amdgcn_s_memtime() - w0 < pacc) __builtin_amdgcn_s_sleep(4); }
#endif
#undef PT_BEG
#undef PT_END
#undef A_GLDS
#undef A_UNIT
#undef A_PREFETCH
#undef A_DMAK
#undef A_DMAV
#undef A_DMAWAIT
#undef A_QK
#undef A_PV
#undef A_VRD
#undef A_MASK
#undef A_ROWMAX
#undef A_EXPPACK
#undef A_VALU
#undef A_BIAS
#undef A_MFMA
#undef A_KRD
}

#define XB_TMO      128
#define XB_XCNT(j)  (256  + 64 * (j))
#define XB_XSUB(j)  (1280 + 64 * (j))
#define XB_XGEN(j)  (2304 + 64 * (j))
#define XB_TOP      3328
#define XB_TOPGEN   3392
#define XCD_BAR_WORDS 3456
#define XB_SPIN_CAP (1u << 18)

__device__ __forceinline__ unsigned xb_ld(unsigned* p)              { return __hip_atomic_load(p, __ATOMIC_RELAXED, __HIP_MEMORY_SCOPE_AGENT); }
__device__ __forceinline__ unsigned xb_add(unsigned* p, unsigned v) { return __hip_atomic_fetch_add(p, v, __ATOMIC_RELAXED, __HIP_MEMORY_SCOPE_AGENT); }
__device__ __forceinline__ unsigned xb_xcc_id() { return (unsigned)__builtin_amdgcn_s_getreg((3 << 11) | 20) & 0xFu; }
#define XB_SPIN(cond, bar) do { unsigned _sp = 0; while (cond) { __builtin_amdgcn_s_sleep(1); \
    if ((++_sp & 255u) == 0u) { if (xb_ld(&(bar)[XB_TMO])) break; if (_sp > XB_SPIN_CAP) { atomicAdd(&(bar)[XB_TMO], 1u); break; } } } } while (0)

struct XcdBarrier {
    unsigned* bar; unsigned x;
    volatile LAS unsigned* st;
};

__device__ __forceinline__ XcdBarrier xcd_barrier_post(unsigned* bar, volatile LAS unsigned* st, const int wv_) {
    XcdBarrier b; b.bar = bar; b.x = xb_xcc_id(); b.st = st;
    if (otid(wv_) == 0) (void)xb_add(&bar[XB_XCNT(b.x)], 1u);
    return b;
}
__device__ __forceinline__ void xcd_barrier_complete(unsigned* bar, unsigned x, unsigned& nloc, unsigned& nx) {
    const unsigned G = gridDim.x * gridDim.y * gridDim.z;
    unsigned sum, cnt, mine, sp = 0u;
    for (;;) {
        sum = 0u; cnt = 0u; mine = 0u;
#pragma unroll
        for (unsigned j = 0; j < 16; ++j) { const unsigned c = xb_ld(&bar[XB_XCNT(j)]); sum += c; cnt += (c > 0u) ? 1u : 0u; mine = (j == x) ? c : mine; }
        if (sum == G) break;
        __builtin_amdgcn_s_sleep(1);
        if ((++sp & 255u) == 0u) { if (xb_ld(&bar[XB_TMO])) break; if (sp > XB_SPIN_CAP) { atomicAdd(&bar[XB_TMO], 1u); break; } }
    }
    nloc = mine > 0u ? mine : 1u; nx = cnt > 0u ? cnt : 1u;
}

__device__ __forceinline__ void xcd_barrier(const XcdBarrier& b, const int wv_) {
    asm volatile("s_waitcnt vmcnt(0)" ::: "memory");
    __syncthreads();
    if (otid(wv_) == 0) {
        unsigned* bar = b.bar;
        __builtin_amdgcn_s_waitcnt(0);
        unsigned nloc = b.st[0], nx = b.st[1];
        if (nloc == 0u) { xcd_barrier_complete(bar, b.x, nloc, nx); b.st[0] = nloc; b.st[1] = nx; }
        const unsigned old = xb_add(&bar[XB_XSUB(b.x)], 1u);
        const unsigned gen = old / nloc;
        if (old + 1u == (gen + 1u) * nloc) {
            __builtin_amdgcn_fence(__ATOMIC_RELEASE, "agent");
            asm volatile("s_waitcnt vmcnt(0)" ::: "memory");
            const unsigned og = xb_add(&bar[XB_TOP], 1u);
            const unsigned tg = og / nx;
            if (og + 1u == (tg + 1u) * nx) xb_add(&bar[XB_TOPGEN], 1u);
            else XB_SPIN(xb_ld(&bar[XB_TOPGEN]) == tg, bar);
            __builtin_amdgcn_fence(__ATOMIC_ACQUIRE, "agent");
            xb_add(&bar[XB_XGEN(b.x)], 1u);
            asm volatile("s_waitcnt vmcnt(0)" ::: "memory");
        } else {
            XB_SPIN(xb_ld(&bar[XB_XGEN(b.x)]) == gen, bar);
            __builtin_amdgcn_fence(__ATOMIC_ACQUIRE, "agent");
            asm volatile("s_waitcnt vmcnt(0)" ::: "memory");
        }
    }
    __syncthreads();
}

__device__ __forceinline__ const float* inptr(LAS unsigned char* lds, int i) {
    unsigned off = PTR_OFF + 8 * i; asm volatile("" : "+v"(off));
    const u32x2 v = *(const LAS u32x2*)(lds + off);
    const unsigned lo = __builtin_amdgcn_readfirstlane(v.x), hi = __builtin_amdgcn_readfirstlane(v.y);
    return (const float*)(((unsigned long long)hi << 32) | lo);
}
__global__ void __launch_bounds__(NTHR, 2) trunk_fwd(Params p) {
    extern __shared__ __attribute__((aligned(16))) unsigned char lds_raw[];
    LAS unsigned char* lds = (LAS unsigned char*)lds_raw;
    cg::grid_group grid = cg::this_grid();
    const int wv_ = __builtin_amdgcn_readfirstlane(threadIdx.x >> 6);
#ifdef PROBE_CAT
    const unsigned long long tp0_ = __builtin_amdgcn_s_memrealtime();
#endif
#ifndef NO_PRO
    prologue(p, lds, wv_);
#endif
#ifdef PROBE_CAT
    if (PROBE_CAT == 'P') { const unsigned long long d_ = __builtin_amdgcn_s_memrealtime() - tp0_; const unsigned long long w0_ = __builtin_amdgcn_s_memrealtime(); while (__builtin_amdgcn_s_memrealtime() - w0_ < d_) __builtin_amdgcn_s_sleep(8); }
#endif
    { const int t0 = otid(wv_); if (t0 < 22) { const unsigned long long v = (t0 < 20) ? (unsigned long long)p.in[t0 < 20 ? t0 : 0] : (t0 == 20 ? (unsigned long long)p.out : (unsigned long long)p.ws);
        ((LAS unsigned long long*)(lds + PTR_OFF))[t0] = v; }
      if (t0 < 2) ((volatile LAS unsigned*)(lds + PTR_OFF + 256))[t0] = 0u; }
    if (blockIdx.x == 0) { unsigned* bw = (unsigned*)(p.ws + WS_CTL); for (int i = otid(wv_); i < XCD_BAR_WORDS; i += NTHR) __hip_atomic_store(bw + i, 0u, __ATOMIC_RELAXED, __HIP_MEMORY_SCOPE_AGENT); }
    __syncthreads();
    grid.sync();
    const XcdBarrier bar = xcd_barrier_post((unsigned*)(p.ws + WS_CTL), (volatile LAS unsigned*)(lds + PTR_OFF + 256), wv_);
#ifdef PROBE_CAT
    unsigned long long tprev_ = __builtin_amdgcn_s_memrealtime();
#define GSYNC(C) do { if ((C) == PROBE_CAT) { const unsigned long long d_ = __builtin_amdgcn_s_memrealtime() - tprev_; const unsigned long long w0_ = __builtin_amdgcn_s_memrealtime(); \
        while (__builtin_amdgcn_s_memrealtime() - w0_ < d_) __builtin_amdgcn_s_sleep(8); } xcd_barrier(bar, wv_); tprev_ = __builtin_amdgcn_s_memrealtime(); } while (0)
#else
#define GSYNC(C) xcd_barrier(bar, wv_)
#endif
#define WSP ((unsigned char*)inptr(lds, 21))
#define XRES ((float*)inptr(lds, 20))
#pragma nounroll
    for (int l = 0; l < DEPTH; ++l) {
        const int j = l >> 1; const bool fox = (l & 1) == 0;
#ifndef NO_NORM
        { unsigned char* ws = WSP; const float* modl = (const float*)(ws + WS_MOD) + (size_t)l * 16 * 6144;
          if (fox) norm_phase<2, true>((l == 0) ? (const void*)inptr(lds, I_X) : (const void*)(ws + WS_XB), l != 0, inptr(lds, I_GMIX) + l * DM, modl + 0, modl + 1024, (bf16*)(ws + WS_H), inptr(lds, I_FWIN) + (size_t)j * DM * 3088, inptr(lds, I_FBF) + j * 16, (float*)(ws + WS_LF), lds, wv_);
          else norm_phase<8, false>((const void*)(ws + WS_XB), true, inptr(lds, I_GMIX) + l * DM, modl + 0, modl + 1024, (bf16*)(ws + WS_H), nullptr, nullptr, nullptr, lds, wv_); }
#endif
        GSYNC('N');
        if (fox) {
#ifndef NO_CUM
            { unsigned char* ws = WSP; fox_cumsum((const float*)(ws + WS_LF), (float*)(ws + WS_CQ), lds, wv_); }
#endif
#ifndef NO_G1F
            { unsigned char* ws = WSP; const bf16* WinT = (const bf16*)(ws + WS_W + W_FOX + (size_t)j * W_FOX_STRIDE);
              pg8::Gemm g{(const bf16*)(ws + WS_H), WinT, M, 3072, DM}; pg8::StaticOrder S; S.init(M, 3072, ogrid(), obid());
              pg8::EpiQkvFox E{ws, 0.125f * LOG2E};
              pg8::gemm_phase<pg8::EpiQkvFox, pg8::StaticOrder, true, true>(lds, g, S, E, wv_); }
#endif
            GSYNC('G');
#ifndef NO_ATT5
            { unsigned char* ws = WSP; attn_phase<4, true, false>(lds, (const bf16*)(ws + WS_Q), (const bf16*)(ws + WS_K), (const bf16*)(ws + WS_V), (bf16*)(ws + WS_H), (const float*)(ws + WS_CQ), (const bf16*)nullptr, wv_); }
#ifdef PROBE_ATT2
            { unsigned char* ws = WSP; attn_phase<4, true, false>(lds, (const bf16*)(ws + WS_Q), (const bf16*)(ws + WS_K), (const bf16*)(ws + WS_V), (bf16*)(ws + WS_H), (const float*)(ws + WS_CQ), (const bf16*)nullptr, wv_); }
#endif
#endif
            GSYNC('A');
        } else {
#ifndef NO_GD
            { unsigned char* ws = WSP; const bf16* WdT = (const bf16*)(ws + WS_W + W_MLA + (size_t)j * W_MLA_STRIDE);
              pg8::Gemm g{(const bf16*)(ws + WS_H), WdT, M, 512, DM}; pg8::StaticOrder S; S.init(M, 512, ogrid(), obid());
              pg8::EpiMlaDown E{ws};
              pg8::gemm_phase<pg8::EpiMlaDown, pg8::StaticOrder, true, true>(lds, g, S, E, wv_); }
#endif
            GSYNC('H');
#ifndef NO_GQ
            { unsigned char* ws = WSP; const bf16* WuqT = (const bf16*)(ws + WS_W + W_MLA + (size_t)j * W_MLA_STRIDE) + (size_t)512 * 1024;
              int Kq = 256; asm volatile("" : "+s"(Kq));
              pg8::Gemm g{(const bf16*)(ws + WS_CQ), WuqT, M, 1536, Kq}; pg8::StaticOrder S; S.init(M, 1536, ogrid(), obid());
              pg8::EpiMlaQ E{ws, 0.10206207261596575f * LOG2E};
              pg8::gemm_phase<pg8::EpiMlaQ, pg8::StaticOrder, true, true>(lds, g, S, E, wv_); }
#endif
#ifndef NO_GKV
            { unsigned char* ws = WSP; const bf16* WukvT = (const bf16*)(ws + WS_W + W_MLA + (size_t)j * W_MLA_STRIDE) + (size_t)512 * 1024 + (size_t)1536 * 256;
              int Kkv = 128; asm volatile("" : "+s"(Kkv));
              pg8::Gemm g{(const bf16*)(ws + WS_CKV), WukvT, M, 2048, Kkv}; pg8::StaticOrder S; S.init(M, 2048, ogrid(), obid());
              pg8::EpiMlaKv E{ws};
              pg8::gemm_phase<pg8::EpiMlaKv, pg8::StaticOrder, true, true>(lds, g, S, E, wv_); }
#endif
            GSYNC('Q');
#ifndef NO_ATT6
            { unsigned char* ws = WSP; attn_phase<6, false, true>(lds, (const bf16*)(ws + WS_Q), (const bf16*)(ws + WS_K), (const bf16*)(ws + WS_V), (bf16*)(ws + WS_H), (const float*)nullptr, (const bf16*)(ws + WS_KR), wv_); }
#ifdef PROBE_ATT2
            { unsigned char* ws = WSP; attn_phase<6, false, true>(lds, (const bf16*)(ws + WS_Q), (const bf16*)(ws + WS_K), (const bf16*)(ws + WS_V), (bf16*)(ws + WS_H), (const float*)nullptr, (const bf16*)(ws + WS_KR), wv_); }
#endif
#endif
            GSYNC('B');
        }
#ifndef NO_GO
        { unsigned char* ws = WSP; const float* modl = (const float*)(ws + WS_MOD) + (size_t)l * 16 * 6144;
          const bf16* WoutT = fox ? (const bf16*)(ws + WS_W + W_FOX + (size_t)j * W_FOX_STRIDE) + (size_t)3072 * DM : (const bf16*)(ws + WS_W + W_MLA + (size_t)j * W_MLA_STRIDE + 3 * MiB);
          pg8::Gemm g{(const bf16*)(ws + WS_H), WoutT, M, DM, DM}; pg8::StaticOrder S; S.init(M, DM, ogrid(), obid());
          pg8::EpiResid E{(l == 0) ? inptr(lds, I_X) : (const float*)nullptr, (bf16*)(ws + WS_XB), modl + 2048};
          pg8::gemm_phase<pg8::EpiResid, pg8::StaticOrder, true, true>(lds, g, S, E, wv_); }
#endif
        GSYNC('O');
#ifndef NO_NORM2
        { unsigned char* ws = WSP; const float* modl = (const float*)(ws + WS_MOD) + (size_t)l * 16 * 6144;
          norm_phase<8, false>((const void*)(ws + WS_XB), true, inptr(lds, I_GMLP) + l * DM, modl + 3072, modl + 4096, (bf16*)(ws + WS_H), nullptr, nullptr, nullptr, lds, wv_); }
#endif
        GSYNC('M');
#ifndef NO_GU
        { unsigned char* ws = WSP; const bf16* W1T = (const bf16*)(ws + WS_W + W_MLP + (size_t)l * W_MLP_STRIDE);
          pg8::Gemm g{(const bf16*)(ws + WS_H), W1T, M, FF, DM}; pg8::StaticOrder S; S.init(M, FF, ogrid(), obid());
          pg8::EpiRelu2 E{ws};
          pg8::gemm_phase<pg8::EpiRelu2, pg8::StaticOrder, true, true>(lds, g, S, E, wv_); }
#endif
        GSYNC('U');
#ifndef NO_GDN
        { unsigned char* ws = WSP; const float* modl = (const float*)(ws + WS_MOD) + (size_t)l * 16 * 6144;
          const bf16* W2T = (const bf16*)(ws + WS_W + W_MLP + (size_t)l * W_MLP_STRIDE) + (size_t)FF * DM;
          pg8::Gemm g{(const bf16*)(ws + WS_BIG), W2T, M, DM, FF}; pg8::StaticOrder S; S.init(M, DM, ogrid(), obid());
          pg8::EpiResid E{(const float*)nullptr, (bf16*)(ws + WS_XB), modl + 5120};
          pg8::gemm_phase<pg8::EpiResid, pg8::StaticOrder, true, true>(lds, g, S, E, wv_); }
#endif
        GSYNC('D');
    }
    final_norm((const bf16*)(WSP + WS_XB), XRES, inptr(lds, I_GFIN), wv_);
#ifdef PROBE_CAT
    if (PROBE_CAT == 'F') { const unsigned long long d_ = __builtin_amdgcn_s_memrealtime() - tprev_; const unsigned long long w0_ = __builtin_amdgcn_s_memrealtime(); while (__builtin_amdgcn_s_memrealtime() - w0_ < d_) __builtin_amdgcn_s_sleep(8); }
#endif
}

extern "C" void kernel_launch(void* const* d_in, const int* in_sizes, int n_in, void* d_out, int out_size, void* d_ws, size_t ws_size, hipStream_t stream) {
    static int grid = 0;
    if (grid == 0) {
        if (n_in != 20 || in_sizes[0] != M * DM || out_size != M * DM || ws_size < WS_END) { fprintf(stderr, "kernel_launch: unexpected shapes (n_in %d, in0 %d, out %d, ws %zu)\n", n_in, n_in > 0 ? in_sizes[0] : -1, out_size, ws_size); grid = -1; return; }
        int dev = 0, cus = 0, per_cu = 0;
        if (hipGetDevice(&dev) != hipSuccess || hipDeviceGetAttribute(&cus, hipDeviceAttributeMultiprocessorCount, dev) != hipSuccess) { fprintf(stderr, "kernel_launch: device query failed\n"); grid = -1; return; }
        if (hipFuncSetAttribute((const void*)trunk_fwd, hipFuncAttributeMaxDynamicSharedMemorySize, LDS_BYTES) != hipSuccess) { fprintf(stderr, "kernel_launch: hipFuncSetAttribute failed\n"); grid = -1; return; }
        if (hipOccupancyMaxActiveBlocksPerMultiprocessor(&per_cu, (const void*)trunk_fwd, NTHR, LDS_BYTES) != hipSuccess || per_cu < 1) { fprintf(stderr, "kernel_launch: occupancy query gave %d\n", per_cu); per_cu = 1; }
        (void)hipGetLastError();
        grid = cus * per_cu;
    }
    if (grid < 0) return;
    Params prm{};
    for (int i = 0; i < 20; ++i) prm.in[i] = (const float*)d_in[i];
    prm.out = (float*)d_out; prm.ws = (unsigned char*)d_ws;
    void* args[] = {&prm};
    hipError_t e = hipLaunchCooperativeKernel((const void*)trunk_fwd, dim3(grid), dim3(NTHR), args, LDS_BYTES, stream);
    if (e != hipSuccess) fprintf(stderr, "kernel_launch: cooperative launch failed: %s (grid %d)\n", hipGetErrorString(e), grid);
}
```
